# Optimizing an MI355X kernel written in HIP

```python
import jax, jax.numpy as jnp
from jax import lax
import numpy as np

D_MODEL = 1024
BATCH = 4
SEQ = 4096
DEPTH = 2

HEAD_DIM = 64
FOX_HEADS = 6
FOX_WIDTH = FOX_HEADS * HEAD_DIM
POOL_GROUPS = 4
POOL_GROUP_DIM = 64
POOL_WINDOWS = (2, 4, 8, 16)
POOL_WIDTH = POOL_GROUPS * POOL_GROUP_DIM
NSA_HEADS = 6
NSA_KV_HEADS = 2
NSA_REP = NSA_HEADS // NSA_KV_HEADS
NSA_WIDTH = NSA_HEADS * HEAD_DIM
KV_WIDTH = NSA_KV_HEADS * HEAD_DIM
N_BRANCH = 3
CMP_LEN = 32
CMP_STRIDE = 16
CMP_HIDDEN = 256
SEL_BLOCK = 64
SEL_TOPN = 16
WINDOW = 512
FORCE_SCORE = 1.0e4
Q_BLOCK = 128
MIX_WIDTH = FOX_WIDTH + POOL_WIDTH + NSA_WIDTH
IN_SPLITS = (FOX_WIDTH, FOX_WIDTH, FOX_WIDTH, FOX_HEADS, POOL_WIDTH, NSA_WIDTH,
             KV_WIDTH, KV_WIDTH, KV_WIDTH, KV_WIDTH, KV_WIDTH, KV_WIDTH, NSA_HEADS * N_BRANCH)
IN_WIDTH = 3 * FOX_WIDTH + FOX_HEADS + POOL_WIDTH + NSA_WIDTH + 6 * KV_WIDTH + NSA_HEADS * N_BRANCH
MEM_LEN = 256
MEM_HEADS = 4
MEM_HEAD_DIM = D_MODEL // MEM_HEADS
N_GROUPS = 4
EXPERTS_PER_GROUP = 4
N_EXPERTS = N_GROUPS * EXPERTS_PER_GROUP
FINE_TOP_K = 2
EXPERT_FF = 512

EPS = 1e-6
NEG_INF = -1e30

kernel_name = "hybrid_fox_pool_nsa_hmoe"


def _split_points():
    pts, acc = [], 0
    for s in IN_SPLITS[:-1]:
        acc += s
        pts.append(acc)
    return pts


def rms_norm(x, g):
    xf = x.astype(jnp.float32)
    y = xf * lax.rsqrt(jnp.mean(xf * xf, axis=-1, keepdims=True) + EPS)
    return (y * g.astype(jnp.float32)).astype(x.dtype)


def masked_softmax(s, valid):
    p = jax.nn.softmax(jnp.where(valid, s, NEG_INF), axis=-1)
    return jnp.where(valid, p, 0.0)


def alibi_slopes(n_heads):
    return jnp.exp2(-8.0 * jnp.arange(1, n_heads + 1, dtype=jnp.float32) / n_heads)


def fox_attention(q, k, v, f_logit, b_f):
    bsz, T, _ = q.shape
    H, dh = FOX_HEADS, HEAD_DIM
    heads = lambda t: t.reshape(bsz, T, H, dh).transpose(0, 2, 1, 3)
    q, k, v = heads(q), heads(k), heads(v)
    log_f = jax.nn.log_sigmoid(f_logit.astype(jnp.float32) + b_f.astype(jnp.float32))
    cum = jnp.cumsum(log_f, axis=1).transpose(0, 2, 1)
    scale = dh ** -0.5
    kpos = jnp.arange(T)

    def block(i):
        q0 = i * Q_BLOCK
        qb = lax.dynamic_slice_in_dim(q, q0, Q_BLOCK, axis=2)
        cq = lax.dynamic_slice_in_dim(cum, q0, Q_BLOCK, axis=2)
        s = (jnp.einsum('bhqd,bhkd->bhqk', qb, k).astype(jnp.float32) * scale
             + cq[..., :, None] - cum[:, :, None, :])
        qpos = q0 + jnp.arange(Q_BLOCK)
        p = masked_softmax(s, kpos[None, :] <= qpos[:, None])
        return jnp.einsum('bhqk,bhkd->bhqd', p.astype(v.dtype), v)

    out = lax.map(block, jnp.arange(T // Q_BLOCK))
    return out.transpose(1, 0, 3, 2, 4).reshape(bsz, T, H * dh)


def pool_mixer(u, w_pool, scale):
    bsz, T, _ = u.shape
    uf = u.astype(jnp.float32).reshape(bsz, T, POOL_GROUPS, POOL_GROUP_DIM)
    cs = jnp.concatenate([jnp.zeros((bsz, 1, POOL_GROUPS, POOL_GROUP_DIM), jnp.float32),
                          jnp.cumsum(uf, axis=1)], axis=1)
    t = jnp.arange(T)
    outs = []
    for gi, w in enumerate(POOL_WINDOWS):
        start = jnp.maximum(t + 1 - w, 0)
        win_sum = cs[:, 1:, gi] - cs[:, start, gi]
        count = jnp.minimum(t + 1, w).astype(jnp.float32)
        outs.append(win_sum / count[None, :, None] - uf[:, :, gi])
    pooled = jnp.stack(outs, axis=2).astype(u.dtype)
    mixed = jnp.einsum('btgc,gcd->btgd', pooled, w_pool)
    return mixed.reshape(bsz, T, POOL_WIDTH) * scale


def nsa_attention(q, k_cmp, v_cmp, k_slc, v_slc, k_win, v_win, gate_logit, gate_b,
                  pe_k, pe_v, w1_k, w2_k, w1_v, w2_v):
    bsz, T, _ = q.shape
    G, R, dh = NSA_KV_HEADS, NSA_REP, HEAD_DIM
    scale = dh ** -0.5
    qh = q.reshape(bsz, T, G, R, dh).transpose(0, 2, 3, 1, 4)
    kv_heads = lambda t: t.reshape(bsz, T, G, dh).transpose(0, 2, 1, 3)
    k_cmp, v_cmp, k_slc, v_slc, k_win, v_win = (kv_heads(t) for t in (k_cmp, v_cmp, k_slc, v_slc, k_win, v_win))
    gates = jax.nn.sigmoid(gate_logit.astype(jnp.float32) + gate_b.astype(jnp.float32))
    gates = gates.reshape(bsz, T, G, R, N_BRANCH).transpose(0, 2, 3, 1, 4)

    n_chunk = T // CMP_STRIDE
    n_sub = CMP_LEN // CMP_STRIDE
    n_cmp = n_chunk - n_sub + 1

    def compress(t, pe, w1, w2):
        ch = t.reshape(bsz, G, n_chunk, CMP_STRIDE, dh)
        blocks = jnp.concatenate([ch[:, :, j:j + n_cmp] for j in range(n_sub)], axis=3)
        flat = (blocks + pe).reshape(bsz, G, n_cmp, CMP_LEN * dh)
        return jax.nn.gelu(flat @ w1) @ w2

    kc = compress(k_cmp, pe_k, w1_k, w2_k)
    vc = compress(v_cmp, pe_v, w1_v, w2_v)
    c_start = jnp.arange(n_cmp) * CMP_STRIDE
    c_end = c_start + CMP_LEN - 1

    n_sel_blk = T // SEL_BLOCK
    n_top = min(SEL_TOPN, n_sel_blk)
    s_start = jnp.arange(n_sel_blk) * SEL_BLOCK
    overlap = ((c_start[:, None] < s_start[None, :] + SEL_BLOCK)
               & (c_end[:, None] >= s_start[None, :])).astype(jnp.float32)
    ks_blk = k_slc.reshape(bsz, G, n_sel_blk, SEL_BLOCK, dh)
    vs_blk = v_slc.reshape(bsz, G, n_sel_blk, SEL_BLOCK, dh)
    kw_pad = jnp.pad(k_win, ((0, 0), (0, 0), (WINDOW, 0), (0, 0)))
    vw_pad = jnp.pad(v_win, ((0, 0), (0, 0), (WINDOW, 0), (0, 0)))
    slopes = alibi_slopes(NSA_HEADS).reshape(1, G, R, 1, 1)
    b_idx = jnp.arange(bsz)[:, None, None, None]
    g_idx = jnp.arange(G)[None, :, None, None]
    blk_ids = jnp.arange(n_sel_blk)
    in_blk = jnp.arange(SEL_BLOCK)
    win_off = jnp.arange(WINDOW + Q_BLOCK)

    def block(i):
        q0 = i * Q_BLOCK
        qb = lax.dynamic_slice_in_dim(qh, q0, Q_BLOCK, axis=3)
        gb = lax.dynamic_slice_in_dim(gates, q0, Q_BLOCK, axis=3)
        tq = q0 + jnp.arange(Q_BLOCK)

        dist_c = tq[:, None] - c_end[None, :]
        s_c = (jnp.einsum('bgrqd,bgcd->bgrqc', qb, kc).astype(jnp.float32) * scale
               - slopes * dist_c.astype(jnp.float32))
        p_c = masked_softmax(s_c, dist_c >= 0)
        o_c = jnp.einsum('bgrqc,bgcd->bgrqd', p_c.astype(vc.dtype), vc)

        imp = jnp.einsum('bgrqc,cj->bgqj', p_c, overlap)
        cur = tq // SEL_BLOCK
        forced = ((blk_ids[None, :] == 0) | (blk_ids[None, :] == cur[:, None])
                  | (blk_ids[None, :] == cur[:, None] - 1))
        causal_blk = blk_ids[None, :] <= cur[:, None]
        score = jnp.where(forced, FORCE_SCORE, jnp.where(causal_blk, imp, -1.0))
        _, sel = lax.top_k(score, n_top)

        k_sel = ks_blk[b_idx, g_idx, sel].reshape(bsz, G, Q_BLOCK, n_top * SEL_BLOCK, dh)
        v_sel = vs_blk[b_idx, g_idx, sel].reshape(bsz, G, Q_BLOCK, n_top * SEL_BLOCK, dh)
        pos = (sel[..., None] * SEL_BLOCK + in_blk).reshape(bsz, G, Q_BLOCK, n_top * SEL_BLOCK)
        dist_s = (tq[None, None, :, None] - pos)[:, :, None]
        s_s = (jnp.einsum('bgrqd,bgqld->bgrql', qb, k_sel).astype(jnp.float32) * scale
               - slopes * dist_s.astype(jnp.float32))
        p_s = masked_softmax(s_s, dist_s >= 0)
        o_s = jnp.einsum('bgrql,bgqld->bgrqd', p_s.astype(v_sel.dtype), v_sel)

        kw = lax.dynamic_slice_in_dim(kw_pad, q0, WINDOW + Q_BLOCK, axis=2)
        vw = lax.dynamic_slice_in_dim(vw_pad, q0, WINDOW + Q_BLOCK, axis=2)
        pk = q0 - WINDOW + win_off
        dist_w = tq[:, None] - pk[None, :]
        valid_w = (dist_w >= 0) & (dist_w < WINDOW) & (pk[None, :] >= 0)
        s_w = (jnp.einsum('bgrqd,bgkd->bgrqk', qb, kw).astype(jnp.float32) * scale
               - slopes * dist_w.astype(jnp.float32))
        p_w = masked_softmax(s_w, valid_w)
        o_w = jnp.einsum('bgrqk,bgkd->bgrqd', p_w.astype(vw.dtype), vw)

        o = gb[..., 0:1] * o_c + gb[..., 1:2] * o_s + gb[..., 2:3] * o_w
        return o.astype(q.dtype)

    out = lax.map(block, jnp.arange(T // Q_BLOCK))
    return out.transpose(1, 0, 4, 2, 3, 5).reshape(bsz, T, NSA_WIDTH)


def memory_cross_attention(h, mem_n, wq, wk, wv, wo):
    bsz, T, _ = h.shape
    M = mem_n.shape[1]
    q = (h @ wq).reshape(bsz, T, MEM_HEADS, MEM_HEAD_DIM)
    k = (mem_n @ wk).reshape(bsz, M, MEM_HEADS, MEM_HEAD_DIM)
    v = (mem_n @ wv).reshape(bsz, M, MEM_HEADS, MEM_HEAD_DIM)
    s = jnp.einsum('bqhd,bkhd->bhqk', q, k).astype(jnp.float32) * MEM_HEAD_DIM ** -0.5
    p = jax.nn.softmax(s, axis=-1)
    o = jnp.einsum('bhqk,bkhd->bqhd', p.astype(v.dtype), v).reshape(bsz, T, D_MODEL)
    return o @ wo


def hier_moe(h, w_coarse, b_coarse, w_fine, b_fine, w_gate, w_up, w_down):
    bsz, T, D = h.shape
    ht = h.reshape(-1, D)
    n_tok = ht.shape[0]
    p_coarse = jax.nn.softmax((ht @ w_coarse).astype(jnp.float32) + b_coarse.astype(jnp.float32), axis=-1)
    grp = jnp.argmax(p_coarse, axis=-1)
    w_grp = jnp.take_along_axis(p_coarse, grp[:, None], axis=-1)
    fine = ((ht @ w_fine).astype(jnp.float32) + b_fine.astype(jnp.float32)).reshape(n_tok, N_GROUPS, EXPERTS_PER_GROUP)
    fine = jnp.take_along_axis(fine, grp[:, None, None], axis=1)[:, 0]
    top_p, top_i = lax.top_k(jax.nn.softmax(fine, axis=-1), FINE_TOP_K)
    top_p = top_p / jnp.sum(top_p, axis=-1, keepdims=True)
    expert_id = grp[:, None] * EXPERTS_PER_GROUP + top_i
    weights = w_grp * top_p
    combine = jnp.sum(jax.nn.one_hot(expert_id, N_EXPERTS, dtype=jnp.float32) * weights[..., None], axis=1)
    combine = combine.astype(h.dtype)
    y = jnp.zeros_like(ht)
    for e in range(N_EXPERTS):
        he = jax.nn.silu(ht @ w_gate[e]) * (ht @ w_up[e])
        y = y + combine[:, e:e + 1] * (he @ w_down[e])
    return y.reshape(bsz, T, D)


def setup_inputs(seed: int = 0) -> dict:
    key = jax.random.key(seed)
    ks = list(jax.random.split(key, 32))
    def nrm(shape, scale):
        return jax.random.normal(ks.pop(), shape, jnp.float32) * scale
    def gain(shape):
        return 1.0 + nrm(shape, 0.02)
    L, D = DEPTH, D_MODEL
    x = nrm((BATCH, SEQ, D), 1.0)
    mem = nrm((BATCH, MEM_LEN, D), 1.0)
    mix_norm_g = gain((L, D))
    w_in = nrm((L, D, IN_WIDTH), D ** -0.5)
    fox_forget_b = jax.random.uniform(ks.pop(), (L, FOX_HEADS), jnp.float32, 1.0, 4.0)
    pool_w = nrm((L, POOL_GROUPS, POOL_GROUP_DIM, POOL_GROUP_DIM), POOL_GROUP_DIM ** -0.5)
    pool_scale = 1.0 + nrm((L, POOL_WIDTH), 0.1)
    cmp_pe_k = nrm((L, CMP_LEN, HEAD_DIM), 0.02)
    cmp_pe_v = nrm((L, CMP_LEN, HEAD_DIM), 0.02)
    cmp_w1_k = nrm((L, CMP_LEN * HEAD_DIM, CMP_HIDDEN), (CMP_LEN * HEAD_DIM) ** -0.5)
    cmp_w2_k = nrm((L, CMP_HIDDEN, HEAD_DIM), CMP_HIDDEN ** -0.5)
    cmp_w1_v = nrm((L, CMP_LEN * HEAD_DIM, CMP_HIDDEN), (CMP_LEN * HEAD_DIM) ** -0.5)
    cmp_w2_v = nrm((L, CMP_HIDDEN, HEAD_DIM), CMP_HIDDEN ** -0.5)
    nsa_gate_b = nrm((L, NSA_HEADS * N_BRANCH), 0.01)
    w_out = nrm((L, MIX_WIDTH, D), MIX_WIDTH ** -0.5)
    xattn_norm_g = gain((L, D))
    mem_norm_g = gain((L, D))
    xattn_wq = nrm((L, D, D), D ** -0.5)
    xattn_wk = nrm((L, D, D), D ** -0.5)
    xattn_wv = nrm((L, D, D), D ** -0.5)
    xattn_wo = nrm((L, D, D), D ** -0.5)
    ffn_norm_g = gain((L, D))
    router_coarse_w = nrm((L, D, N_GROUPS), D ** -0.5)
    router_coarse_b = nrm((L, N_GROUPS), 0.01)
    router_fine_w = nrm((L, D, N_EXPERTS), D ** -0.5)
    router_fine_b = nrm((L, N_EXPERTS), 0.01)
    exp_w_gate = nrm((L, N_EXPERTS, D, EXPERT_FF), D ** -0.5)
    exp_w_up = nrm((L, N_EXPERTS, D, EXPERT_FF), D ** -0.5)
    exp_w_down = nrm((L, N_EXPERTS, EXPERT_FF, D), EXPERT_FF ** -0.5)
    final_norm_g = gain((D,))
    return {"x": x, "mem": mem, "mix_norm_g": mix_norm_g, "w_in": w_in, "fox_forget_b": fox_forget_b,
            "pool_w": pool_w, "pool_scale": pool_scale, "cmp_pe_k": cmp_pe_k, "cmp_pe_v": cmp_pe_v,
            "cmp_w1_k": cmp_w1_k, "cmp_w2_k": cmp_w2_k, "cmp_w1_v": cmp_w1_v, "cmp_w2_v": cmp_w2_v,
            "nsa_gate_b": nsa_gate_b, "w_out": w_out, "xattn_norm_g": xattn_norm_g, "mem_norm_g": mem_norm_g,
            "xattn_wq": xattn_wq, "xattn_wk": xattn_wk, "xattn_wv": xattn_wv, "xattn_wo": xattn_wo,
            "ffn_norm_g": ffn_norm_g, "router_coarse_w": router_coarse_w, "router_coarse_b": router_coarse_b,
            "router_fine_w": router_fine_w, "router_fine_b": router_fine_b, "exp_w_gate": exp_w_gate,
            "exp_w_up": exp_w_up, "exp_w_down": exp_w_down, "final_norm_g": final_norm_g}


def reference(x, mem, mix_norm_g, w_in, fox_forget_b, pool_w, pool_scale, cmp_pe_k, cmp_pe_v,
              cmp_w1_k, cmp_w2_k, cmp_w1_v, cmp_w2_v, nsa_gate_b, w_out, xattn_norm_g, mem_norm_g,
              xattn_wq, xattn_wk, xattn_wv, xattn_wo, ffn_norm_g, router_coarse_w, router_coarse_b,
              router_fine_w, router_fine_b, exp_w_gate, exp_w_up, exp_w_down, final_norm_g):
    pts = _split_points()
    for l in range(DEPTH):
        h = rms_norm(x, mix_norm_g[l])
        (qa, ka, va, fa, ub, qc, kcm, vcm, ksl, vsl, kwn, vwn, gl) = jnp.split(h @ w_in[l], pts, axis=-1)
        o_a = fox_attention(qa, ka, va, fa, fox_forget_b[l])
        o_b = pool_mixer(ub, pool_w[l], pool_scale[l])
        o_c = nsa_attention(qc, kcm, vcm, ksl, vsl, kwn, vwn, gl, nsa_gate_b[l],
                            cmp_pe_k[l], cmp_pe_v[l], cmp_w1_k[l], cmp_w2_k[l], cmp_w1_v[l], cmp_w2_v[l])
        x = x + jnp.concatenate([o_a, o_b.astype(o_a.dtype), o_c], axis=-1) @ w_out[l]
        x = x + memory_cross_attention(rms_norm(x, xattn_norm_g[l]), rms_norm(mem, mem_norm_g[l]),
                                       xattn_wq[l], xattn_wk[l], xattn_wv[l], xattn_wo[l])
        x = x + hier_moe(rms_norm(x, ffn_norm_g[l]), router_coarse_w[l], router_coarse_b[l],
                         router_fine_w[l], router_fine_b[l], exp_w_gate[l], exp_w_up[l], exp_w_down[l])
    return rms_norm(x, final_norm_g)
```

```cpp
#include <hip/hip_runtime.h>
#include <hip/hip_cooperative_groups.h>
#include <cstdint>
#include <cstdio>
#include <cstring>
namespace cg = cooperative_groups;

#define LAS __attribute__((address_space(3)))
typedef unsigned short bf16_t;
typedef short bf16x8 __attribute__((ext_vector_type(8)));
typedef short s16x4 __attribute__((ext_vector_type(4)));
typedef float f32x16 __attribute__((ext_vector_type(16)));
typedef float f32x4 __attribute__((ext_vector_type(4)));
typedef float f32x2 __attribute__((ext_vector_type(2)));
typedef unsigned u32x4 __attribute__((ext_vector_type(4)));
typedef unsigned u32x2 __attribute__((ext_vector_type(2)));
typedef __bf16 bf16x2_t __attribute__((ext_vector_type(2)));

#define NTOK 16384
#define SEQ 4096
#define DM 1024
#define PW 2560
#define LOG2E 1.4426950408889634f

__device__ __forceinline__ unsigned cvtpk(float lo, float hi) { f32x2 v = {lo, hi}; bf16x2_t b = __builtin_convertvector(v, bf16x2_t); return __builtin_bit_cast(unsigned, b); }
__device__ __forceinline__ bf16_t f2bf(float x) { return (bf16_t)(cvtpk(x, 0.f) & 0xffffu); }
__device__ __forceinline__ float bf2f(bf16_t b) { return __uint_as_float(((unsigned)b) << 16); }
__device__ __forceinline__ int crow(int r, int hi) { return (r & 3) + 8 * (r >> 2) + 4 * hi; }
__device__ __forceinline__ float fexp2(float x) { return __builtin_amdgcn_exp2f(x); }
__device__ __forceinline__ int otid() { int t = threadIdx.x; asm volatile("" : "+v"(t)); return t; }
__device__ __forceinline__ float sigmoidf_(float x) { return 1.0f / (1.0f + __expf(-x)); }

struct TJob { const float* src; bf16_t* dst; long sbs, dbs; int K, N, lds, ldd, map, tpb, tile0, pad; };
#define NJOBS 15
struct Params {
  const float *x_in, *mem, *mix_g, *fox_b, *pool_w, *pool_scale, *pe_k, *pe_v, *w1k, *w1v, *gate_b;
  const float *xattn_g, *mem_g, *ffn_g, *rc_b, *rf_b, *final_g;
  float* xw;
  bf16_t *WinT, *WoutT, *WqT, *WkT, *WvT, *WoT, *WguT, *WdT, *W1T, *W2T, *WrT;
  float* bias1;
  bf16_t *hb, *P, *cat, *memn, *Kmem, *Vmem, *hid, *kvc, *qx, *ox, *he;
  float *fgl, *cum, *onsa, *tokw;
  int *mlist, *mcnt;
  unsigned* bar;
  TJob jobs[NJOBS];
  int ttiles; int never;
};

#define XB_TMO      128
#define XB_XCNT(j)  (256  + 64 * (j))
#define XB_XSUB(j)  (1280 + 64 * (j))
#define XB_XGEN(j)  (2304 + 64 * (j))
#define XB_TOP      3328
#define XB_TOPGEN   3392
#define XCD_BAR_WORDS 3456
#define XB_SPIN_CAP (1u << 22)
__device__ __forceinline__ unsigned xb_ld(unsigned* p)              { return __hip_atomic_load(p, __ATOMIC_RELAXED, __HIP_MEMORY_SCOPE_AGENT); }
__device__ __forceinline__ unsigned xb_add(unsigned* p, unsigned v) { return __hip_atomic_fetch_add(p, v, __ATOMIC_RELAXED, __HIP_MEMORY_SCOPE_AGENT); }
__device__ __forceinline__ unsigned xb_xcc_id() { return (unsigned)__builtin_amdgcn_s_getreg((3 << 11) | 20) & 0xFu; }
#define XB_SPIN(cond, bar) do { unsigned _sp = 0; while (cond) { __builtin_amdgcn_s_sleep(1); \
    if ((++_sp & 255u) == 0u) { if (xb_ld(&(bar)[XB_TMO])) break; if (_sp > XB_SPIN_CAP) { atomicAdd(&(bar)[XB_TMO], 1u); break; } } } } while (0)
struct XcdBarrier { unsigned* bar; unsigned x; volatile LAS unsigned* st; };
__device__ __forceinline__ XcdBarrier xcd_barrier_post(unsigned* bar, volatile LAS unsigned* st) {
    XcdBarrier b; b.bar = bar; b.x = xb_xcc_id(); b.st = st;
    if (threadIdx.x == 0) (void)xb_add(&bar[XB_XCNT(b.x)], 1u);
    return b;
}
__device__ __forceinline__ void xcd_barrier_complete(unsigned* bar, unsigned x, unsigned& nloc, unsigned& nx) {
    const unsigned G = gridDim.x * gridDim.y * gridDim.z;
    unsigned sum, cnt, mine, sp = 0u;
    for (;;) {
        sum = 0u; cnt = 0u; mine = 0u;
#pragma unroll
        for (unsigned j = 0; j < 16; ++j) { const unsigned c = xb_ld(&bar[XB_XCNT(j)]); sum += c; cnt += (c > 0u) ? 1u : 0u; mine = (j == x) ? c : mine; }
        if (sum == G) break;
        __builtin_amdgcn_s_sleep(1);
        if ((++sp & 255u) == 0u) { if (xb_ld(&bar[XB_TMO])) break; if (sp > XB_SPIN_CAP) { atomicAdd(&bar[XB_TMO], 1u); break; } }
    }
    nloc = mine > 0u ? mine : 1u; nx = cnt > 0u ? cnt : 1u;
}
__device__ __forceinline__ void xcd_barrier(const XcdBarrier& b) {
    asm volatile("s_waitcnt vmcnt(0)" ::: "memory");
    __syncthreads();
    if (threadIdx.x == 0) {
        unsigned* bar = b.bar;
        __builtin_amdgcn_s_waitcnt(0);
        unsigned nloc = b.st[0], nx = b.st[1];
        if (nloc == 0u) { xcd_barrier_complete(bar, b.x, nloc, nx); b.st[0] = nloc; b.st[1] = nx; }
        const unsigned old = xb_add(&bar[XB_XSUB(b.x)], 1u);
        const unsigned gen = old / nloc;
        if (old + 1u == (gen + 1u) * nloc) {
            __builtin_amdgcn_fence(__ATOMIC_RELEASE, "agent");
            asm volatile("s_waitcnt vmcnt(0)" ::: "memory");
            const unsigned og = xb_add(&bar[XB_TOP], 1u);
            const unsigned tg = og / nx;
            if (og + 1u == (tg + 1u) * nx) xb_add(&bar[XB_TOPGEN], 1u);
            else XB_SPIN(xb_ld(&bar[XB_TOPGEN]) == tg, bar);
            __builtin_amdgcn_fence(__ATOMIC_ACQUIRE, "agent");
            xb_add(&bar[XB_XGEN(b.x)], 1u);
            asm volatile("s_waitcnt vmcnt(0)" ::: "memory");
        } else {
            XB_SPIN(xb_ld(&bar[XB_XGEN(b.x)]) == gen, bar);
            __builtin_amdgcn_fence(__ATOMIC_ACQUIRE, "agent");
            asm volatile("s_waitcnt vmcnt(0)" ::: "memory");
        }
    }
    __syncthreads();
}

__device__ __forceinline__ int nmap(int map, int n) {
  if (map == 1) { if (n < 1152) return n; if (n < 1158) return 2560 + (n - 1152); if (n < 2566) return n - 6; return n; }
  if (map == 2) return 64 * (n >> 5) + (n & 31);
  if (map == 3) return 64 * (n >> 5) + 32 + (n & 31);
  return n;
}
__device__ __forceinline__ void transpose_tile(const TJob& j, int t, LAS char* sm) {
  const int tid = otid();
  const int tb = t / j.tpb, tt = t - tb * j.tpb;
  const int nkt = j.K >> 6;
  const int kt = tt % nkt, nt = tt / nkt;
  const float* src = j.src + (long)tb * j.sbs + (long)(kt * 64) * j.lds + nt * 64;
  bf16_t* dst = j.dst + (long)tb * j.dbs;
  LAS float* tile = (LAS float*)sm;
  {
    const int tk = tid >> 4, tn4 = tid & 15;
    const bool ok = (nt * 64 + tn4 * 4) < j.N;
#pragma unroll
    for (int i = 0; i < 4; ++i) {
      const int k = tk + 16 * i;
      f32x4 v = {0.f, 0.f, 0.f, 0.f};
      if (ok) v = *(const f32x4*)(src + (long)k * j.lds + tn4 * 4);
      tile[k * 65 + tn4 * 4 + 0] = v[0]; tile[k * 65 + tn4 * 4 + 1] = v[1]; tile[k * 65 + tn4 * 4 + 2] = v[2]; tile[k * 65 + tn4 * 4 + 3] = v[3];
    }
  }
  __syncthreads();
  {
    const int n = tid >> 2, kq = tid & 3, ng = nt * 64 + n;
    if (ng < j.N) {
      const int row = nmap(j.map, ng);
      unsigned w[8];
#pragma unroll
      for (int c = 0; c < 8; ++c) w[c] = cvtpk(tile[(kq * 16 + 2 * c) * 65 + n], tile[(kq * 16 + 2 * c + 1) * 65 + n]);
      bf16_t* d = dst + (long)row * j.ldd + kt * 64 + kq * 16;
      *(u32x4*)d = (u32x4){w[0], w[1], w[2], w[3]};
      *(u32x4*)(d + 8) = (u32x4){w[4], w[5], w[6], w[7]};
    }
  }
  __syncthreads();
}

template <bool F32OUT>
__device__ __forceinline__ void rownorm(const float* x, const float* g, void* out, int nrows) {
  const int tid = otid(); const int lane = tid & 63;
  const int gw = blockIdx.x * 4 + (tid >> 6), nw = gridDim.x * 4;
  for (int row = gw; row < nrows; row += nw) {
    const float* xr = x + (long)row * DM;
    f32x4 v[4]; float ss = 0.f;
#pragma unroll
    for (int i = 0; i < 4; ++i) { v[i] = *(const f32x4*)(xr + i * 256 + lane * 4); ss += v[i][0] * v[i][0] + v[i][1] * v[i][1] + v[i][2] * v[i][2] + v[i][3] * v[i][3]; }
#pragma unroll
    for (int o = 32; o >= 1; o >>= 1) ss += __shfl_xor(ss, o);
    const float rstd = 1.0f / sqrtf(ss * (1.0f / DM) + 1e-6f);
#pragma unroll
    for (int i = 0; i < 4; ++i) {
      const f32x4 gg = *(const f32x4*)(g + i * 256 + lane * 4);
      const f32x4 y = v[i] * rstd * gg;
      if (F32OUT) *(f32x4*)((float*)out + (long)row * DM + i * 256 + lane * 4) = y;
      else { u32x2 w; w.x = cvtpk(y[0], y[1]); w.y = cvtpk(y[2], y[3]); *(u32x2*)((bf16_t*)out + (long)row * DM + i * 256 + lane * 4) = w; }
    }
  }
}

struct RowDense { const bf16_t* base; long ld; long ks;
  __device__ __forceinline__ const bf16_t* rowptr(int r) const { return base + (long)r * ld; }
  __device__ __forceinline__ long koff(int kt) const { return (long)kt * ks; } };
struct RowGather { const bf16_t* base; long ld; LAS const int* toks;
  __device__ __forceinline__ const bf16_t* rowptr(int r) const { int t = toks[r]; t = t < 0 ? 0 : t; return base + (long)t * ld; }
  __device__ __forceinline__ long koff(int kt) const { return (long)kt * 64; } };
struct RowCmp { const bf16_t* base; int r0;
  __device__ __forceinline__ const bf16_t* rowptr(int r) const { const int R = r0 + r; const int bg = R >> 8; int c = R & 255; c = c > 254 ? 254 : c;
    return base + (long)((bg >> 1) * SEQ + 16 * c) * PW + (bg & 1) * 64; }
  __device__ __forceinline__ long koff(int kt) const { return (long)kt * PW; } };
struct RowSplit { const bf16_t* base; long ld; long delta;
  __device__ __forceinline__ const bf16_t* rowptr(int r) const { return base + (long)r * ld; }
  __device__ __forceinline__ long koff(int kt) const { return kt < 8 ? (long)kt * 64 : delta + (long)(kt - 8) * 64; } };
struct RowWrap64 { const bf16_t* base; long ld;
  __device__ __forceinline__ const bf16_t* rowptr(int r) const { return base + (long)(r & 63) * ld; }
  __device__ __forceinline__ long koff(int kt) const { return (long)kt * 64; } };

template <class AF, class BF, class EPI>
__device__ __forceinline__ void gemm_tile(LAS char* sm, int nkt, const AF& af, const BF& bfn, const EPI& epi) {
  const int tid = otid(), lane = tid & 63, wid = tid >> 6, wm = wid >> 1, wn = wid & 1, l31 = lane & 31, hh = lane >> 5;
  const int lrow = tid >> 3, lkc = tid & 7;
  const int wofs = lrow * 128 + ((lkc ^ ((lrow >> 1) & 7)) << 4);
  const bf16_t* ap[4]; const bf16_t* bp[4];
#pragma unroll
  for (int i = 0; i < 4; ++i) { ap[i] = af.rowptr(lrow + 32 * i) + lkc * 8; bp[i] = bfn.rowptr(lrow + 32 * i) + lkc * 8; }
  const int swz = (l31 >> 1) & 7;
  int koffs[4];
#pragma unroll
  for (int s = 0; s < 4; ++s) koffs[s] = (((2 * s + hh) ^ swz) << 4);
  const int arow = (wm * 64 + l31) * 128, brow = 16384 + (wn * 64 + l31) * 128;
  f32x16 acc[2][2];
#pragma unroll
  for (int i = 0; i < 2; ++i)
#pragma unroll
    for (int j = 0; j < 2; ++j)
#pragma unroll
      for (int r = 0; r < 16; ++r) acc[i][j][r] = 0.f;
  u32x4 ra[4], rb[4];
  { const long ka = af.koff(0), kb = bfn.koff(0);
#pragma unroll
    for (int i = 0; i < 4; ++i) { ra[i] = *(const u32x4*)(ap[i] + ka); rb[i] = *(const u32x4*)(bp[i] + kb); } }
#pragma unroll
  for (int i = 0; i < 4; ++i) { *(LAS u32x4*)(sm + wofs + i * 4096) = ra[i]; *(LAS u32x4*)(sm + 16384 + wofs + i * 4096) = rb[i]; }
  __syncthreads();
  for (int kt = 0; kt < nkt; ++kt) {
    const int cur = (kt & 1) * 32768;
    if (kt + 1 < nkt) { const long ka = af.koff(kt + 1), kb = bfn.koff(kt + 1);
#pragma unroll
      for (int i = 0; i < 4; ++i) { ra[i] = *(const u32x4*)(ap[i] + ka); rb[i] = *(const u32x4*)(bp[i] + kb); } }
#pragma unroll
    for (int s = 0; s < 4; ++s) {
      const bf16x8 a0 = *(LAS const bf16x8*)(sm + cur + arow + koffs[s]);
      const bf16x8 a1 = *(LAS const bf16x8*)(sm + cur + arow + 4096 + koffs[s]);
      const bf16x8 b0 = *(LAS const bf16x8*)(sm + cur + brow + koffs[s]);
      const bf16x8 b1 = *(LAS const bf16x8*)(sm + cur + brow + 4096 + koffs[s]);
      acc[0][0] = __builtin_amdgcn_mfma_f32_32x32x16_bf16(a0, b0, acc[0][0], 0, 0, 0);
      acc[0][1] = __builtin_amdgcn_mfma_f32_32x32x16_bf16(a0, b1, acc[0][1], 0, 0, 0);
      acc[1][0] = __builtin_amdgcn_mfma_f32_32x32x16_bf16(a1, b0, acc[1][0], 0, 0, 0);
      acc[1][1] = __builtin_amdgcn_mfma_f32_32x32x16_bf16(a1, b1, acc[1][1], 0, 0, 0);
    }
    if (kt + 1 < nkt) { const int nx = cur ^ 32768;
#pragma unroll
      for (int i = 0; i < 4; ++i) { *(LAS u32x4*)(sm + nx + wofs + i * 4096) = ra[i]; *(LAS u32x4*)(sm + nx + 16384 + wofs + i * 4096) = rb[i]; } }
    __syncthreads();
  }
  epi(acc, wm, wn, lane);
}

struct EpiInproj { bf16_t* P; float* fgl; int mt, nt;
  __device__ __forceinline__ void operator()(f32x16 (&acc)[2][2], int wm, int wn, int lane) const {
    const int l31 = lane & 31, hh = lane >> 5;
#pragma unroll
    for (int i = 0; i < 2; ++i)
#pragma unroll
      for (int j = 0; j < 2; ++j) {
        const int col = nt * 128 + wn * 64 + j * 32 + l31;
#pragma unroll
        for (int r = 0; r < 16; ++r) {
          const int row = mt * 128 + wm * 64 + i * 32 + crow(r, hh);
          if (nt < 20) P[(long)row * PW + col] = f2bf(acc[i][j][r]);
          else { const int c = col - 2560; if (c < 24) fgl[row * 32 + c] = acc[i][j][r]; }
        }
      }
  } };
struct EpiBf16 { bf16_t* out; long ld; int row0, col0;
  __device__ __forceinline__ void operator()(f32x16 (&acc)[2][2], int wm, int wn, int lane) const {
    const int l31 = lane & 31, hh = lane >> 5;
#pragma unroll
    for (int i = 0; i < 2; ++i)
#pragma unroll
      for (int j = 0; j < 2; ++j) {
        const int col = col0 + wn * 64 + j * 32 + l31;
#pragma unroll
        for (int r = 0; r < 16; ++r) { const int row = row0 + wm * 64 + i * 32 + crow(r, hh); out[(long)row * ld + col] = f2bf(acc[i][j][r]); }
      }
  } };
struct EpiResid { const float* base; float* out; int row0, col0;
  __device__ __forceinline__ void operator()(f32x16 (&acc)[2][2], int wm, int wn, int lane) const {
    const int l31 = lane & 31, hh = lane >> 5;
#pragma unroll
    for (int i = 0; i < 2; ++i)
#pragma unroll
      for (int j = 0; j < 2; ++j) {
        const int col = col0 + wn * 64 + j * 32 + l31;
#pragma unroll
        for (int r = 0; r < 16; ++r) { const long o = (long)(row0 + wm * 64 + i * 32 + crow(r, hh)) * DM + col; out[o] = base[o] + acc[i][j][r]; }
      }
  } };
__device__ __forceinline__ float gelu_tanh(float x) { const float u = 0.7978845608028654f * (x + 0.044715f * x * x * x); return 0.5f * x * (1.0f + tanhf(u)); }
struct EpiCmp1 { bf16_t* hid; const float* bias; int row0, col0;
  __device__ __forceinline__ void operator()(f32x16 (&acc)[2][2], int wm, int wn, int lane) const {
    const int l31 = lane & 31, hh = lane >> 5;
#pragma unroll
    for (int i = 0; i < 2; ++i)
#pragma unroll
      for (int j = 0; j < 2; ++j) {
        const int col = col0 + wn * 64 + j * 32 + l31; const float bv = bias[col];
#pragma unroll
        for (int r = 0; r < 16; ++r) { const int row = row0 + wm * 64 + i * 32 + crow(r, hh); hid[(long)row * 256 + col] = f2bf(gelu_tanh(acc[i][j][r] + bv)); }
      }
  } };
struct EpiCmp2 { bf16_t* out; int row0;
  __device__ __forceinline__ void operator()(f32x16 (&acc)[2][2], int wm, int wn, int lane) const {
    const int l31 = lane & 31, hh = lane >> 5;
    if (wn != 0) return;
#pragma unroll
    for (int i = 0; i < 2; ++i)
#pragma unroll
      for (int j = 0; j < 2; ++j) {
        const int col = j * 32 + l31;
#pragma unroll
        for (int r = 0; r < 16; ++r) { const int row = row0 + wm * 64 + i * 32 + crow(r, hh); out[(long)row * 64 + col] = ((row & 255) == 255) ? (bf16_t)0 : f2bf(acc[i][j][r]); }
      }
  } };
struct EpiMoeUp { bf16_t* he; long herow0; int hcol0; LAS const float* wts;
  __device__ __forceinline__ void operator()(f32x16 (&acc)[2][2], int wm, int wn, int lane) const {
    const int l31 = lane & 31, hh = lane >> 5;
    const int col = hcol0 + wn * 32 + l31;
#pragma unroll
    for (int i = 0; i < 2; ++i)
#pragma unroll
      for (int r = 0; r < 16; ++r) {
        const int rl = wm * 64 + i * 32 + crow(r, hh);
        const float gte = acc[i][0][r], up = acc[i][1][r];
        const float v = gte * sigmoidf_(gte) * up * wts[rl];
        he[(herow0 + rl) * DM + col] = f2bf(v);
      }
  } };
struct EpiMoeDown { float* x; int col0; LAS const int* toks;
  __device__ __forceinline__ void operator()(f32x16 (&acc)[2][2], int wm, int wn, int lane) const {
    const int l31 = lane & 31, hh = lane >> 5;
#pragma unroll
    for (int i = 0; i < 2; ++i)
#pragma unroll
      for (int r = 0; r < 16; ++r) {
        const int rl = wm * 64 + i * 32 + crow(r, hh);
        const int tok = toks[rl];
        if (tok >= 0) {
#pragma unroll
          for (int j = 0; j < 2; ++j) { const long o = (long)tok * DM + col0 + wn * 64 + j * 32 + l31; x[o] += acc[i][j][r]; }
        }
      }
  } };
struct EpiRouter { LAS float* lg;
  __device__ __forceinline__ void operator()(f32x16 (&acc)[2][2], int wm, int wn, int lane) const {
    const int l31 = lane & 31, hh = lane >> 5;
    if (wn == 0 && l31 < 20) {
#pragma unroll
      for (int i = 0; i < 2; ++i)
#pragma unroll
        for (int r = 0; r < 16; ++r) lg[(wm * 64 + i * 32 + crow(r, hh)) * 20 + l31] = acc[i][0][r];
    }
  } };

template <int NKS> __device__ __forceinline__ int kswz(int kc, int row) {
  if (NKS == 4) return kc ^ ((row >> 1) & 7);
  return (kc & 16) | ((kc & 15) ^ (row & 15));
}
template <int NKS, int NDT, class SM>
__device__ __forceinline__ void flash_step(const bf16x8* qf, LAS const char* Ks, LAS const char* Vs, float& m, float& l, f32x16* O, const SM& smod, int kv0, int lane) {
  const int l31 = lane & 31, hh = lane >> 5;
  f32x16 p0, p1;
#pragma unroll
  for (int r = 0; r < 16; ++r) { p0[r] = 0.f; p1[r] = 0.f; }
#pragma unroll
  for (int ds = 0; ds < NKS; ++ds) {
    const int so = kswz<NKS>(2 * ds + hh, l31) << 4;
    const bf16x8 k0 = *(LAS const bf16x8*)(Ks + l31 * (NKS * 32) + so);
    const bf16x8 k1 = *(LAS const bf16x8*)(Ks + (32 + l31) * (NKS * 32) + so);
    p0 = __builtin_amdgcn_mfma_f32_32x32x16_bf16(k0, qf[ds], p0, 0, 0, 0);
    p1 = __builtin_amdgcn_mfma_f32_32x32x16_bf16(k1, qf[ds], p1, 0, 0, 0);
  }
  smod.apply(p0, p1, kv0, lane);
  float mx = p0[0];
#pragma unroll
  for (int r = 1; r < 16; ++r) mx = fmaxf(mx, p0[r]);
#pragma unroll
  for (int r = 0; r < 16; ++r) mx = fmaxf(mx, p1[r]);
  mx = fmaxf(mx, __shfl_xor(mx, 32));
  const float mn = fmaxf(m, mx);
  const float mu = (mn == -INFINITY) ? 0.f : mn;
  const float alpha = fexp2(m - mu);
  float rs = 0.f;
#pragma unroll
  for (int r = 0; r < 16; ++r) { p0[r] = fexp2(p0[r] - mu); rs += p0[r]; }
#pragma unroll
  for (int r = 0; r < 16; ++r) { p1[r] = fexp2(p1[r] - mu); rs += p1[r]; }
  l = l * alpha + rs; m = mn;
#pragma unroll
  for (int dt = 0; dt < NDT; ++dt)
#pragma unroll
    for (int r = 0; r < 16; ++r) O[dt][r] *= alpha;
  bf16x8 pb[4];
  { u32x4 w;
    w = (u32x4){cvtpk(p0[0], p0[1]), cvtpk(p0[2], p0[3]), cvtpk(p0[4], p0[5]), cvtpk(p0[6], p0[7])}; pb[0] = __builtin_bit_cast(bf16x8, w);
    w = (u32x4){cvtpk(p0[8], p0[9]), cvtpk(p0[10], p0[11]), cvtpk(p0[12], p0[13]), cvtpk(p0[14], p0[15])}; pb[1] = __builtin_bit_cast(bf16x8, w);
    w = (u32x4){cvtpk(p1[0], p1[1]), cvtpk(p1[2], p1[3]), cvtpk(p1[4], p1[5]), cvtpk(p1[6], p1[7])}; pb[2] = __builtin_bit_cast(bf16x8, w);
    w = (u32x4){cvtpk(p1[8], p1[9]), cvtpk(p1[10], p1[11]), cvtpk(p1[12], p1[13]), cvtpk(p1[14], p1[15])}; pb[3] = __builtin_bit_cast(bf16x8, w); }
  const int vlane = (4 * hh + ((lane & 15) >> 2)) * 64 + (((lane >> 4) & 1) * 16 + (lane & 3) * 4) * 2;
#pragma unroll
  for (int dt = 0; dt < NDT; ++dt)
#pragma unroll
    for (int ks = 0; ks < 4; ++ks) {
      LAS const char* vp = Vs + dt * 4096 + ks * 16 * 64 + vlane;
      const s16x4 lo = __builtin_amdgcn_ds_read_tr16_b64_v4i16((LAS s16x4*)vp);
      const s16x4 hi = __builtin_amdgcn_ds_read_tr16_b64_v4i16((LAS s16x4*)(vp + 8 * 64));
      const bf16x8 vf = (bf16x8){lo[0], lo[1], lo[2], lo[3], hi[0], hi[1], hi[2], hi[3]};
      O[dt] = __builtin_amdgcn_mfma_f32_32x32x16_bf16(vf, pb[ks], O[dt], 0, 0, 0);
    }
}

template <int NKS, int NDT>
struct TileRegs { u32x4 k[NKS / 2]; u32x4 v[NDT]; };
template <int NKS, int NDT>
__device__ __forceinline__ void tile_load(TileRegs<NKS, NDT>& t, const bf16_t* Kb, long ldk, const bf16_t* Vb, long ldv, int kv0) {
  const int tid = otid();
#pragma unroll
  for (int i = 0; i < NKS / 2; ++i) { const int p = tid + 256 * i; const int row = p / (NKS * 2), kc = p % (NKS * 2);
    t.k[i] = *(const u32x4*)(Kb + (long)(kv0 + row) * ldk + kc * 8); }
#pragma unroll
  for (int i = 0; i < NDT; ++i) { const int p = tid + 256 * i; const int kv = (p & 255) >> 2, cp = (p >> 8) * 4 + (p & 3);
    t.v[i] = *(const u32x4*)(Vb + (long)(kv0 + kv) * ldv + cp * 8); }
}
template <int NKS, int NDT>
__device__ __forceinline__ void tile_store(const TileRegs<NKS, NDT>& t, LAS char* Ks, LAS char* Vs) {
  const int tid = otid();
#pragma unroll
  for (int i = 0; i < NKS / 2; ++i) { const int p = tid + 256 * i; const int row = p / (NKS * 2), kc = p % (NKS * 2);
    *(LAS u32x4*)(Ks + row * (NKS * 32) + (kswz<NKS>(kc, row) << 4)) = t.k[i]; }
#pragma unroll
  for (int i = 0; i < NDT; ++i) { const int p = tid + 256 * i; *(LAS u32x4*)(Vs + p * 16) = t.v[i]; }
}
struct TLRange { int n, kv_first; __device__ __forceinline__ int count() const { return n; } __device__ __forceinline__ int kv0(int i) const { return kv_first + 64 * i; } };
struct TLList { int n; LAS const int* lst; __device__ __forceinline__ int count() const { return n; } __device__ __forceinline__ int kv0(int i) const { return lst[i]; } };

template <int NKS, int NDT, bool PF, class SM, class TL>
__device__ __forceinline__ void flash_run(LAS char* Ks, LAS char* Vs, const bf16x8* qf, const bf16_t* Kb, long ldk, const bf16_t* Vb, long ldv,
                                          const TL& tl, const SM& smod, float& m, float& l, f32x16* O) {
  const int n = tl.count(); const int lane = otid() & 63;
  if (n <= 0) return;
  TileRegs<NKS, NDT> t;
  if (PF) tile_load<NKS, NDT>(t, Kb, ldk, Vb, ldv, tl.kv0(0));
  for (int it = 0; it < n; ++it) {
    const int kvc = tl.kv0(it);
    __syncthreads();
    if (!PF) tile_load<NKS, NDT>(t, Kb, ldk, Vb, ldv, kvc);
    tile_store<NKS, NDT>(t, Ks, Vs);
    __syncthreads();
    if (PF && it + 1 < n) tile_load<NKS, NDT>(t, Kb, ldk, Vb, ldv, tl.kv0(it + 1));
    flash_step<NKS, NDT, SM>(qf, Ks, Vs, m, l, O, smod, kvc, lane);
  }
}

struct SMFox { float cq; const float* ck; int tq;
  __device__ __forceinline__ void apply(f32x16& p0, f32x16& p1, int kv0, int lane) const {
    const int hh = lane >> 5; const float C = 0.125f * LOG2E;
    const int db = tq - kv0 - 4 * hh;
    const float* cp = ck + kv0 + 4 * hh;
#pragma unroll
    for (int a = 0; a < 4; ++a) {
      const f32x4 c0 = *(const f32x4*)(cp + 8 * a);
      const f32x4 c1 = *(const f32x4*)(cp + 32 + 8 * a);
#pragma unroll
      for (int e = 0; e < 4; ++e) {
        const int c = 8 * a + e;
        p0[4 * a + e] = (db >= c) ? __builtin_fmaf(p0[4 * a + e], C, cq - c0[e]) : -INFINITY;
        p1[4 * a + e] = (db >= c + 32) ? __builtin_fmaf(p1[4 * a + e], C, cq - c1[e]) : -INFINITY;
      }
    }
  } };
struct SMWin { int tq; float slope2;
  __device__ __forceinline__ void apply(f32x16& p0, f32x16& p1, int kv0, int lane) const {
    const int hh = lane >> 5; const float C = 0.125f * LOG2E;
    const int db = tq - kv0 - 4 * hh; const float sb = -slope2 * (float)db;
#pragma unroll
    for (int r = 0; r < 16; ++r) {
      const int c = (r & 3) + 8 * (r >> 2);
      const int d0 = db - c, d1 = db - c - 32;
      p0[r] = (d0 >= 0 && d0 < 512) ? __builtin_fmaf(p0[r], C, __builtin_fmaf(slope2, (float)c, sb)) : -INFINITY;
      p1[r] = (d1 >= 0 && d1 < 512) ? __builtin_fmaf(p1[r], C, __builtin_fmaf(slope2, (float)(c + 32), sb)) : -INFINITY;
    }
  } };
struct SMSel { int tq; float slope2; unsigned mlo, mhi;
  __device__ __forceinline__ void apply(f32x16& p0, f32x16& p1, int kv0, int lane) const {
    const int hh = lane >> 5; const float C = 0.125f * LOG2E;
    const int j = kv0 >> 6;
    const bool sel = ((j < 32 ? (mlo >> j) : (mhi >> (j - 32))) & 1u) != 0u;
    const int db = sel ? (tq - kv0 - 4 * hh) : -1; const float sb = -slope2 * (float)db;
#pragma unroll
    for (int r = 0; r < 16; ++r) {
      const int c = (r & 3) + 8 * (r >> 2);
      p0[r] = (db >= c) ? __builtin_fmaf(p0[r], C, __builtin_fmaf(slope2, (float)c, sb)) : -INFINITY;
      p1[r] = (db >= c + 32) ? __builtin_fmaf(p1[r], C, __builtin_fmaf(slope2, (float)(c + 32), sb)) : -INFINITY;
    }
  } };
struct SMCmp { int tq; float slope2;
  __device__ __forceinline__ void apply(f32x16& p0, f32x16& p1, int kv0, int lane) const {
    const int hh = lane >> 5; const float C = 0.125f * LOG2E;
    const int db = tq - 31 - 16 * kv0 - 64 * hh; const float sb = -slope2 * (float)db;
#pragma unroll
    for (int r = 0; r < 16; ++r) {
      const int c = 16 * ((r & 3) + 8 * (r >> 2));
      p0[r] = (db >= c) ? __builtin_fmaf(p0[r], C, __builtin_fmaf(slope2, (float)c, sb)) : -INFINITY;
      p1[r] = (db >= c + 512) ? __builtin_fmaf(p1[r], C, __builtin_fmaf(slope2, (float)(c + 512), sb)) : -INFINITY;
    }
  } };
struct SMNone { float C;
  __device__ __forceinline__ void apply(f32x16& p0, f32x16& p1, int kv0, int lane) const {
#pragma unroll
    for (int r = 0; r < 16; ++r) { p0[r] *= C; p1[r] *= C; }
  } };

__device__ __forceinline__ void fox_unit(const Params& p, int b, int h, int qb, LAS char* sm) {
  const int tid = otid(), lane = tid & 63, w = tid >> 6, l31 = lane & 31, hh = lane >> 5;
  const int tq = qb * 128 + w * 32 + l31; const long tok = (long)b * SEQ + tq;
  const bf16_t* Pb = p.P + (long)b * SEQ * PW;
  bf16x8 qf[4];
#pragma unroll
  for (int ds = 0; ds < 4; ++ds) qf[ds] = *(const bf16x8*)(p.P + tok * PW + h * 64 + ds * 16 + hh * 8);
  const float* ck = p.cum + (long)(b * 6 + h) * SEQ;
  SMFox smod; smod.cq = ck[tq]; smod.ck = ck; smod.tq = tq;
  float m = -INFINITY, l = 0.f; f32x16 O[2];
#pragma unroll
  for (int r = 0; r < 16; ++r) { O[0][r] = 0.f; O[1][r] = 0.f; }
  TLRange tl; tl.n = 2 * qb + 2; tl.kv_first = 0;
  flash_run<4, 2, true>(sm, sm + 8192, qf, Pb + 384 + h * 64, PW, Pb + 768 + h * 64, PW, tl, smod, m, l, O);
  const float lt = l + __shfl_xor(l, 32); const float inv = lt > 0.f ? 1.0f / lt : 0.f;
  bf16_t* op = p.cat + tok * DM + h * 64;
#pragma unroll
  for (int dt = 0; dt < 2; ++dt)
#pragma unroll
    for (int a = 0; a < 4; ++a) { u32x2 wv; wv.x = cvtpk(O[dt][4 * a] * inv, O[dt][4 * a + 1] * inv); wv.y = cvtpk(O[dt][4 * a + 2] * inv, O[dt][4 * a + 3] * inv);
      *(u32x2*)(op + dt * 32 + 8 * a + 4 * hh) = wv; }
}

__device__ __forceinline__ void xattn_unit(const Params& p, int layer, int b, int hd, int qb, int dh, LAS char* sm) {
  const int tid = otid(), lane = tid & 63, w = tid >> 6, l31 = lane & 31, hh = lane >> 5;
  const int tq = qb * 128 + w * 32 + l31; const long tok = (long)b * SEQ + tq;
  bf16x8 qf[16];
#pragma unroll
  for (int ds = 0; ds < 16; ++ds) qf[ds] = *(const bf16x8*)(p.qx + tok * DM + hd * 256 + ds * 16 + hh * 8);
  SMNone smod; smod.C = 0.0625f * LOG2E;
  float m = -INFINITY, l = 0.f; f32x16 O[4];
#pragma unroll
  for (int dt = 0; dt < 4; ++dt)
#pragma unroll
    for (int r = 0; r < 16; ++r) O[dt][r] = 0.f;
  TLRange tl; tl.n = 4; tl.kv_first = 0;
  const bf16_t* Kb = p.Kmem + ((long)layer * 1024 + b * 256) * DM + hd * 256;
  const bf16_t* Vb = p.Vmem + ((long)layer * 1024 + b * 256) * DM + hd * 256 + dh * 128;
  flash_run<16, 4, false>(sm, sm + 32768, qf, Kb, DM, Vb, DM, tl, smod, m, l, O);
  const float lt = l + __shfl_xor(l, 32); const float inv = 1.0f / lt;
  bf16_t* op = p.ox + tok * DM + hd * 256 + dh * 128;
#pragma unroll
  for (int dt = 0; dt < 4; ++dt)
#pragma unroll
    for (int a = 0; a < 4; ++a) { u32x2 wv; wv.x = cvtpk(O[dt][4 * a] * inv, O[dt][4 * a + 1] * inv); wv.y = cvtpk(O[dt][4 * a + 2] * inv, O[dt][4 * a + 3] * inv);
      *(u32x2*)(op + dt * 32 + 8 * a + 4 * hh) = wv; }
}

#define NSA_SC 16384
#define NSA_UNI 49664
#define NSA_TL 49680
__device__ __forceinline__ void nsa_unit(const Params& p, int layer, int b, int g, int qb, LAS char* sm) {
  const int tid = otid(), lane = tid & 63, w = tid >> 6, l31 = lane & 31, hh = lane >> 5;
  const int tq = qb * 128 + w * 32 + l31; const long tok = (long)b * SEQ + tq;
  const bf16_t* Pb = p.P + (long)b * SEQ * PW;
  LAS char* Ks = sm; LAS char* Vs = sm + 8192;
  LAS float* sc = (LAS float*)(sm + NSA_SC);
  LAS unsigned* uni = (LAS unsigned*)(sm + NSA_UNI);
  LAS int* tll = (LAS int*)(sm + NSA_TL);
  const bf16_t* kcb = p.kvc + (long)(0 * 8 + b * 2 + g) * 256 * 64;
  const bf16_t* vcb = p.kvc + (long)(1 * 8 + b * 2 + g) * 256 * 64;
  const int ntc = min(4, (8 * qb + 6) / 64 + 1);
  LAS float* myrow = sc + (w * 32 + l31) * 65;
  __syncthreads();
#pragma unroll
  for (int i = 0; i < 32; ++i) myrow[2 * i + hh] = 0.f;
  const float* glp = p.fgl + tok * 32 + 6;
  const float* gbp = p.gate_b + layer * 18;
#pragma unroll 1
  for (int r3 = 0; r3 < 3; ++r3) {
    const int head = 3 * g + r3;
    const float slope2 = exp2f(-8.0f * (float)(head + 1) / 6.0f) * LOG2E;
    bf16x8 qf[4];
#pragma unroll
    for (int ds = 0; ds < 4; ++ds) qf[ds] = *(const bf16x8*)(p.P + tok * PW + 1408 + head * 64 + ds * 16 + hh * 8);
    SMCmp smod; smod.tq = tq; smod.slope2 = slope2;
    float m = -INFINITY, l = 0.f; f32x16 O[2];
#pragma unroll
    for (int r = 0; r < 16; ++r) { O[0][r] = 0.f; O[1][r] = 0.f; }
    TLRange tl; tl.n = ntc; tl.kv_first = 0;
    flash_run<4, 2, true>(Ks, Vs, qf, kcb, 64, vcb, 64, tl, smod, m, l, O);
    const float lt = l + __shfl_xor(l, 32); const float inv = lt > 0.f ? 1.0f / lt : 0.f;
    const float gc = sigmoidf_(glp[head * 3 + 0] + gbp[head * 3 + 0]) * inv;
    float* ob = p.onsa + tok * 384 + head * 64;
#pragma unroll
    for (int dt = 0; dt < 2; ++dt)
#pragma unroll
      for (int a = 0; a < 4; ++a) *(f32x4*)(ob + dt * 32 + 8 * a + 4 * hh) = (f32x4){O[dt][4 * a] * gc, O[dt][4 * a + 1] * gc, O[dt][4 * a + 2] * gc, O[dt][4 * a + 3] * gc};
    const float mu = (m == -INFINITY) ? 0.f : m;
    float e_prev = 0.f;
#pragma unroll
    for (int it = 0; it < 4; ++it) {
      if (it < ntc) {
        __syncthreads();
        { const int pp = tid, pp2 = tid + 256;
          const u32x4 k0 = *(const u32x4*)(kcb + (long)(64 * it + (pp >> 3)) * 64 + (pp & 7) * 8);
          const u32x4 k1 = *(const u32x4*)(kcb + (long)(64 * it + (pp2 >> 3)) * 64 + (pp2 & 7) * 8);
          *(LAS u32x4*)(Ks + (pp >> 3) * 128 + (kswz<4>(pp & 7, pp >> 3) << 4)) = k0;
          *(LAS u32x4*)(Ks + (pp2 >> 3) * 128 + (kswz<4>(pp2 & 7, pp2 >> 3) << 4)) = k1; }
        __syncthreads();
        f32x16 p0, p1;
#pragma unroll
        for (int r = 0; r < 16; ++r) { p0[r] = 0.f; p1[r] = 0.f; }
#pragma unroll
        for (int ds = 0; ds < 4; ++ds) {
          const int so = kswz<4>(2 * ds + hh, l31) << 4;
          const bf16x8 k0 = *(LAS const bf16x8*)(Ks + l31 * 128 + so);
          const bf16x8 k1 = *(LAS const bf16x8*)(Ks + (32 + l31) * 128 + so);
          p0 = __builtin_amdgcn_mfma_f32_32x32x16_bf16(k0, qf[ds], p0, 0, 0, 0);
          p1 = __builtin_amdgcn_mfma_f32_32x32x16_bf16(k1, qf[ds], p1, 0, 0, 0);
        }
        smod.apply(p0, p1, 64 * it, lane);
#pragma unroll
        for (int r = 0; r < 16; ++r) { p0[r] = fexp2(p0[r] - mu) * inv; p1[r] = fexp2(p1[r] - mu) * inv; }
#pragma unroll
        for (int pi = 0; pi < 2; ++pi)
#pragma unroll
          for (int a = 0; a < 4; ++a) {
            const float q0 = pi ? p1[4 * a] : p0[4 * a], q1 = pi ? p1[4 * a + 1] : p0[4 * a + 1], q2 = pi ? p1[4 * a + 2] : p0[4 * a + 2], q3 = pi ? p1[4 * a + 3] : p0[4 * a + 3];
            const float ex = __shfl_xor(q3, 32);
            myrow[2 * (8 * it + 4 * pi + a) + hh] += (q0 + q1) + (q2 + q3) + (hh ? ex : e_prev);
            e_prev = ex;
          }
      }
    }
  }
  __syncthreads();
  {
    const int cur = tq >> 6;
#pragma unroll
    for (int mi = 0; mi < 32; ++mi) {
      const int j = 2 * mi + hh;
      const bool forced = (j == 0) || (j == cur) || (j == cur - 1);
      const float iv = myrow[j];
      myrow[j] = forced ? 1.0e4f : (j <= cur ? iv : -1.0f);
    }
    if (tid < 2) uni[tid] = 0u;
  }
  __syncthreads();
  unsigned mlo = 0u, mhi = 0u;
  if (hh == 0) {
    LAS float* row = sc + (w * 32 + l31) * 65;
    for (int itk = 0; itk < 16; ++itk) {
      float best = -INFINITY; int bi = 0;
      for (int j = 0; j < 64; ++j) { const float v = row[j]; if (v > best) { best = v; bi = j; } }
      row[bi] = -INFINITY;
      if (bi < 32) mlo |= (1u << bi); else mhi |= (1u << (bi - 32));
    }
    __hip_atomic_fetch_or(uni, mlo, __ATOMIC_RELAXED, __HIP_MEMORY_SCOPE_WORKGROUP); __hip_atomic_fetch_or(uni + 1, mhi, __ATOMIC_RELAXED, __HIP_MEMORY_SCOPE_WORKGROUP);
  }
  mlo = __shfl(mlo, l31); mhi = __shfl(mhi, l31);
  __syncthreads();
  if (tid == 0) {
    unsigned long long u = ((unsigned long long)uni[1] << 32) | (unsigned long long)uni[0];
    const int jmax = (qb * 128 + 127) >> 6;
    int n = 0;
    for (int j = 0; j <= jmax; ++j) if ((u >> j) & 1ull) tll[1 + n++] = 64 * j;
    tll[0] = n;
  }
  __syncthreads();
  const int nsel = tll[0];
#pragma unroll 1
  for (int r3 = 0; r3 < 3; ++r3) {
    const int head = 3 * g + r3;
    const float slope2 = exp2f(-8.0f * (float)(head + 1) / 6.0f) * LOG2E;
    bf16x8 qf[4];
#pragma unroll
    for (int ds = 0; ds < 4; ++ds) qf[ds] = *(const bf16x8*)(p.P + tok * PW + 1408 + head * 64 + ds * 16 + hh * 8);
    {
      SMSel smod; smod.tq = tq; smod.slope2 = slope2; smod.mlo = mlo; smod.mhi = mhi;
      float m = -INFINITY, l = 0.f; f32x16 O[2];
#pragma unroll
      for (int r = 0; r < 16; ++r) { O[0][r] = 0.f; O[1][r] = 0.f; }
      TLList tl; tl.n = nsel; tl.lst = tll + 1;
      flash_run<4, 2, true>(Ks, Vs, qf, Pb + 2048 + g * 64, PW, Pb + 2176 + g * 64, PW, tl, smod, m, l, O);
      const float lt = l + __shfl_xor(l, 32); const float inv = lt > 0.f ? 1.0f / lt : 0.f;
      const float gs = sigmoidf_(glp[head * 3 + 1] + gbp[head * 3 + 1]) * inv;
      float* ob = p.onsa + tok * 384 + head * 64;
#pragma unroll
      for (int dt = 0; dt < 2; ++dt)
#pragma unroll
        for (int a = 0; a < 4; ++a) { f32x4 oc = *(const f32x4*)(ob + dt * 32 + 8 * a + 4 * hh);
          oc[0] += O[dt][4 * a] * gs; oc[1] += O[dt][4 * a + 1] * gs; oc[2] += O[dt][4 * a + 2] * gs; oc[3] += O[dt][4 * a + 3] * gs;
          *(f32x4*)(ob + dt * 32 + 8 * a + 4 * hh) = oc; }
    }
    {
      SMWin smod; smod.tq = tq; smod.slope2 = slope2;
      float m = -INFINITY, l = 0.f; f32x16 O[2];
#pragma unroll
      for (int r = 0; r < 16; ++r) { O[0][r] = 0.f; O[1][r] = 0.f; }
      const int kvf = max(0, qb * 128 - 512);
      TLRange tl; tl.kv_first = kvf; tl.n = (qb * 128 + 128 - kvf) >> 6;
      flash_run<4, 2, true>(Ks, Vs, qf, Pb + 2304 + g * 64, PW, Pb + 2432 + g * 64, PW, tl, smod, m, l, O);
      const float lt = l + __shfl_xor(l, 32); const float inv = lt > 0.f ? 1.0f / lt : 0.f;
      const float gw = sigmoidf_(glp[head * 3 + 2] + gbp[head * 3 + 2]) * inv;
      const float* ob = p.onsa + tok * 384 + head * 64;
      bf16_t* op = p.cat + tok * DM + 640 + head * 64;
#pragma unroll
      for (int dt = 0; dt < 2; ++dt)
#pragma unroll
        for (int a = 0; a < 4; ++a) {
          const f32x4 oc = *(const f32x4*)(ob + dt * 32 + 8 * a + 4 * hh);
          u32x2 wv; wv.x = cvtpk(O[dt][4 * a] * gw + oc[0], O[dt][4 * a + 1] * gw + oc[1]); wv.y = cvtpk(O[dt][4 * a + 2] * gw + oc[2], O[dt][4 * a + 3] * gw + oc[3]);
          *(u32x2*)(op + dt * 32 + 8 * a + 4 * hh) = wv;
        }
    }
  }
  __syncthreads();
}

__device__ __forceinline__ void pool_unit(const Params& p, int layer, int b, int tb, int g, LAS char* sm) {
  const int tid = otid();
  LAS float* u = (LAS float*)sm;
  LAS float* W = (LAS float*)(sm + 20480);
  LAS float* pl = (LAS float*)(sm + 36864);
  const int t0 = tb * 64;
  const int wsz = 2 << g;
  __syncthreads();
  for (int i = tid; i < 79 * 64; i += 256) { const int rr = i >> 6, c = i & 63; const int t = t0 - 15 + rr;
    u[i] = (t >= 0) ? bf2f(p.P[((long)b * SEQ + t) * PW + 1152 + g * 64 + c]) : 0.f; }
  for (int i = tid; i < 4096; i += 256) W[i] = p.pool_w[((long)layer * 4 + g) * 4096 + i];
  __syncthreads();
  for (int i = tid; i < 4096; i += 256) { const int tl = i >> 6, c = i & 63; const int t = t0 + tl;
    float s = 0.f; for (int k = 0; k < wsz; ++k) s += u[(tl + 15 - k) * 64 + c];
    const float cnt = (float)min(t + 1, wsz);
    pl[i] = s / cnt - u[(tl + 15) * 64 + c]; }
  __syncthreads();
  { const int d = tid & 63, tg = tid >> 6;
    const float scl = p.pool_scale[layer * 256 + g * 64 + d];
    float o[16];
#pragma unroll
    for (int i = 0; i < 16; ++i) o[i] = 0.f;
    for (int c = 0; c < 64; ++c) { const float wv = W[c * 64 + d];
#pragma unroll
      for (int i = 0; i < 16; ++i) o[i] += pl[(tg * 16 + i) * 64 + c] * wv; }
#pragma unroll
    for (int i = 0; i < 16; ++i) p.cat[((long)b * SEQ + t0 + tg * 16 + i) * DM + 384 + g * 64 + d] = f2bf(o[i] * scl); }
}

__device__ __forceinline__ void cum_unit(const Params& p, int layer, int b, int h, LAS char* sm) {
  const int tid = otid();
  LAS float* part = (LAS float*)sm;
  const float bf = p.fox_b[layer * 6 + h];
  float v[16]; float s = 0.f;
#pragma unroll
  for (int i = 0; i < 16; ++i) { const int t = tid * 16 + i; const float z = p.fgl[((long)b * SEQ + t) * 32 + h] + bf;
    const float ls = fminf(z, 0.f) - log1pf(__expf(-fabsf(z))); s += ls; v[i] = s; }
  __syncthreads();
  part[tid] = s;
  __syncthreads();
  if (tid == 0) { float a = 0.f; for (int i = 0; i < 256; ++i) { const float t = part[i]; part[i] = a; a += t; } }
  __syncthreads();
  const float base = part[tid];
#pragma unroll
  for (int i = 0; i < 16; ++i) p.cum[(long)(b * 6 + h) * SEQ + tid * 16 + i] = (base + v[i]) * LOG2E;
  __syncthreads();
}

#define GSYNC() xcd_barrier(xb)
#ifndef SKIPMASK
#define SKIPMASK 0
#endif
#define PH(n) if (!((SKIPMASK >> (n)) & 1))
__global__ void __launch_bounds__(256, 2) fwd_kernel(Params p) {
  __shared__ __attribute__((aligned(16))) char smem_raw[65536];
  __shared__ uint4 xb_words;
  __shared__ __attribute__((aligned(16))) int xs_raw[320];
  LAS char* sm = (LAS char*)smem_raw;
  LAS int* xs = (LAS int*)xs_raw;
  const int tid = otid(); const int bid = blockIdx.x, nb = gridDim.x;
  if (p.never) cg::this_grid().sync();
  if (tid == 0) xb_words = make_uint4(0u, 0u, 0u, 0u);
  __syncthreads();
  XcdBarrier xb = xcd_barrier_post(p.bar, (volatile LAS unsigned*)&xb_words);

  PH(0) for (int t = bid; t < p.ttiles; t += nb) {
    int ji = 0;
#pragma unroll
    for (int q = 1; q < NJOBS; ++q) if (t >= p.jobs[q].tile0) ji = q;
    transpose_tile(p.jobs[ji], t - p.jobs[ji].tile0, sm);
  }
  PH(1) {
    const long gt = (long)bid * 256 + tid, gs = (long)nb * 256;
    for (long i = gt; i < 2L * 104 * 1024 / 8; i += gs) { const long l = i / (104 * 128), rem = i % (104 * 128); *(u32x4*)(p.WinT + (l * 2688 + 2584) * 1024 + rem * 8) = (u32x4){0u, 0u, 0u, 0u}; }
    for (long i = gt; i < 2L * 108 * 1024 / 8; i += gs) { const long l = i / (108 * 128), rem = i % (108 * 128); *(u32x4*)(p.WrT + (l * 128 + 20) * 1024 + rem * 8) = (u32x4){0u, 0u, 0u, 0u}; }
    if (gt < 64) p.mcnt[gt] = 0;
    if (gt < 1024) { const int l = (int)(gt >> 9), kv = (int)((gt >> 8) & 1), n = (int)(gt & 255);
      const float* pe = (kv ? p.pe_v : p.pe_k) + l * 2048; const float* w1 = (kv ? p.w1v : p.w1k) + (long)l * 2048 * 256 + n;
      float s = 0.f; for (int k = 0; k < 2048; ++k) s += pe[k] * w1[(long)k * 256];
      p.bias1[gt] = s; }
  }
  PH(2) rownorm<false>(p.mem, p.mem_g, p.memn, 1024);
  rownorm<false>(p.mem, p.mem_g + DM, p.memn + 1024 * DM, 1024);
  rownorm<false>(p.x_in, p.mix_g, p.hb, NTOK);
  GSYNC();

  for (int layer = 0; layer < 2; ++layer) {
    const float* xsrc = layer == 0 ? p.x_in : p.xw;
    PH(3) {
      const int nmain = 128 * 21, nextra = layer == 0 ? 256 : 0;
      for (int it = bid; it < nmain + nextra; it += nb) {
        if (it < nmain) {
          const int nt = it / 128, mt = it % 128;
          RowDense af{p.hb + (long)mt * 128 * DM, DM, 64};
          RowDense bf{p.WinT + ((long)layer * 2688 + nt * 128) * DM, DM, 64};
          EpiInproj ep{p.P, p.fgl, mt, nt};
          gemm_tile(sm, 16, af, bf, ep);
        } else {
          const int e = it - nmain; const int l2 = e >> 7, kv = (e >> 6) & 1, mt = (e >> 3) & 7, nt = e & 7;
          RowDense af{p.memn + ((long)l2 * 1024 + mt * 128) * DM, DM, 64};
          RowDense bf{(kv ? p.WvT : p.WkT) + ((long)l2 * 1024 + nt * 128) * DM, DM, 64};
          EpiBf16 ep{(kv ? p.Vmem : p.Kmem) + (long)l2 * 1024 * DM, DM, mt * 128, nt * 128};
          gemm_tile(sm, 16, af, bf, ep);
        }
      }
    }
    GSYNC();
    PH(4) {
      const int n_cum = 24, n_c1 = 64, n_pool = 1024;
      for (int it = bid; it < n_cum + n_c1 + n_pool; it += nb) {
        if (it < n_cum) cum_unit(p, layer, it / 6, it % 6, sm);
        else if (it < n_cum + n_c1) {
          const int e = it - n_cum; const int kv = e >> 5, mt = (e >> 1) & 15, nt = e & 1;
          RowCmp af{p.P + (kv ? 1920 : 1792), mt * 128};
          RowDense bf{p.W1T + (((long)layer * 2 + kv) * 256 + nt * 128) * 2048, 2048, 64};
          EpiCmp1 ep{p.hid + (long)kv * 2048 * 256, p.bias1 + (layer * 2 + kv) * 256, mt * 128, nt * 128};
          gemm_tile(sm, 32, af, bf, ep);
        } else { const int e = it - n_cum - n_c1; pool_unit(p, layer, e >> 8, (e >> 2) & 63, e & 3, sm); }
      }
    }
    GSYNC();
    PH(5) for (int it = bid; it < 32; it += nb) {
      const int kv = it >> 4, mt = it & 15;
      RowDense af{p.hid + ((long)kv * 2048 + mt * 128) * 256, 256, 64};
      RowWrap64 bf{p.W2T + ((long)layer * 2 + kv) * 64 * 256, 256};
      EpiCmp2 ep{p.kvc + (long)kv * 2048 * 64, mt * 128};
      gemm_tile(sm, 4, af, bf, ep);
    }
    GSYNC();
    PH(6) for (int it = bid; it < 256 + 768; it += nb) {
      if (it < 256) {
#ifndef NO_NSA
        const int qb = 31 - (it >> 3), bg = it & 7; nsa_unit(p, layer, bg >> 1, bg & 1, qb, sm);
#endif
      }
      else {
#ifndef NO_FOX
        const int e = it - 256; const int qb = 31 - e / 24, bh = e % 24; fox_unit(p, bh / 6, bh % 6, qb, sm);
#endif
      }
    }
    GSYNC();
    PH(7) for (int it = bid; it < 1024; it += nb) {
      const int nt = it >> 7, mt = it & 127;
      RowDense af{p.cat + (long)mt * 128 * DM, DM, 64};
      RowDense bf{p.WoutT + ((long)layer * 1024 + nt * 128) * DM, DM, 64};
      EpiResid ep{xsrc, p.xw, mt * 128, nt * 128};
      gemm_tile(sm, 16, af, bf, ep);
    }
    GSYNC();
    rownorm<false>(p.xw, p.xattn_g + layer * DM, p.hb, NTOK);
    GSYNC();
    PH(8) for (int it = bid; it < 1024; it += nb) {
      const int nt = it >> 7, mt = it & 127;
      RowDense af{p.hb + (long)mt * 128 * DM, DM, 64};
      RowDense bf{p.WqT + ((long)layer * 1024 + nt * 128) * DM, DM, 64};
      EpiBf16 ep{p.qx, DM, mt * 128, nt * 128};
      gemm_tile(sm, 16, af, bf, ep);
    }
    GSYNC();
#ifndef NO_XATTN
    for (int it = bid; it < 1024; it += nb) { const int dh = it & 1, hd = (it >> 1) & 3, b = (it >> 3) & 3, qb = it >> 5; xattn_unit(p, layer, b, hd, qb, dh, sm); }
#endif
    GSYNC();
    PH(9) for (int it = bid; it < 1024; it += nb) {
      const int nt = it >> 7, mt = it & 127;
      RowDense af{p.ox + (long)mt * 128 * DM, DM, 64};
      RowDense bf{p.WoT + ((long)layer * 1024 + nt * 128) * DM, DM, 64};
      EpiResid ep{p.xw, p.xw, mt * 128, nt * 128};
      gemm_tile(sm, 16, af, bf, ep);
    }
    GSYNC();
    rownorm<false>(p.xw, p.ffn_g + layer * DM, p.hb, NTOK);
    GSYNC();
    PH(10) for (int mt = bid; mt < 128; mt += nb) {
      RowDense af{p.hb + (long)mt * 128 * DM, DM, 64};
      RowDense bf{p.WrT + (long)layer * 128 * DM, DM, 64};
      LAS float* lg = (LAS float*)sm;
      EpiRouter ep{lg};
      gemm_tile(sm, 16, af, bf, ep);
      __syncthreads();
      if (tid < 128) {
        const int tok = mt * 128 + tid;
        float c[4], f[4];
#pragma unroll
        for (int i = 0; i < 4; ++i) c[i] = lg[tid * 20 + i] + p.rc_b[layer * 4 + i];
        int grp = 0; float cm = c[0];
#pragma unroll
        for (int i = 1; i < 4; ++i) if (c[i] > cm) { cm = c[i]; grp = i; }
        float cs = 0.f;
#pragma unroll
        for (int i = 0; i < 4; ++i) cs += __expf(c[i] - cm);
        const float wgrp = 1.0f / cs;
#pragma unroll
        for (int i = 0; i < 4; ++i) f[i] = lg[tid * 20 + 4 + grp * 4 + i] + p.rf_b[layer * 16 + grp * 4 + i];
        int i1 = 0; float f1 = f[0];
#pragma unroll
        for (int i = 1; i < 4; ++i) if (f[i] > f1) { f1 = f[i]; i1 = i; }
        int i2 = -1; float f2 = -INFINITY;
#pragma unroll
        for (int i = 0; i < 4; ++i) if (i != i1 && f[i] > f2) { f2 = f[i]; i2 = i; }
        const float e2 = __expf(f2 - f1);
        const float w1 = wgrp / (1.0f + e2), w2 = wgrp * e2 / (1.0f + e2);
        const int a = i1 < i2 ? i1 : i2, bq = i1 < i2 ? i2 : i1;
        const float wa = i1 < i2 ? w1 : w2, wb = i1 < i2 ? w2 : w1;
        const int pairidx = (a == 0) ? (bq - 1) : (a == 1 ? bq + 1 : 5);
        const int cls = grp * 6 + pairidx;
        const int pos = atomicAdd(&p.mcnt[layer * 32 + cls], 1);
        p.mlist[((long)layer * 24 + cls) * NTOK + pos] = tok;
        p.tokw[tok * 2 + 0] = wa; p.tokw[tok * 2 + 1] = wb;
      }
      __syncthreads();
    }
    GSYNC();
    PH(11) {
      LAS int* tstart = (LAS int*)xs;
      LAS int* ccnt = (LAS int*)xs + 32;
      LAS int* toks = (LAS int*)xs + 64;
      LAS float* wts = (LAS float*)xs + 192;
      __syncthreads();
      if (tid == 0) { int a = 0; for (int c = 0; c < 24; ++c) { const int n = p.mcnt[layer * 32 + c]; ccnt[c] = n; tstart[c] = a; a += (n + 127) >> 7; } tstart[24] = a; }
      __syncthreads();
      const int nrt = tstart[24];
      for (int pass = 0; pass < 2; ++pass) {
        const int nct = pass == 0 ? 16 : 8;
        for (int it = bid; it < nrt * nct; it += nb) {
          const int rt = it / nct, ct = it % nct;
          int cls = 0;
          for (int c = 1; c < 24; ++c) if (rt >= tstart[c]) cls = c;
          const int rtl = rt - tstart[cls];
          const int grp = cls / 6, pi = cls % 6;
          const int ea = grp * 4 + (pi < 3 ? 0 : (pi < 5 ? 1 : 2)), eb = grp * 4 + (pi < 3 ? pi + 1 : (pi < 5 ? pi - 1 : 3));
          __syncthreads();
          if (tid < 128) { const int idx = rtl * 128 + tid; const bool ok = idx < ccnt[cls];
            const int tk = ok ? p.mlist[((long)layer * 24 + cls) * NTOK + idx] : -1; toks[tid] = tk;
            wts[tid] = ok ? p.tokw[tk * 2 + (ct < 8 ? 0 : 1)] : 0.f; }
          __syncthreads();
          if (pass == 0) {
            const int ex = ct < 8 ? ea : eb;
            RowGather af{p.hb, DM, toks};
            RowDense bf{p.WguT + (((long)layer * 16 + ex) * 1024 + (ct & 7) * 128) * DM, DM, 64};
            EpiMoeUp ep{p.he, (long)rt * 128, (ct < 8 ? 0 : 512) + (ct & 7) * 64, wts};
            gemm_tile(sm, 16, af, bf, ep);
          } else {
            RowDense af{p.he + (long)rt * 128 * DM, DM, 64};
            const bf16_t* ba = p.WdT + (((long)layer * 16 + ea) * 1024 + ct * 128) * 512;
            const bf16_t* bb = p.WdT + (((long)layer * 16 + eb) * 1024 + ct * 128) * 512;
            RowSplit bf{ba, 512, (long)(bb - ba)};
            EpiMoeDown ep{p.xw, ct * 128, toks};
            gemm_tile(sm, 16, af, bf, ep);
          }
        }
        GSYNC();
      }
    }
    if (layer == 0) { rownorm<false>(p.xw, p.mix_g + DM, p.hb, NTOK); GSYNC(); }
  }
  rownorm<true>(p.xw, p.final_g, p.xw, NTOK);
}

static inline size_t al256(size_t x) { return (x + 255) & ~(size_t)255; }
extern "C" void kernel_launch(void* const* d_in, const int* in_sizes, int n_in, void* d_out, int out_size, void* d_ws, size_t ws_size, hipStream_t stream) {
  Params p; memset(&p, 0, sizeof(p));
  const float* const* in = (const float* const*)d_in;
  p.x_in = in[0]; p.mem = in[1]; p.mix_g = in[2]; p.fox_b = in[4]; p.pool_w = in[5]; p.pool_scale = in[6]; p.pe_k = in[7]; p.pe_v = in[8];
  p.w1k = in[9]; p.w1v = in[11]; p.gate_b = in[13]; p.xattn_g = in[15]; p.mem_g = in[16]; p.ffn_g = in[21]; p.rc_b = in[23]; p.rf_b = in[25]; p.final_g = in[29];
  p.xw = (float*)d_out;
  char* ws = (char*)d_ws; size_t off = 0;
  auto take = [&](size_t bytes) { char* r = ws + off; off = al256(off + bytes); return r; };
  p.bar = (unsigned*)take(XCD_BAR_WORDS * 4);
  p.mcnt = (int*)take(64 * 4);
  p.WinT = (bf16_t*)take(2UL * 2688 * 1024 * 2);
  p.WoutT = (bf16_t*)take(2UL * 1024 * 1024 * 2);
  p.WqT = (bf16_t*)take(2UL * 1024 * 1024 * 2);
  p.WkT = (bf16_t*)take(2UL * 1024 * 1024 * 2);
  p.WvT = (bf16_t*)take(2UL * 1024 * 1024 * 2);
  p.WoT = (bf16_t*)take(2UL * 1024 * 1024 * 2);
  p.WguT = (bf16_t*)take(2UL * 16 * 1024 * 1024 * 2);
  p.WdT = (bf16_t*)take(2UL * 16 * 1024 * 512 * 2);
  p.W1T = (bf16_t*)take(2UL * 2 * 256 * 2048 * 2);
  p.W2T = (bf16_t*)take(2UL * 2 * 64 * 256 * 2);
  p.WrT = (bf16_t*)take(2UL * 128 * 1024 * 2);
  p.bias1 = (float*)take(1024 * 4);
  p.hb = (bf16_t*)take((size_t)NTOK * 1024 * 2);
  p.onsa = (float*)p.hb;
  p.P = (bf16_t*)take((size_t)NTOK * PW * 2);
  p.qx = p.P;
  p.ox = p.P + (size_t)NTOK * 1024;
  p.he = p.P;
  p.cat = (bf16_t*)take((size_t)NTOK * 1024 * 2);
  p.memn = (bf16_t*)take(2UL * 1024 * 1024 * 2);
  p.Kmem = (bf16_t*)take(2UL * 1024 * 1024 * 2);
  p.Vmem = (bf16_t*)take(2UL * 1024 * 1024 * 2);
  p.hid = (bf16_t*)take(2UL * 2048 * 256 * 2);
  p.kvc = (bf16_t*)take(2UL * 2048 * 64 * 2);
  p.fgl = (float*)take((size_t)NTOK * 32 * 4);
  p.cum = (float*)take(24UL * SEQ * 4);
  p.tokw = (float*)take((size_t)NTOK * 2 * 4);
  p.mlist = (int*)take(2UL * 24 * NTOK * 4);
  int nj = 0, tile0 = 0;
  auto job = [&](const float* src, bf16_t* dst, long sbs, long dbs, int K, int N, int lds, int ldd, int map, int nbatch) {
    TJob& j = p.jobs[nj++]; j.src = src; j.dst = dst; j.sbs = sbs; j.dbs = dbs; j.K = K; j.N = N; j.lds = lds; j.ldd = ldd; j.map = map;
    j.tpb = (K / 64) * ((N + 63) / 64); j.tile0 = tile0; j.pad = 0; tile0 += j.tpb * nbatch; };
  job(in[26], p.WguT, 1024L * 512, 1024L * 1024, 1024, 512, 512, 1024, 2, 32);
  job(in[27], p.WguT, 1024L * 512, 1024L * 1024, 1024, 512, 512, 1024, 3, 32);
  job(in[28], p.WdT, 512L * 1024, 1024L * 512, 512, 1024, 1024, 512, 0, 32);
  job(in[3], p.WinT, 1024L * 2584, 2688L * 1024, 1024, 2584, 2584, 1024, 1, 2);
  job(in[14], p.WoutT, 1024L * 1024, 1024L * 1024, 1024, 1024, 1024, 1024, 0, 2);
  job(in[17], p.WqT, 1024L * 1024, 1024L * 1024, 1024, 1024, 1024, 1024, 0, 2);
  job(in[18], p.WkT, 1024L * 1024, 1024L * 1024, 1024, 1024, 1024, 1024, 0, 2);
  job(in[19], p.WvT, 1024L * 1024, 1024L * 1024, 1024, 1024, 1024, 1024, 0, 2);
  job(in[20], p.WoT, 1024L * 1024, 1024L * 1024, 1024, 1024, 1024, 1024, 0, 2);
  job(in[9], p.W1T, 2048L * 256, 2L * 256 * 2048, 2048, 256, 256, 2048, 0, 2);
  job(in[11], p.W1T + 256L * 2048, 2048L * 256, 2L * 256 * 2048, 2048, 256, 256, 2048, 0, 2);
  job(in[10], p.W2T, 256L * 64, 2L * 64 * 256, 256, 64, 64, 256, 0, 2);
  job(in[12], p.W2T + 64L * 256, 256L * 64, 2L * 64 * 256, 256, 64, 64, 256, 0, 2);
  job(in[22], p.WrT, 1024L * 4, 128L * 1024, 1024, 4, 4, 1024, 0, 2);
  job(in[24], p.WrT + 4L * 1024, 1024L * 16, 128L * 1024, 1024, 16, 16, 1024, 0, 2);
  p.ttiles = tile0; p.never = 0;
  static int grid_blocks = 0;
  if (!grid_blocks) {
    int dev = 0, cus = 0, per_cu = 0;
    hipGetDevice(&dev);
    hipDeviceGetAttribute(&cus, hipDeviceAttributeMultiprocessorCount, dev);
    hipOccupancyMaxActiveBlocksPerMultiprocessor(&per_cu, fwd_kernel, 256, 0);
    if (per_cu > 2) per_cu = 2;
    if (per_cu < 1) per_cu = 1;
    grid_blocks = cus * per_cu;
  }
  hipMemsetAsync(p.bar, 0, XCD_BAR_WORDS * 4, stream);
  void* args[] = {&p};
  hipError_t e = hipLaunchCooperativeKernel((void*)fwd_kernel, dim3(grid_blocks), dim3(256), args, 0, stream);
  if (e != hipSuccess) fprintf(stderr, "cooperative launch failed: %s (grid %d, ws needed %zu of %zu)\n", hipGetErrorString(e), grid_blocks, off, ws_size);
}
```

```cpp
#define DUPMASK 0
#include <hip/hip_runtime.h>
#include <hip/hip_cooperative_groups.h>
#include <cstdint>
#include <cstdio>
#include <cstring>
namespace cg = cooperative_groups;

#define LAS __attribute__((address_space(3)))
typedef unsigned short bf16_t;
typedef short bf16x8 __attribute__((ext_vector_type(8)));
typedef short s16x4 __attribute__((ext_vector_type(4)));
typedef float f32x16 __attribute__((ext_vector_type(16)));
typedef float f32x4 __attribute__((ext_vector_type(4)));
typedef float f32x2 __attribute__((ext_vector_type(2)));
typedef unsigned u32x4 __attribute__((ext_vector_type(4)));
typedef unsigned u32x2 __attribute__((ext_vector_type(2)));
typedef __bf16 bf16x2_t __attribute__((ext_vector_type(2)));

#define NTOK 16384
#define SEQ 4096
#define DM 1024
#define PW 2560
#define LOG2E 1.4426950408889634f

__device__ __forceinline__ unsigned cvtpk(float lo, float hi) { f32x2 v = {lo, hi}; bf16x2_t b = __builtin_convertvector(v, bf16x2_t); return __builtin_bit_cast(unsigned, b); }
__device__ __forceinline__ bf16_t f2bf(float x) { return (bf16_t)(cvtpk(x, 0.f) & 0xffffu); }
__device__ __forceinline__ float bf2f(bf16_t b) { return __uint_as_float(((unsigned)b) << 16); }
__device__ __forceinline__ int crow(int r, int hi) { return (r & 3) + 8 * (r >> 2) + 4 * hi; }
__device__ __forceinline__ float fexp2(float x) { return __builtin_amdgcn_exp2f(x); }
__device__ __forceinline__ int otid() { int t = threadIdx.x; asm volatile("" : "+v"(t)); return t; }
__device__ __forceinline__ float sigmoidf_(float x) { return 1.0f / (1.0f + __expf(-x)); }

struct TJob { const float* src; bf16_t* dst; long sbs, dbs; int K, N, lds, ldd, map, tpb, tile0, pad; };
#define NJOBS 15
struct Params {
  const float *x_in, *mem, *mix_g, *fox_b, *pool_w, *pool_scale, *pe_k, *pe_v, *w1k, *w1v, *gate_b;
  const float *xattn_g, *mem_g, *ffn_g, *rc_b, *rf_b, *final_g;
  float* xw;
  bf16_t *WinT, *WoutT, *WqT, *WkT, *WvT, *WoT, *WguT, *WdT, *W1T, *W2T, *WrT;
  float* bias1;
  bf16_t *hb, *P, *cat, *memn, *Kmem, *Vmem, *hid, *kvc, *qx, *ox, *he;
  float *fgl, *cum, *onsa, *tokw;
  int *mlist, *mcnt, *wq;
  unsigned* selm;
  unsigned* bar;
  TJob jobs[NJOBS];
  int ttiles; int never;
};

#define XB_TMO      128
#define XB_XCNT(j)  (256  + 64 * (j))
#define XB_XSUB(j)  (1280 + 64 * (j))
#define XB_XGEN(j)  (2304 + 64 * (j))
#define XB_TOP      3328
#define XB_TOPGEN   3392
#define XCD_BAR_WORDS 3456
#define XB_SPIN_CAP (1u << 22)
__device__ __forceinline__ unsigned xb_ld(unsigned* p)              { return __hip_atomic_load(p, __ATOMIC_RELAXED, __HIP_MEMORY_SCOPE_AGENT); }
__device__ __forceinline__ unsigned xb_add(unsigned* p, unsigned v) { return __hip_atomic_fetch_add(p, v, __ATOMIC_RELAXED, __HIP_MEMORY_SCOPE_AGENT); }
__device__ __forceinline__ unsigned xb_xcc_id() { return (unsigned)__builtin_amdgcn_s_getreg((3 << 11) | 20) & 0xFu; }
#define XB_SPIN(cond, bar) do { unsigned _sp = 0; while (cond) { __builtin_amdgcn_s_sleep(1); \
    if ((++_sp & 255u) == 0u) { if (xb_ld(&(bar)[XB_TMO])) break; if (_sp > XB_SPIN_CAP) { atomicAdd(&(bar)[XB_TMO], 1u); break; } } } } while (0)
struct XcdBarrier { unsigned* bar; unsigned x; volatile LAS unsigned* st; };
__device__ __forceinline__ XcdBarrier xcd_barrier_post(unsigned* bar, volatile LAS unsigned* st) {
    XcdBarrier b; b.bar = bar; b.x = xb_xcc_id(); b.st = st;
    if (threadIdx.x == 0) (void)xb_add(&bar[XB_XCNT(b.x)], 1u);
    return b;
}
__device__ __forceinline__ void xcd_barrier_complete(unsigned* bar, unsigned x, unsigned& nloc, unsigned& nx) {
    const unsigned G = gridDim.x * gridDim.y * gridDim.z;
    unsigned sum, cnt, mine, sp = 0u;
    for (;;) {
        sum = 0u; cnt = 0u; mine = 0u;
#pragma unroll
        for (unsigned j = 0; j < 16; ++j) { const unsigned c = xb_ld(&bar[XB_XCNT(j)]); sum += c; cnt += (c > 0u) ? 1u : 0u; mine = (j == x) ? c : mine; }
        if (sum == G) break;
        __builtin_amdgcn_s_sleep(1);
        if ((++sp & 255u) == 0u) { if (xb_ld(&bar[XB_TMO])) break; if (sp > XB_SPIN_CAP) { atomicAdd(&bar[XB_TMO], 1u); break; } }
    }
    nloc = mine > 0u ? mine : 1u; nx = cnt > 0u ? cnt : 1u;
}
__device__ __forceinline__ void xcd_barrier(const XcdBarrier& b) {
    asm volatile("s_waitcnt vmcnt(0)" ::: "memory");
    __syncthreads();
    if (threadIdx.x == 0) {
        unsigned* bar = b.bar;
        __builtin_amdgcn_s_waitcnt(0);
        unsigned nloc = b.st[0], nx = b.st[1];
        if (nloc == 0u) { xcd_barrier_complete(bar, b.x, nloc, nx); b.st[0] = nloc; b.st[1] = nx; }
        const unsigned old = xb_add(&bar[XB_XSUB(b.x)], 1u);
        const unsigned gen = old / nloc;
        if (old + 1u == (gen + 1u) * nloc) {
            __builtin_amdgcn_fence(__ATOMIC_RELEASE, "agent");
            asm volatile("s_waitcnt vmcnt(0)" ::: "memory");
            const unsigned og = xb_add(&bar[XB_TOP], 1u);
            const unsigned tg = og / nx;
            if (og + 1u == (tg + 1u) * nx) xb_add(&bar[XB_TOPGEN], 1u);
            else XB_SPIN(xb_ld(&bar[XB_TOPGEN]) == tg, bar);
            __builtin_amdgcn_fence(__ATOMIC_ACQUIRE, "agent");
            xb_add(&bar[XB_XGEN(b.x)], 1u);
            asm volatile("s_waitcnt vmcnt(0)" ::: "memory");
        } else {
            XB_SPIN(xb_ld(&bar[XB_XGEN(b.x)]) == gen, bar);
            __builtin_amdgcn_fence(__ATOMIC_ACQUIRE, "agent");
            asm volatile("s_waitcnt vmcnt(0)" ::: "memory");
        }
    }
    __syncthreads();
}

__device__ __forceinline__ int nmap(int map, int n) {
  if (map == 1) { if (n < 1152) return n; if (n < 1158) return 2560 + (n - 1152); if (n < 2566) return n - 6; return n; }
  if (map == 2) return 64 * (n >> 5) + (n & 31);
  if (map == 3) return 64 * (n >> 5) + 32 + (n & 31);
  return n;
}
__device__ __forceinline__ void transpose_tile(const TJob& j, int t, LAS char* sm) {
  const int tid = otid();
  const int tb = t / j.tpb, tt = t - tb * j.tpb;
  const int nkt = j.K >> 6;
  const int kt = tt % nkt, nt = tt / nkt;
  const float* src = j.src + (long)tb * j.sbs + (long)(kt * 64) * j.lds + nt * 64;
  bf16_t* dst = j.dst + (long)tb * j.dbs;
  LAS float* tile = (LAS float*)sm;
  {
    const int tk = tid >> 4, tn4 = tid & 15;
    const bool ok = (nt * 64 + tn4 * 4) < j.N;
#pragma unroll
    for (int i = 0; i < 4; ++i) {
      const int k = tk + 16 * i;
      f32x4 v = {0.f, 0.f, 0.f, 0.f};
      if (ok) v = *(const f32x4*)(src + (long)k * j.lds + tn4 * 4);
      tile[k * 65 + tn4 * 4 + 0] = v[0]; tile[k * 65 + tn4 * 4 + 1] = v[1]; tile[k * 65 + tn4 * 4 + 2] = v[2]; tile[k * 65 + tn4 * 4 + 3] = v[3];
    }
  }
  __syncthreads();
  {
    const int n = tid >> 2, kq = tid & 3, ng = nt * 64 + n;
    if (ng < j.N) {
      const int row = nmap(j.map, ng);
      unsigned w[8];
#pragma unroll
      for (int c = 0; c < 8; ++c) w[c] = cvtpk(tile[(kq * 16 + 2 * c) * 65 + n], tile[(kq * 16 + 2 * c + 1) * 65 + n]);
      bf16_t* d = dst + (long)row * j.ldd + kt * 64 + kq * 16;
      *(u32x4*)d = (u32x4){w[0], w[1], w[2], w[3]};
      *(u32x4*)(d + 8) = (u32x4){w[4], w[5], w[6], w[7]};
    }
  }
  __syncthreads();
}

template <bool F32OUT>
__device__ __forceinline__ void rownorm(const float* x, const float* g, void* out, int nrows) {
  const int tid = otid(); const int lane = tid & 63;
  const int gw = blockIdx.x * 4 + (tid >> 6), nw = gridDim.x * 4;
  for (int row = gw; row < nrows; row += nw) {
    const float* xr = x + (long)row * DM;
    f32x4 v[4]; float ss = 0.f;
#pragma unroll
    for (int i = 0; i < 4; ++i) { v[i] = *(const f32x4*)(xr + i * 256 + lane * 4); ss += v[i][0] * v[i][0] + v[i][1] * v[i][1] + v[i][2] * v[i][2] + v[i][3] * v[i][3]; }
#pragma unroll
    for (int o = 32; o >= 1; o >>= 1) ss += __shfl_xor(ss, o);
    const float rstd = 1.0f / sqrtf(ss * (1.0f / DM) + 1e-6f);
#pragma unroll
    for (int i = 0; i < 4; ++i) {
      const f32x4 gg = *(const f32x4*)(g + i * 256 + lane * 4);
      const f32x4 y = v[i] * rstd * gg;
      if (F32OUT) *(f32x4*)((float*)out + (long)row * DM + i * 256 + lane * 4) = y;
      else { u32x2 w; w.x = cvtpk(y[0], y[1]); w.y = cvtpk(y[2], y[3]); *(u32x2*)((bf16_t*)out + (long)row * DM + i * 256 + lane * 4) = w; }
    }
  }
}

struct RowDense { const bf16_t* base; long ld; long ks;
  __device__ __forceinline__ const bf16_t* rowptr(int r) const { return base + (long)r * ld; }
  __device__ __forceinline__ long koff(int kt) const { return (long)kt * ks; } };
struct RowGather { const bf16_t* base; long ld; LAS const int* toks;
  __device__ __forceinline__ const bf16_t* rowptr(int r) const { int t = toks[r]; t = t < 0 ? 0 : t; return base + (long)t * ld; }
  __device__ __forceinline__ long koff(int kt) const { return (long)kt * 64; } };
struct RowCmp { const bf16_t* base; int r0;
  __device__ __forceinline__ const bf16_t* rowptr(int r) const { const int R = r0 + r; const int bg = R >> 8; int c = R & 255; c = c > 254 ? 254 : c;
    return base + (long)((bg >> 1) * SEQ + 16 * c) * PW + (bg & 1) * 64; }
  __device__ __forceinline__ long koff(int kt) const { return (long)kt * PW; } };
struct RowSplit { const bf16_t* base; long ld; long delta;
  __device__ __forceinline__ const bf16_t* rowptr(int r) const { return base + (long)r * ld; }
  __device__ __forceinline__ long koff(int kt) const { return kt < 8 ? (long)kt * 64 : delta + (long)(kt - 8) * 64; } };
struct RowWrap64 { const bf16_t* base; long ld;
  __device__ __forceinline__ const bf16_t* rowptr(int r) const { return base + (long)(r & 63) * ld; }
  __device__ __forceinline__ long koff(int kt) const { return (long)kt * 64; } };

template <class AF, class BF, class EPI>
__device__ __forceinline__ void gemm_tile(LAS char* sm, int nkt, const AF& af, const BF& bfn, const EPI& epi) {
  const int tid = otid(), lane = tid & 63, wid = tid >> 6, wm = wid >> 1, wn = wid & 1, l31 = lane & 31, hh = lane >> 5;
  const int lrow = tid >> 3, lkc = tid & 7;
  const int wofs = lrow * 128 + ((lkc ^ ((lrow >> 1) & 7)) << 4);
  const bf16_t* ap[4]; const bf16_t* bp[4];
#pragma unroll
  for (int i = 0; i < 4; ++i) { ap[i] = af.rowptr(lrow + 32 * i) + lkc * 8; bp[i] = bfn.rowptr(lrow + 32 * i) + lkc * 8; }
  const int swz = (l31 >> 1) & 7;
  int koffs[4];
#pragma unroll
  for (int s = 0; s < 4; ++s) koffs[s] = (((2 * s + hh) ^ swz) << 4);
  const int arow = (wm * 64 + l31) * 128, brow = 16384 + (wn * 64 + l31) * 128;
  f32x16 acc[2][2];
#pragma unroll
  for (int i = 0; i < 2; ++i)
#pragma unroll
    for (int j = 0; j < 2; ++j)
#pragma unroll
      for (int r = 0; r < 16; ++r) acc[i][j][r] = 0.f;
  u32x4 ra[4], rb[4];
  { const long ka = af.koff(0), kb = bfn.koff(0);
#pragma unroll
    for (int i = 0; i < 4; ++i) { ra[i] = *(const u32x4*)(ap[i] + ka); rb[i] = *(const u32x4*)(bp[i] + kb); } }
#pragma unroll
  for (int i = 0; i < 4; ++i) { *(LAS u32x4*)(sm + wofs + i * 4096) = ra[i]; *(LAS u32x4*)(sm + 16384 + wofs + i * 4096) = rb[i]; }
  __syncthreads();
  for (int kt = 0; kt < nkt; ++kt) {
    const int cur = (kt & 1) * 32768;
    if (kt + 1 < nkt) { const long ka = af.koff(kt + 1), kb = bfn.koff(kt + 1);
#pragma unroll
      for (int i = 0; i < 4; ++i) { ra[i] = *(const u32x4*)(ap[i] + ka); rb[i] = *(const u32x4*)(bp[i] + kb); } }
#pragma unroll
    for (int s = 0; s < 4; ++s) {
      const bf16x8 a0 = *(LAS const bf16x8*)(sm + cur + arow + koffs[s]);
      const bf16x8 a1 = *(LAS const bf16x8*)(sm + cur + arow + 4096 + koffs[s]);
      const bf16x8 b0 = *(LAS const bf16x8*)(sm + cur + brow + koffs[s]);
      const bf16x8 b1 = *(LAS const bf16x8*)(sm + cur + brow + 4096 + koffs[s]);
      acc[0][0] = __builtin_amdgcn_mfma_f32_32x32x16_bf16(a0, b0, acc[0][0], 0, 0, 0);
      acc[0][1] = __builtin_amdgcn_mfma_f32_32x32x16_bf16(a0, b1, acc[0][1], 0, 0, 0);
      acc[1][0] = __builtin_amdgcn_mfma_f32_32x32x16_bf16(a1, b0, acc[1][0], 0, 0, 0);
      acc[1][1] = __builtin_amdgcn_mfma_f32_32x32x16_bf16(a1, b1, acc[1][1], 0, 0, 0);
    }
    if (kt + 1 < nkt) { const int nx = cur ^ 32768;
#pragma unroll
      for (int i = 0; i < 4; ++i) { *(LAS u32x4*)(sm + nx + wofs + i * 4096) = ra[i]; *(LAS u32x4*)(sm + nx + 16384 + wofs + i * 4096) = rb[i]; } }
    __syncthreads();
  }
  epi(acc, wm, wn, lane);
}

struct EpiInproj { bf16_t* P; float* fgl; int mt, nt;
  __device__ __forceinline__ void operator()(f32x16 (&acc)[2][2], int wm, int wn, int lane) const {
    const int l31 = lane & 31, hh = lane >> 5;
#pragma unroll
    for (int i = 0; i < 2; ++i)
#pragma unroll
      for (int j = 0; j < 2; ++j) {
        const int col = nt * 128 + wn * 64 + j * 32 + l31;
#pragma unroll
        for (int r = 0; r < 16; ++r) {
          const int row = mt * 128 + wm * 64 + i * 32 + crow(r, hh);
          if (nt < 20) P[(long)row * PW + col] = f2bf(acc[i][j][r]);
          else { const int c = col - 2560; if (c < 24) fgl[row * 32 + c] = acc[i][j][r]; }
        }
      }
  } };
struct EpiBf16 { bf16_t* out; long ld; int row0, col0;
  __device__ __forceinline__ void operator()(f32x16 (&acc)[2][2], int wm, int wn, int lane) const {
    const int l31 = lane & 31, hh = lane >> 5;
#pragma unroll
    for (int i = 0; i < 2; ++i)
#pragma unroll
      for (int j = 0; j < 2; ++j) {
        const int col = col0 + wn * 64 + j * 32 + l31;
#pragma unroll
        for (int r = 0; r < 16; ++r) { const int row = row0 + wm * 64 + i * 32 + crow(r, hh); out[(long)row * ld + col] = f2bf(acc[i][j][r]); }
      }
  } };
struct EpiResid { const float* base; float* out; int row0, col0;
  __device__ __forceinline__ void operator()(f32x16 (&acc)[2][2], int wm, int wn, int lane) const {
    const int l31 = lane & 31, hh = lane >> 5;
#pragma unroll
    for (int i = 0; i < 2; ++i)
#pragma unroll
      for (int j = 0; j < 2; ++j) {
        const int col = col0 + wn * 64 + j * 32 + l31;
#pragma unroll
        for (int r = 0; r < 16; ++r) { const long o = (long)(row0 + wm * 64 + i * 32 + crow(r, hh)) * DM + col; out[o] = base[o] + acc[i][j][r]; }
      }
  } };
__device__ __forceinline__ float gelu_tanh(float x) { const float u = 0.7978845608028654f * (x + 0.044715f * x * x * x); return 0.5f * x * (1.0f + tanhf(u)); }
struct EpiCmp1 { bf16_t* hid; const float* bias; int row0, col0;
  __device__ __forceinline__ void operator()(f32x16 (&acc)[2][2], int wm, int wn, int lane) const {
    const int l31 = lane & 31, hh = lane >> 5;
#pragma unroll
    for (int i = 0; i < 2; ++i)
#pragma unroll
      for (int j = 0; j < 2; ++j) {
        const int col = col0 + wn * 64 + j * 32 + l31; const float bv = bias[col];
#pragma unroll
        for (int r = 0; r < 16; ++r) { const int row = row0 + wm * 64 + i * 32 + crow(r, hh); hid[(long)row * 256 + col] = f2bf(gelu_tanh(acc[i][j][r] + bv)); }
      }
  } };
struct EpiCmp2 { bf16_t* out; int row0;
  __device__ __forceinline__ void operator()(f32x16 (&acc)[2][2], int wm, int wn, int lane) const {
    const int l31 = lane & 31, hh = lane >> 5;
    if (wn != 0) return;
#pragma unroll
    for (int i = 0; i < 2; ++i)
#pragma unroll
      for (int j = 0; j < 2; ++j) {
        const int col = j * 32 + l31;
#pragma unroll
        for (int r = 0; r < 16; ++r) { const int row = row0 + wm * 64 + i * 32 + crow(r, hh); out[(long)row * 64 + col] = ((row & 255) == 255) ? (bf16_t)0 : f2bf(acc[i][j][r]); }
      }
  } };
struct EpiMoeUp { bf16_t* he; long herow0; int hcol0; LAS const float* wts;
  __device__ __forceinline__ void operator()(f32x16 (&acc)[2][2], int wm, int wn, int lane) const {
    const int l31 = lane & 31, hh = lane >> 5;
    const int col = hcol0 + wn * 32 + l31;
#pragma unroll
    for (int i = 0; i < 2; ++i)
#pragma unroll
      for (int r = 0; r < 16; ++r) {
        const int rl = wm * 64 + i * 32 + crow(r, hh);
        const float gte = acc[i][0][r], up = acc[i][1][r];
        const float v = gte * sigmoidf_(gte) * up * wts[rl];
        he[(herow0 + rl) * DM + col] = f2bf(v);
      }
  } };
struct EpiMoeDown { float* x; int col0; LAS const int* toks;
  __device__ __forceinline__ void operator()(f32x16 (&acc)[2][2], int wm, int wn, int lane) const {
    const int l31 = lane & 31, hh = lane >> 5;
#pragma unroll
    for (int i = 0; i < 2; ++i)
#pragma unroll
      for (int r = 0; r < 16; ++r) {
        const int rl = wm * 64 + i * 32 + crow(r, hh);
        const int tok = toks[rl];
        if (tok >= 0) {
#pragma unroll
          for (int j = 0; j < 2; ++j) { const long o = (long)tok * DM + col0 + wn * 64 + j * 32 + l31; x[o] += acc[i][j][r]; }
        }
      }
  } };
struct EpiRouter { LAS float* lg;
  __device__ __forceinline__ void operator()(f32x16 (&acc)[2][2], int wm, int wn, int lane) const {
    const int l31 = lane & 31, hh = lane >> 5;
    if (wn == 0 && l31 < 20) {
#pragma unroll
      for (int i = 0; i < 2; ++i)
#pragma unroll
        for (int r = 0; r < 16; ++r) lg[(wm * 64 + i * 32 + crow(r, hh)) * 20 + l31] = acc[i][0][r];
    }
  } };

template <int NKS> __device__ __forceinline__ int kswz(int kc, int row) {
  if (NKS == 4) return kc ^ ((row >> 1) & 7);
  return (kc & 16) | ((kc & 15) ^ (row & 15));
}
template <int NKS, int NDT, class SM>
__device__ __forceinline__ void flash_step(const bf16x8* qf, LAS const char* Ks, LAS const char* Vs, float& m, float& l, f32x16* O, const SM& smod, int kv0, int lane) {
  const int l31 = lane & 31, hh = lane >> 5;
  f32x16 p0, p1;
#pragma unroll
  for (int r = 0; r < 16; ++r) { p0[r] = 0.f; p1[r] = 0.f; }
#pragma unroll
  for (int ds = 0; ds < NKS; ++ds) {
    const int so = kswz<NKS>(2 * ds + hh, l31) << 4;
    const bf16x8 k0 = *(LAS const bf16x8*)(Ks + l31 * (NKS * 32) + so);
    const bf16x8 k1 = *(LAS const bf16x8*)(Ks + (32 + l31) * (NKS * 32) + so);
    p0 = __builtin_amdgcn_mfma_f32_32x32x16_bf16(k0, qf[ds], p0, 0, 0, 0);
    p1 = __builtin_amdgcn_mfma_f32_32x32x16_bf16(k1, qf[ds], p1, 0, 0, 0);
  }
  smod.apply(p0, p1, kv0, lane);
  float mx = p0[0];
#pragma unroll
  for (int r = 1; r < 16; ++r) mx = fmaxf(mx, p0[r]);
#pragma unroll
  for (int r = 0; r < 16; ++r) mx = fmaxf(mx, p1[r]);
  mx = fmaxf(mx, __shfl_xor(mx, 32));
  const float mn = fmaxf(m, mx);
  const float mu = (mn == -INFINITY) ? 0.f : mn;
  const float alpha = fexp2(m - mu);
  float rs = 0.f;
#pragma unroll
  for (int r = 0; r < 16; ++r) { p0[r] = fexp2(p0[r] - mu); rs += p0[r]; }
#pragma unroll
  for (int r = 0; r < 16; ++r) { p1[r] = fexp2(p1[r] - mu); rs += p1[r]; }
  l = l * alpha + rs; m = mn;
#pragma unroll
  for (int dt = 0; dt < NDT; ++dt)
#pragma unroll
    for (int r = 0; r < 16; ++r) O[dt][r] *= alpha;
  bf16x8 pb[4];
  { u32x4 w;
    w = (u32x4){cvtpk(p0[0], p0[1]), cvtpk(p0[2], p0[3]), cvtpk(p0[4], p0[5]), cvtpk(p0[6], p0[7])}; pb[0] = __builtin_bit_cast(bf16x8, w);
    w = (u32x4){cvtpk(p0[8], p0[9]), cvtpk(p0[10], p0[11]), cvtpk(p0[12], p0[13]), cvtpk(p0[14], p0[15])}; pb[1] = __builtin_bit_cast(bf16x8, w);
    w = (u32x4){cvtpk(p1[0], p1[1]), cvtpk(p1[2], p1[3]), cvtpk(p1[4], p1[5]), cvtpk(p1[6], p1[7])}; pb[2] = __builtin_bit_cast(bf16x8, w);
    w = (u32x4){cvtpk(p1[8], p1[9]), cvtpk(p1[10], p1[11]), cvtpk(p1[12], p1[13]), cvtpk(p1[14], p1[15])}; pb[3] = __builtin_bit_cast(bf16x8, w); }
  const int vlane = (4 * hh + ((lane & 15) >> 2)) * 64 + (((lane >> 4) & 1) * 16 + (lane & 3) * 4) * 2;
#pragma unroll
  for (int dt = 0; dt < NDT; ++dt)
#pragma unroll
    for (int ks = 0; ks < 4; ++ks) {
      LAS const char* vp = Vs + dt * 4096 + ks * 16 * 64 + vlane;
      const s16x4 lo = __builtin_amdgcn_ds_read_tr16_b64_v4i16((LAS s16x4*)vp);
      const s16x4 hi = __builtin_amdgcn_ds_read_tr16_b64_v4i16((LAS s16x4*)(vp + 8 * 64));
      const bf16x8 vf = (bf16x8){lo[0], lo[1], lo[2], lo[3], hi[0], hi[1], hi[2], hi[3]};
      O[dt] = __builtin_amdgcn_mfma_f32_32x32x16_bf16(vf, pb[ks], O[dt], 0, 0, 0);
    }
}

template <int NKS, int NDT>
struct TileRegs { u32x4 k[NKS / 2]; u32x4 v[NDT]; };
template <int NKS, int NDT>
__device__ __forceinline__ void tile_load(TileRegs<NKS, NDT>& t, const bf16_t* Kb, long ldk, const bf16_t* Vb, long ldv, int kv0) {
  const int tid = otid();
#pragma unroll
  for (int i = 0; i < NKS / 2; ++i) { const int p = tid + 256 * i; const int row = p / (NKS * 2), kc = p % (NKS * 2);
    t.k[i] = *(const u32x4*)(Kb + (long)(kv0 + row) * ldk + kc * 8); }
#pragma unroll
  for (int i = 0; i < NDT; ++i) { const int p = tid + 256 * i; const int kv = (p & 255) >> 2, cp = (p >> 8) * 4 + (p & 3);
    t.v[i] = *(const u32x4*)(Vb + (long)(kv0 + kv) * ldv + cp * 8); }
}
template <int NKS, int NDT>
__device__ __forceinline__ void tile_store(const TileRegs<NKS, NDT>& t, LAS char* Ks, LAS char* Vs) {
  const int tid = otid();
#pragma unroll
  for (int i = 0; i < NKS / 2; ++i) { const int p = tid + 256 * i; const int row = p / (NKS * 2), kc = p % (NKS * 2);
    *(LAS u32x4*)(Ks + row * (NKS * 32) + (kswz<NKS>(kc, row) << 4)) = t.k[i]; }
#pragma unroll
  for (int i = 0; i < NDT; ++i) { const int p = tid + 256 * i; *(LAS u32x4*)(Vs + p * 16) = t.v[i]; }
}
struct TLRange { int n, kv_first; __device__ __forceinline__ int count() const { return n; } __device__ __forceinline__ int kv0(int i) const { return kv_first + 64 * i; } };
struct TLList { int n; LAS const int* lst; __device__ __forceinline__ int count() const { return n; } __device__ __forceinline__ int kv0(int i) const { return lst[i]; } };

template <int NKS, int NDT, bool PF, class SM, class TL>
__device__ __forceinline__ void flash_run(LAS char* Ks, LAS char* Vs, const bf16x8* qf, const bf16_t* Kb, long ldk, const bf16_t* Vb, long ldv,
                                          const TL& tl, const SM& smod, float& m, float& l, f32x16* O) {
  const int n = tl.count(); const int lane = threadIdx.x & 63;
  if (n <= 0) return;
  TileRegs<NKS, NDT> t; f32x4 xr = {0.f, 0.f, 0.f, 0.f}; const int tid_ = otid();
  if (PF) { tile_load<NKS, NDT>(t, Kb, ldk, Vb, ldv, tl.kv0(0)); if (SM::EXTRA) xr = smod.xload(tl.kv0(0), tid_); }
  for (int it = 0; it < n; ++it) {
    const int kvc = tl.kv0(it);
    __syncthreads();
    if (!PF) { tile_load<NKS, NDT>(t, Kb, ldk, Vb, ldv, kvc); if (SM::EXTRA) xr = smod.xload(kvc, tid_); }
    tile_store<NKS, NDT>(t, Ks, Vs); if (SM::EXTRA) smod.xstore(xr, tid_);
    __syncthreads();
    if (PF && it + 1 < n) { tile_load<NKS, NDT>(t, Kb, ldk, Vb, ldv, tl.kv0(it + 1)); if (SM::EXTRA) xr = smod.xload(tl.kv0(it + 1), tid_); }
    if (smod.active(kvc)) flash_step<NKS, NDT, SM>(qf, Ks, Vs, m, l, O, smod, kvc, lane);
  }
}

struct SMFox { float cq; const float* ck; int tq; int tqmax; LAS const float* ckl;
  static constexpr bool EXTRA = true;
  __device__ __forceinline__ bool active(int kv0) const { return kv0 <= tqmax; }
  __device__ __forceinline__ f32x4 xload(int kv0, int tid) const { f32x4 v = {0.f, 0.f, 0.f, 0.f}; if (tid < 16) v = *(const f32x4*)(ck + kv0 + 4 * tid); return v; }
  __device__ __forceinline__ void xstore(const f32x4& v, int tid) const { if (tid < 16) *(LAS f32x4*)(ckl + 4 * tid) = v; }
  __device__ __forceinline__ void apply(f32x16& p0, f32x16& p1, int kv0, int lane) const {
    const int hh = lane >> 5; const float C = 0.125f * LOG2E;
    const int db = tq - kv0 - 4 * hh;
    LAS const float* cp = ckl + 4 * hh;
#pragma unroll
    for (int a = 0; a < 4; ++a) {
      const f32x4 c0 = *(LAS const f32x4*)(cp + 8 * a);
      const f32x4 c1 = *(LAS const f32x4*)(cp + 32 + 8 * a);
#pragma unroll
      for (int e = 0; e < 4; ++e) {
        const int c = 8 * a + e;
        p0[4 * a + e] = (db >= c) ? __builtin_fmaf(p0[4 * a + e], C, cq - c0[e]) : -INFINITY;
        p1[4 * a + e] = (db >= c + 32) ? __builtin_fmaf(p1[4 * a + e], C, cq - c1[e]) : -INFINITY;
      }
    }
  } };
struct SMWin { int tq; float slope2; int tqmax;
  static constexpr bool EXTRA = false;
  __device__ __forceinline__ f32x4 xload(int, int) const { return (f32x4){0.f, 0.f, 0.f, 0.f}; }
  __device__ __forceinline__ void xstore(const f32x4&, int) const {}
  __device__ __forceinline__ bool active(int kv0) const { return kv0 <= tqmax && kv0 + 63 + 512 > tqmax - 31; }
  __device__ __forceinline__ void apply(f32x16& p0, f32x16& p1, int kv0, int lane) const {
    const int hh = lane >> 5; const float C = 0.125f * LOG2E;
    const int db = tq - kv0 - 4 * hh; const float sb = -slope2 * (float)db;
#pragma unroll
    for (int r = 0; r < 16; ++r) {
      const int c = (r & 3) + 8 * (r >> 2);
      const int d0 = db - c, d1 = db - c - 32;
      p0[r] = (d0 >= 0 && d0 < 512) ? __builtin_fmaf(p0[r], C, __builtin_fmaf(slope2, (float)c, sb)) : -INFINITY;
      p1[r] = (d1 >= 0 && d1 < 512) ? __builtin_fmaf(p1[r], C, __builtin_fmaf(slope2, (float)(c + 32), sb)) : -INFINITY;
    }
  } };
struct SMSel { int tq; float slope2; unsigned mlo, mhi; int tqmax;
  static constexpr bool EXTRA = false;
  __device__ __forceinline__ f32x4 xload(int, int) const { return (f32x4){0.f, 0.f, 0.f, 0.f}; }
  __device__ __forceinline__ void xstore(const f32x4&, int) const {}
  __device__ __forceinline__ bool active(int kv0) const { const int j = kv0 >> 6; const bool sel = ((j < 32 ? (mlo >> j) : (mhi >> (j - 32))) & 1u) != 0u;
    return kv0 <= tqmax && __builtin_amdgcn_ballot_w64(sel) != 0ull; }
  __device__ __forceinline__ void apply(f32x16& p0, f32x16& p1, int kv0, int lane) const {
    const int hh = lane >> 5; const float C = 0.125f * LOG2E;
    const int j = kv0 >> 6;
    const bool sel = ((j < 32 ? (mlo >> j) : (mhi >> (j - 32))) & 1u) != 0u;
    const int db = sel ? (tq - kv0 - 4 * hh) : -1; const float sb = -slope2 * (float)db;
#pragma unroll
    for (int r = 0; r < 16; ++r) {
      const int c = (r & 3) + 8 * (r >> 2);
      p0[r] = (db >= c) ? __builtin_fmaf(p0[r], C, __builtin_fmaf(slope2, (float)c, sb)) : -INFINITY;
      p1[r] = (db >= c + 32) ? __builtin_fmaf(p1[r], C, __builtin_fmaf(slope2, (float)(c + 32), sb)) : -INFINITY;
    }
  } };
struct SMCmp { int tq; float slope2; int tqmax;
  static constexpr bool EXTRA = false;
  __device__ __forceinline__ f32x4 xload(int, int) const { return (f32x4){0.f, 0.f, 0.f, 0.f}; }
  __device__ __forceinline__ void xstore(const f32x4&, int) const {}
  __device__ __forceinline__ bool active(int kv0) const { return 16 * kv0 + 31 <= tqmax; }
  __device__ __forceinline__ void apply(f32x16& p0, f32x16& p1, int kv0, int lane) const {
    const int hh = lane >> 5; const float C = 0.125f * LOG2E;
    const int db = tq - 31 - 16 * kv0 - 64 * hh; const float sb = -slope2 * (float)db;
#pragma unroll
    for (int r = 0; r < 16; ++r) {
      const int c = 16 * ((r & 3) + 8 * (r >> 2));
      p0[r] = (db >= c) ? __builtin_fmaf(p0[r], C, __builtin_fmaf(slope2, (float)c, sb)) : -INFINITY;
      p1[r] = (db >= c + 512) ? __builtin_fmaf(p1[r], C, __builtin_fmaf(slope2, (float)(c + 512), sb)) : -INFINITY;
    }
  } };
struct SMNone { float C;
  static constexpr bool EXTRA = false;
  __device__ __forceinline__ f32x4 xload(int, int) const { return (f32x4){0.f, 0.f, 0.f, 0.f}; }
  __device__ __forceinline__ void xstore(const f32x4&, int) const {}
  __device__ __forceinline__ bool active(int kv0) const { return true; }
  __device__ __forceinline__ void apply(f32x16& p0, f32x16& p1, int kv0, int lane) const {
#pragma unroll
    for (int r = 0; r < 16; ++r) { p0[r] *= C; p1[r] *= C; }
  } };

__device__ __forceinline__ void fox_unit(const Params& p, int b, int h, int qb, LAS char* sm) {
  const int tid = otid(), lane = tid & 63, w = tid >> 6, l31 = lane & 31, hh = lane >> 5;
  const int tq = qb * 128 + w * 32 + l31; const long tok = (long)b * SEQ + tq;
  const bf16_t* Pb = p.P + (long)b * SEQ * PW;
  bf16x8 qf[4];
#pragma unroll
  for (int ds = 0; ds < 4; ++ds) qf[ds] = *(const bf16x8*)(p.P + tok * PW + h * 64 + ds * 16 + hh * 8);
  const float* ck = p.cum + (long)(b * 6 + h) * SEQ;
  SMFox smod; smod.cq = ck[tq]; smod.ck = ck; smod.tq = tq; smod.tqmax = qb * 128 + w * 32 + 31; smod.ckl = (LAS const float*)(sm + 16384);
  float m = -INFINITY, l = 0.f; f32x16 O[2];
#pragma unroll
  for (int r = 0; r < 16; ++r) { O[0][r] = 0.f; O[1][r] = 0.f; }
  TLRange tl; tl.n = 2 * qb + 2; tl.kv_first = 0;
  flash_run<4, 2, true>(sm, sm + 8192, qf, Pb + 384 + h * 64, PW, Pb + 768 + h * 64, PW, tl, smod, m, l, O);
  const float lt = l + __shfl_xor(l, 32); const float inv = lt > 0.f ? 1.0f / lt : 0.f;
  bf16_t* op = p.cat + tok * DM + h * 64;
#pragma unroll
  for (int dt = 0; dt < 2; ++dt)
#pragma unroll
    for (int a = 0; a < 4; ++a) { u32x2 wv; wv.x = cvtpk(O[dt][4 * a] * inv, O[dt][4 * a + 1] * inv); wv.y = cvtpk(O[dt][4 * a + 2] * inv, O[dt][4 * a + 3] * inv);
      *(u32x2*)(op + dt * 32 + 8 * a + 4 * hh) = wv; }
}

__device__ __forceinline__ void xattn_unit(const Params& p, int layer, int b, int hd, int qb, int dh, LAS char* sm) {
  const int tid = otid(), lane = tid & 63, w = tid >> 6, l31 = lane & 31, hh = lane >> 5;
  const int tq = qb * 128 + w * 32 + l31; const long tok = (long)b * SEQ + tq;
  bf16x8 qf[16];
#pragma unroll
  for (int ds = 0; ds < 16; ++ds) qf[ds] = *(const bf16x8*)(p.qx + tok * DM + hd * 256 + ds * 16 + hh * 8);
  SMNone smod; smod.C = 0.0625f * LOG2E;
  float m = -INFINITY, l = 0.f; f32x16 O[4];
#pragma unroll
  for (int dt = 0; dt < 4; ++dt)
#pragma unroll
    for (int r = 0; r < 16; ++r) O[dt][r] = 0.f;
  TLRange tl; tl.n = 4; tl.kv_first = 0;
  const bf16_t* Kb = p.Kmem + ((long)layer * 1024 + b * 256) * DM + hd * 256;
  const bf16_t* Vb = p.Vmem + ((long)layer * 1024 + b * 256) * DM + hd * 256 + dh * 128;
  flash_run<16, 4, false>(sm, sm + 32768, qf, Kb, DM, Vb, DM, tl, smod, m, l, O);
  const float lt = l + __shfl_xor(l, 32); const float inv = 1.0f / lt;
  bf16_t* op = p.ox + tok * DM + hd * 256 + dh * 128;
#pragma unroll
  for (int dt = 0; dt < 4; ++dt)
#pragma unroll
    for (int a = 0; a < 4; ++a) { u32x2 wv; wv.x = cvtpk(O[dt][4 * a] * inv, O[dt][4 * a + 1] * inv); wv.y = cvtpk(O[dt][4 * a + 2] * inv, O[dt][4 * a + 3] * inv);
      *(u32x2*)(op + dt * 32 + 8 * a + 4 * hh) = wv; }
}

#define NSA_SC 16384
#define NSA_UNI 49664
#define NSA_TL 49680
__device__ __forceinline__ void nsa_stageA(const Params& p, int layer, int b, int g, int qb, LAS char* sm) {
  const int tid = otid(), lane = tid & 63, w = tid >> 6, l31 = lane & 31, hh = lane >> 5;
  const int tq = qb * 128 + w * 32 + l31; const long tok = (long)b * SEQ + tq;
  const bf16_t* Pb = p.P + (long)b * SEQ * PW;
  LAS char* Ks = sm; LAS char* Vs = sm + 8192;
  LAS float* sc = (LAS float*)(sm + NSA_SC);
  LAS unsigned* uni = (LAS unsigned*)(sm + NSA_UNI);
  LAS int* tll = (LAS int*)(sm + NSA_TL);
  const bf16_t* kcb = p.kvc + (long)(0 * 8 + b * 2 + g) * 256 * 64;
  const bf16_t* vcb = p.kvc + (long)(1 * 8 + b * 2 + g) * 256 * 64;
  const int ntc = min(4, (8 * qb + 6) / 64 + 1);
  LAS float* myrow = sc + (w * 32 + l31) * 65;
  __syncthreads();
#pragma unroll
  for (int i = 0; i < 32; ++i) myrow[2 * i + hh] = 0.f;
  const float* glp = p.fgl + tok * 32 + 6;
  const float* gbp = p.gate_b + layer * 18;
#pragma unroll 1
  for (int r3 = 0; r3 < 3; ++r3) {
    const int head = 3 * g + r3;
    const float slope2 = exp2f(-8.0f * (float)(head + 1) / 6.0f) * LOG2E;
    bf16x8 qf[4];
#pragma unroll
    for (int ds = 0; ds < 4; ++ds) qf[ds] = *(const bf16x8*)(p.P + tok * PW + 1408 + head * 64 + ds * 16 + hh * 8);
    SMCmp smod; smod.tq = tq; smod.slope2 = slope2; smod.tqmax = qb * 128 + w * 32 + 31;
    float m = -INFINITY, l = 0.f; f32x16 O[2];
#pragma unroll
    for (int r = 0; r < 16; ++r) { O[0][r] = 0.f; O[1][r] = 0.f; }
    TLRange tl; tl.n = ntc; tl.kv_first = 0;
    flash_run<4, 2, true>(Ks, Vs, qf, kcb, 64, vcb, 64, tl, smod, m, l, O);
    const float lt = l + __shfl_xor(l, 32); const float inv = lt > 0.f ? 1.0f / lt : 0.f;
    const float gc = sigmoidf_(glp[head * 3 + 0] + gbp[head * 3 + 0]) * inv;
    float* ob = p.onsa + tok * 384 + head * 64;
#pragma unroll
    for (int dt = 0; dt < 2; ++dt)
#pragma unroll
      for (int a = 0; a < 4; ++a) *(f32x4*)(ob + dt * 32 + 8 * a + 4 * hh) = (f32x4){O[dt][4 * a] * gc, O[dt][4 * a + 1] * gc, O[dt][4 * a + 2] * gc, O[dt][4 * a + 3] * gc};
    const float mu = (m == -INFINITY) ? 0.f : m;
    float e_prev = 0.f;
#pragma unroll
    for (int it = 0; it < 4; ++it) {
      if (it < ntc) {
        __syncthreads();
        { const int pp = tid, pp2 = tid + 256;
          const u32x4 k0 = *(const u32x4*)(kcb + (long)(64 * it + (pp >> 3)) * 64 + (pp & 7) * 8);
          const u32x4 k1 = *(const u32x4*)(kcb + (long)(64 * it + (pp2 >> 3)) * 64 + (pp2 & 7) * 8);
          *(LAS u32x4*)(Ks + (pp >> 3) * 128 + (kswz<4>(pp & 7, pp >> 3) << 4)) = k0;
          *(LAS u32x4*)(Ks + (pp2 >> 3) * 128 + (kswz<4>(pp2 & 7, pp2 >> 3) << 4)) = k1; }
        __syncthreads();
        f32x16 p0, p1;
#pragma unroll
        for (int r = 0; r < 16; ++r) { p0[r] = 0.f; p1[r] = 0.f; }
#pragma unroll
        for (int ds = 0; ds < 4; ++ds) {
          const int so = kswz<4>(2 * ds + hh, l31) << 4;
          const bf16x8 k0 = *(LAS const bf16x8*)(Ks + l31 * 128 + so);
          const bf16x8 k1 = *(LAS const bf16x8*)(Ks + (32 + l31) * 128 + so);
          p0 = __builtin_amdgcn_mfma_f32_32x32x16_bf16(k0, qf[ds], p0, 0, 0, 0);
          p1 = __builtin_amdgcn_mfma_f32_32x32x16_bf16(k1, qf[ds], p1, 0, 0, 0);
        }
        smod.apply(p0, p1, 64 * it, lane);
#pragma unroll
        for (int r = 0; r < 16; ++r) { p0[r] = fexp2(p0[r] - mu) * inv; p1[r] = fexp2(p1[r] - mu) * inv; }
#pragma unroll
        for (int pi = 0; pi < 2; ++pi)
#pragma unroll
          for (int a = 0; a < 4; ++a) {
            const float q0 = pi ? p1[4 * a] : p0[4 * a], q1 = pi ? p1[4 * a + 1] : p0[4 * a + 1], q2 = pi ? p1[4 * a + 2] : p0[4 * a + 2], q3 = pi ? p1[4 * a + 3] : p0[4 * a + 3];
            const float ex = __shfl_xor(q3, 32);
            myrow[2 * (8 * it + 4 * pi + a) + hh] += (q0 + q1) + (q2 + q3) + (hh ? ex : e_prev);
            e_prev = ex;
          }
      }
    }
  }
  __syncthreads();
  {
    const int cur = tq >> 6;
#pragma unroll
    for (int mi = 0; mi < 32; ++mi) {
      const int j = 2 * mi + hh;
      const bool forced = (j == 0) || (j == cur) || (j == cur - 1);
      const float iv = myrow[j];
      myrow[j] = forced ? 1.0e4f : (j <= cur ? iv : -1.0f);
    }
  }
  __syncthreads();
  unsigned mlo = 0u, mhi = 0u;
  if (hh == 0) {
    LAS float* row = sc + (w * 32 + l31) * 65;
    for (int itk = 0; itk < 16; ++itk) {
      float best = -INFINITY; int bi = 0;
      for (int j = 0; j < 64; ++j) { const float v = row[j]; if (v > best) { best = v; bi = j; } }
      row[bi] = -INFINITY;
      if (bi < 32) mlo |= (1u << bi); else mhi |= (1u << (bi - 32));
    }
    *(u32x2*)(p.selm + (tok * 2 + g) * 2) = (u32x2){mlo, mhi};
  }
  __syncthreads();
}

__device__ __forceinline__ void nsa_stageB(const Params& p, int layer, int b, int head, int qb, LAS char* sm) {
  const int tid = otid(), lane = tid & 63, w = tid >> 6, l31 = lane & 31, hh = lane >> 5;
  const int g = head / 3;
  const int tq = qb * 128 + w * 32 + l31; const long tok = (long)b * SEQ + tq;
  const bf16_t* Pb = p.P + (long)b * SEQ * PW;
  LAS char* Ks = sm; LAS char* Vs = sm + 8192;
  LAS unsigned* uni = (LAS unsigned*)(sm + NSA_UNI);
  LAS int* tll = (LAS int*)(sm + NSA_TL);
  const float* glp = p.fgl + tok * 32 + 6;
  const float* gbp = p.gate_b + layer * 18;
  const u32x2 mk = *(const u32x2*)(p.selm + (tok * 2 + g) * 2);
  const unsigned mlo = mk.x, mhi = mk.y;
  __syncthreads();
  if (tid < 2) uni[tid] = 0u;
  __syncthreads();
  if (hh == 0) { __hip_atomic_fetch_or(uni, mlo, __ATOMIC_RELAXED, __HIP_MEMORY_SCOPE_WORKGROUP); __hip_atomic_fetch_or(uni + 1, mhi, __ATOMIC_RELAXED, __HIP_MEMORY_SCOPE_WORKGROUP); }
  __syncthreads();
  if (tid == 0) {
    unsigned long long u = ((unsigned long long)uni[1] << 32) | (unsigned long long)uni[0];
    const int jmax = (qb * 128 + 127) >> 6;
    int n = 0;
    for (int j = 0; j <= jmax; ++j) if ((u >> j) & 1ull) tll[1 + n++] = 64 * j;
    tll[0] = n;
  }
  __syncthreads();
  const int nsel = tll[0];
  const int tqmax = qb * 128 + w * 32 + 31;
  {
    const float slope2 = exp2f(-8.0f * (float)(head + 1) / 6.0f) * LOG2E;
    bf16x8 qf[4];
#pragma unroll
    for (int ds = 0; ds < 4; ++ds) qf[ds] = *(const bf16x8*)(p.P + tok * PW + 1408 + head * 64 + ds * 16 + hh * 8);
    f32x16 acc[2];
    {
      SMSel smod; smod.tq = tq; smod.slope2 = slope2; smod.mlo = mlo; smod.mhi = mhi; smod.tqmax = tqmax;
      float m = -INFINITY, l = 0.f; f32x16 O[2];
#pragma unroll
      for (int r = 0; r < 16; ++r) { O[0][r] = 0.f; O[1][r] = 0.f; }
      TLList tl; tl.n = nsel; tl.lst = tll + 1;
      flash_run<4, 2, true>(Ks, Vs, qf, Pb + 2048 + g * 64, PW, Pb + 2176 + g * 64, PW, tl, smod, m, l, O);
      const float lt = l + __shfl_xor(l, 32); const float inv = lt > 0.f ? 1.0f / lt : 0.f;
      const float gs = sigmoidf_(glp[head * 3 + 1] + gbp[head * 3 + 1]) * inv;
#pragma unroll
      for (int r = 0; r < 16; ++r) { acc[0][r] = O[0][r] * gs; acc[1][r] = O[1][r] * gs; }
    }
    {
      SMWin smod; smod.tq = tq; smod.slope2 = slope2; smod.tqmax = tqmax;
      float m = -INFINITY, l = 0.f; f32x16 O[2];
#pragma unroll
      for (int r = 0; r < 16; ++r) { O[0][r] = 0.f; O[1][r] = 0.f; }
      const int kvf = max(0, qb * 128 - 512);
      TLRange tl; tl.kv_first = kvf; tl.n = (qb * 128 + 128 - kvf) >> 6;
      flash_run<4, 2, true>(Ks, Vs, qf, Pb + 2304 + g * 64, PW, Pb + 2432 + g * 64, PW, tl, smod, m, l, O);
      const float lt = l + __shfl_xor(l, 32); const float inv = lt > 0.f ? 1.0f / lt : 0.f;
      const float gw = sigmoidf_(glp[head * 3 + 2] + gbp[head * 3 + 2]) * inv;
      const float* ob = p.onsa + tok * 384 + head * 64;
      bf16_t* op = p.cat + tok * DM + 640 + head * 64;
#pragma unroll
      for (int dt = 0; dt < 2; ++dt)
#pragma unroll
        for (int a = 0; a < 4; ++a) {
          const f32x4 oc = *(const f32x4*)(ob + dt * 32 + 8 * a + 4 * hh);
          u32x2 wv; wv.x = cvtpk(O[dt][4 * a] * gw + acc[dt][4 * a] + oc[0], O[dt][4 * a + 1] * gw + acc[dt][4 * a + 1] + oc[1]);
          wv.y = cvtpk(O[dt][4 * a + 2] * gw + acc[dt][4 * a + 2] + oc[2], O[dt][4 * a + 3] * gw + acc[dt][4 * a + 3] + oc[3]);
          *(u32x2*)(op + dt * 32 + 8 * a + 4 * hh) = wv;
        }
    }
  }
  __syncthreads();
}

__device__ __forceinline__ void pool_unit(const Params& p, int layer, int b, int tb, int g, LAS char* sm) {
  const int tid = otid();
  LAS float* u = (LAS float*)sm;
  LAS float* W = (LAS float*)(sm + 20480);
  LAS float* pl = (LAS float*)(sm + 36864);
  const int t0 = tb * 64;
  const int wsz = 2 << g;
  __syncthreads();
  for (int i = tid; i < 79 * 64; i += 256) { const int rr = i >> 6, c = i & 63; const int t = t0 - 15 + rr;
    u[i] = (t >= 0) ? bf2f(p.P[((long)b * SEQ + t) * PW + 1152 + g * 64 + c]) : 0.f; }
  for (int i = tid; i < 4096; i += 256) W[i] = p.pool_w[((long)layer * 4 + g) * 4096 + i];
  __syncthreads();
  for (int i = tid; i < 4096; i += 256) { const int tl = i >> 6, c = i & 63; const int t = t0 + tl;
    float s = 0.f; for (int k = 0; k < wsz; ++k) s += u[(tl + 15 - k) * 64 + c];
    const float cnt = (float)min(t + 1, wsz);
    pl[i] = s / cnt - u[(tl + 15) * 64 + c]; }
  __syncthreads();
  { const int d = tid & 63, tg = tid >> 6;
    const float scl = p.pool_scale[layer * 256 + g * 64 + d];
    float o[16];
#pragma unroll
    for (int i = 0; i < 16; ++i) o[i] = 0.f;
    for (int c = 0; c < 64; ++c) { const float wv = W[c * 64 + d];
#pragma unroll
      for (int i = 0; i < 16; ++i) o[i] += pl[(tg * 16 + i) * 64 + c] * wv; }
#pragma unroll
    for (int i = 0; i < 16; ++i) p.cat[((long)b * SEQ + t0 + tg * 16 + i) * DM + 384 + g * 64 + d] = f2bf(o[i] * scl); }
}

__device__ __forceinline__ void cum_unit(const Params& p, int layer, int b, int h, LAS char* sm) {
  const int tid = otid();
  LAS float* part = (LAS float*)sm;
  const float bf = p.fox_b[layer * 6 + h];
  float v[16]; float s = 0.f;
#pragma unroll
  for (int i = 0; i < 16; ++i) { const int t = tid * 16 + i; const float z = p.fgl[((long)b * SEQ + t) * 32 + h] + bf;
    const float ls = fminf(z, 0.f) - log1pf(__expf(-fabsf(z))); s += ls; v[i] = s; }
  __syncthreads();
  part[tid] = s;
  __syncthreads();
  if (tid == 0) { float a = 0.f; for (int i = 0; i < 256; ++i) { const float t = part[i]; part[i] = a; a += t; } }
  __syncthreads();
  const float base = part[tid];
#pragma unroll
  for (int i = 0; i < 16; ++i) p.cum[(long)(b * 6 + h) * SEQ + tid * 16 + i] = (base + v[i]) * LOG2E;
  __syncthreads();
}

#define GSYNC() xcd_barrier(xb)
#ifndef SKIPMASK
#define SKIPMASK 0
#endif
#define PH(n) if (!((SKIPMASK >> (n)) & 1))
#define REP(n) for (int rep_ = 0; rep_ < ((((DUPMASK) >> (n)) & 1) ? 2 : 1); ++rep_)
__global__ void __launch_bounds__(256, 2) fwd_kernel(Params p) {
  __shared__ __attribute__((aligned(16))) char smem_raw[65536];
  __shared__ uint4 xb_words;
  __shared__ __attribute__((aligned(16))) int xs_raw[320];
  LAS char* sm = (LAS char*)smem_raw;
  LAS int* xs = (LAS int*)xs_raw;
  const int tid = otid(); const int bid = blockIdx.x, nb = gridDim.x;
  if (p.never) cg::this_grid().sync();
  if (tid == 0) xb_words = make_uint4(0u, 0u, 0u, 0u);
  __syncthreads();
  XcdBarrier xb = xcd_barrier_post(p.bar, (volatile LAS unsigned*)&xb_words);

  REP(0) PH(0) for (int t = bid; t < p.ttiles; t += nb) {
    int ji = 0;
#pragma unroll
    for (int q = 1; q < NJOBS; ++q) if (t >= p.jobs[q].tile0) ji = q;
    transpose_tile(p.jobs[ji], t - p.jobs[ji].tile0, sm);
  }
  PH(1) {
    const long gt = (long)bid * 256 + tid, gs = (long)nb * 256;
    for (long i = gt; i < 2L * 104 * 1024 / 8; i += gs) { const long l = i / (104 * 128), rem = i % (104 * 128); *(u32x4*)(p.WinT + (l * 2688 + 2584) * 1024 + rem * 8) = (u32x4){0u, 0u, 0u, 0u}; }
    for (long i = gt; i < 2L * 108 * 1024 / 8; i += gs) { const long l = i / (108 * 128), rem = i % (108 * 128); *(u32x4*)(p.WrT + (l * 128 + 20) * 1024 + rem * 8) = (u32x4){0u, 0u, 0u, 0u}; }
    if (gt < 64) { p.mcnt[gt] = 0; p.wq[gt] = 0; }
    if (gt < 1024) { const int l = (int)(gt >> 9), kv = (int)((gt >> 8) & 1), n = (int)(gt & 255);
      const float* pe = (kv ? p.pe_v : p.pe_k) + l * 2048; const float* w1 = (kv ? p.w1v : p.w1k) + (long)l * 2048 * 256 + n;
      float s = 0.f; for (int k = 0; k < 2048; ++k) s += pe[k] * w1[(long)k * 256];
      p.bias1[gt] = s; }
  }
  if ((DUPMASK >> 1) & 1) { for (int q = 0; q < 10; ++q) GSYNC(); }
  PH(2) rownorm<false>(p.mem, p.mem_g, p.memn, 1024);
  rownorm<false>(p.mem, p.mem_g + DM, p.memn + 1024 * DM, 1024);
  rownorm<false>(p.x_in, p.mix_g, p.hb, NTOK);
  GSYNC();

  for (int layer = 0; layer < 2; ++layer) {
    const float* xsrc = layer == 0 ? p.x_in : p.xw;
    REP(3) PH(3) {
      const int nmain = 128 * 21, nextra = layer == 0 ? 256 : 0;
      for (int it = bid; it < nmain + nextra; it += nb) {
        if (it < nmain) {
          const int nt = it / 128, mt = it % 128;
          RowDense af{p.hb + (long)mt * 128 * DM, DM, 64};
          RowDense bf{p.WinT + ((long)layer * 2688 + nt * 128) * DM, DM, 64};
          EpiInproj ep{p.P, p.fgl, mt, nt};
          gemm_tile(sm, 16, af, bf, ep);
        } else {
          const int e = it - nmain; const int l2 = e >> 7, kv = (e >> 6) & 1, mt = (e >> 3) & 7, nt = e & 7;
          RowDense af{p.memn + ((long)l2 * 1024 + mt * 128) * DM, DM, 64};
          RowDense bf{(kv ? p.WvT : p.WkT) + ((long)l2 * 1024 + nt * 128) * DM, DM, 64};
          EpiBf16 ep{(kv ? p.Vmem : p.Kmem) + (long)l2 * 1024 * DM, DM, mt * 128, nt * 128};
          gemm_tile(sm, 16, af, bf, ep);
        }
      }
    }
    GSYNC();
    REP(4) PH(4) {
      const int n_cum = 24, n_c1 = 64, n_pool = 1024;
      for (int it = bid; it < n_cum + n_c1 + n_pool; it += nb) {
        if (it < n_cum) cum_unit(p, layer, it / 6, it % 6, sm);
        else if (it < n_cum + n_c1) {
          const int e = it - n_cum; const int kv = e >> 5, mt = (e >> 1) & 15, nt = e & 1;
          RowCmp af{p.P + (kv ? 1920 : 1792), mt * 128};
          RowDense bf{p.W1T + (((long)layer * 2 + kv) * 256 + nt * 128) * 2048, 2048, 64};
          EpiCmp1 ep{p.hid + (long)kv * 2048 * 256, p.bias1 + (layer * 2 + kv) * 256, mt * 128, nt * 128};
          gemm_tile(sm, 32, af, bf, ep);
        } else { const int e = it - n_cum - n_c1; pool_unit(p, layer, e >> 8, (e >> 2) & 63, e & 3, sm); }
      }
    }
    GSYNC();
    PH(5) for (int it = bid; it < 32; it += nb) {
      const int kv = it >> 4, mt = it & 15;
      RowDense af{p.hid + ((long)kv * 2048 + mt * 128) * 256, 256, 64};
      RowWrap64 bf{p.W2T + ((long)layer * 2 + kv) * 64 * 256, 256};
      EpiCmp2 ep{p.kvc + (long)kv * 2048 * 64, mt * 128};
      gemm_tile(sm, 4, af, bf, ep);
    }
    GSYNC();
    REP(6) {
      int* ctr = p.wq + layer * 8 + rep_ * 2;
      for (;;) {
        __syncthreads();
        if (tid == 0) xs[0] = atomicAdd(ctr, 1);
        __syncthreads();
        const int it = xs[0];
        if (it >= 784) break;
        if (it < 312) { const int qb = 31 - it / 24, bh = it % 24; fox_unit(p, bh / 6, bh % 6, qb, sm); }
        else if (it < 568) { const int e = it - 312; const int qb = 31 - (e >> 3), bg = e & 7; nsa_stageA(p, layer, bg >> 1, bg & 1, qb, sm); }
        else { const int e = it - 568; const int qb = 18 - e / 24, bh = e % 24; fox_unit(p, bh / 6, bh % 6, qb, sm); }
      }
    }
    GSYNC();
    REP(6) {
      int* ctr = p.wq + layer * 8 + 4 + rep_ * 2;
      for (;;) {
        __syncthreads();
        if (tid == 0) xs[0] = atomicAdd(ctr, 1);
        __syncthreads();
        const int it = xs[0];
        if (it >= 1008) break;
        if (it < 384) { const int qb = 31 - it / 12, e = it % 12; nsa_stageB(p, layer, e / 3, 3 + e % 3, qb, sm); }
        else if (it < 768) { const int e2 = it - 384; const int qb = 31 - e2 / 12, e = e2 % 12; nsa_stageB(p, layer, e / 3, e % 3, qb, sm); }
        else { const int e = it - 768; const int qb = 9 - e / 24, bh = e % 24; fox_unit(p, bh / 6, bh % 6, qb, sm); }
      }
    }
    GSYNC();
    PH(7) for (int it = bid; it < 1024; it += nb) {
      const int nt = it >> 7, mt = it & 127;
      RowDense af{p.cat + (long)mt * 128 * DM, DM, 64};
      RowDense bf{p.WoutT + ((long)layer * 1024 + nt * 128) * DM, DM, 64};
      EpiResid ep{xsrc, p.xw, mt * 128, nt * 128};
      gemm_tile(sm, 16, af, bf, ep);
    }
    GSYNC();
    REP(2) rownorm<false>(p.xw, p.xattn_g + layer * DM, p.hb, NTOK);
    GSYNC();
    REP(8) PH(8) for (int it = bid; it < 1024; it += nb) {
      const int nt = it >> 7, mt = it & 127;
      RowDense af{p.hb + (long)mt * 128 * DM, DM, 64};
      RowDense bf{p.WqT + ((long)layer * 1024 + nt * 128) * DM, DM, 64};
      EpiBf16 ep{p.qx, DM, mt * 128, nt * 128};
      gemm_tile(sm, 16, af, bf, ep);
    }
    GSYNC();
#ifndef NO_XATTN
    REP(5) for (int it = bid; it < 1024; it += nb) { const int dh = it & 1, hd = (it >> 1) & 3, b = (it >> 3) & 3, qb = it >> 5; xattn_unit(p, layer, b, hd, qb, dh, sm); }
#endif
    GSYNC();
    PH(9) for (int it = bid; it < 1024; it += nb) {
      const int nt = it >> 7, mt = it & 127;
      RowDense af{p.ox + (long)mt * 128 * DM, DM, 64};
      RowDense bf{p.WoT + ((long)layer * 1024 + nt * 128) * DM, DM, 64};
      EpiResid ep{p.xw, p.xw, mt * 128, nt * 128};
      gemm_tile(sm, 16, af, bf, ep);
    }
    GSYNC();
    REP(2) rownorm<false>(p.xw, p.ffn_g + layer * DM, p.hb, NTOK);
    GSYNC();
    PH(10) for (int mt = bid; mt < 128; mt += nb) {
      RowDense af{p.hb + (long)mt * 128 * DM, DM, 64};
      RowDense bf{p.WrT + (long)layer * 128 * DM, DM, 64};
      LAS float* lg = (LAS float*)sm;
      EpiRouter ep{lg};
      gemm_tile(sm, 16, af, bf, ep);
      __syncthreads();
      if (tid < 128) {
        const int tok = mt * 128 + tid;
        float c[4], f[4];
#pragma unroll
        for (int i = 0; i < 4; ++i) c[i] = lg[tid * 20 + i] + p.rc_b[layer * 4 + i];
        int grp = 0; float cm = c[0];
#pragma unroll
        for (int i = 1; i < 4; ++i) if (c[i] > cm) { cm = c[i]; grp = i; }
        float cs = 0.f;
#pragma unroll
        for (int i = 0; i < 4; ++i) cs += __expf(c[i] - cm);
        const float wgrp = 1.0f / cs;
#pragma unroll
        for (int i = 0; i < 4; ++i) f[i] = lg[tid * 20 + 4 + grp * 4 + i] + p.rf_b[layer * 16 + grp * 4 + i];
        int i1 = 0; float f1 = f[0];
#pragma unroll
        for (int i = 1; i < 4; ++i) if (f[i] > f1) { f1 = f[i]; i1 = i; }
        int i2 = -1; float f2 = -INFINITY;
#pragma unroll
        for (int i = 0; i < 4; ++i) if (i != i1 && f[i] > f2) { f2 = f[i]; i2 = i; }
        const float e2 = __expf(f2 - f1);
        const float w1 = wgrp / (1.0f + e2), w2 = wgrp * e2 / (1.0f + e2);
        const int a = i1 < i2 ? i1 : i2, bq = i1 < i2 ? i2 : i1;
        const float wa = i1 < i2 ? w1 : w2, wb = i1 < i2 ? w2 : w1;
        const int pairidx = (a == 0) ? (bq - 1) : (a == 1 ? bq + 1 : 5);
        const int cls = grp * 6 + pairidx;
        const int pos = atomicAdd(&p.mcnt[layer * 32 + cls], 1);
        p.mlist[((long)layer * 24 + cls) * NTOK + pos] = tok;
        p.tokw[tok * 2 + 0] = wa; p.tokw[tok * 2 + 1] = wb;
      }
      __syncthreads();
    }
    GSYNC();
    PH(11) {
      LAS int* tstart = (LAS int*)xs;
      LAS int* ccnt = (LAS int*)xs + 32;
      LAS int* toks = (LAS int*)xs + 64;
      LAS float* wts = (LAS float*)xs + 192;
      __syncthreads();
      if (tid == 0) { int a = 0; for (int c = 0; c < 24; ++c) { const int n = p.mcnt[layer * 32 + c]; ccnt[c] = n; tstart[c] = a; a += (n + 127) >> 7; } tstart[24] = a; }
      __syncthreads();
      const int nrt = tstart[24];
      for (int pass = 0; pass < 2; ++pass) {
        const int nct = pass == 0 ? 16 : 8;
        for (int it = bid; it < nrt * nct; it += nb) {
          const int rt = it / nct, ct = it % nct;
          int cls = 0;
          for (int c = 1; c < 24; ++c) if (rt >= tstart[c]) cls = c;
          const int rtl = rt - tstart[cls];
          const int grp = cls / 6, pi = cls % 6;
          const int ea = grp * 4 + (pi < 3 ? 0 : (pi < 5 ? 1 : 2)), eb = grp * 4 + (pi < 3 ? pi + 1 : (pi < 5 ? pi - 1 : 3));
          __syncthreads();
          if (tid < 128) { const int idx = rtl * 128 + tid; const bool ok = idx < ccnt[cls];
            const int tk = ok ? p.mlist[((long)layer * 24 + cls) * NTOK + idx] : -1; toks[tid] = tk;
            wts[tid] = ok ? p.tokw[tk * 2 + (ct < 8 ? 0 : 1)] : 0.f; }
          __syncthreads();
          if (pass == 0) REP(7) {
            const int ex = ct < 8 ? ea : eb;
            RowGather af{p.hb, DM, toks};
            RowDense bf{p.WguT + (((long)layer * 16 + ex) * 1024 + (ct & 7) * 128) * DM, DM, 64};
            EpiMoeUp ep{p.he, (long)rt * 128, (ct < 8 ? 0 : 512) + (ct & 7) * 64, wts};
            gemm_tile(sm, 16, af, bf, ep);
          } else {
            RowDense af{p.he + (long)rt * 128 * DM, DM, 64};
            const bf16_t* ba = p.WdT + (((long)layer * 16 + ea) * 1024 + ct * 128) * 512;
            const bf16_t* bb = p.WdT + (((long)layer * 16 + eb) * 1024 + ct * 128) * 512;
            RowSplit bf{ba, 512, (long)(bb - ba)};
            EpiMoeDown ep{p.xw, ct * 128, toks};
            gemm_tile(sm, 16, af, bf, ep);
          }
        }
        GSYNC();
      }
    }
    if (layer == 0) { rownorm<false>(p.xw, p.mix_g + DM, p.hb, NTOK); GSYNC(); }
  }
  rownorm<true>(p.xw, p.final_g, p.xw, NTOK);
}

static inline size_t al256(size_t x) { return (x + 255) & ~(size_t)255; }
extern "C" void kernel_launch(void* const* d_in, const int* in_sizes, int n_in, void* d_out, int out_size, void* d_ws, size_t ws_size, hipStream_t stream) {
  Params p; memset(&p, 0, sizeof(p));
  const float* const* in = (const float* const*)d_in;
  p.x_in = in[0]; p.mem = in[1]; p.mix_g = in[2]; p.fox_b = in[4]; p.pool_w = in[5]; p.pool_scale = in[6]; p.pe_k = in[7]; p.pe_v = in[8];
  p.w1k = in[9]; p.w1v = in[11]; p.gate_b = in[13]; p.xattn_g = in[15]; p.mem_g = in[16]; p.ffn_g = in[21]; p.rc_b = in[23]; p.rf_b = in[25]; p.final_g = in[29];
  p.xw = (float*)d_out;
  char* ws = (char*)d_ws; size_t off = 0;
  auto take = [&](size_t bytes) { char* r = ws + off; off = al256(off + bytes); return r; };
  p.bar = (unsigned*)take(XCD_BAR_WORDS * 4);
  p.mcnt = (int*)take(64 * 4);
  p.wq = (int*)take(64 * 4);
  p.WinT = (bf16_t*)take(2UL * 2688 * 1024 * 2);
  p.WoutT = (bf16_t*)take(2UL * 1024 * 1024 * 2);
  p.WqT = (bf16_t*)take(2UL * 1024 * 1024 * 2);
  p.WkT = (bf16_t*)take(2UL * 1024 * 1024 * 2);
  p.WvT = (bf16_t*)take(2UL * 1024 * 1024 * 2);
  p.WoT = (bf16_t*)take(2UL * 1024 * 1024 * 2);
  p.WguT = (bf16_t*)take(2UL * 16 * 1024 * 1024 * 2);
  p.WdT = (bf16_t*)take(2UL * 16 * 1024 * 512 * 2);
  p.W1T = (bf16_t*)take(2UL * 2 * 256 * 2048 * 2);
  p.W2T = (bf16_t*)take(2UL * 2 * 64 * 256 * 2);
  p.WrT = (bf16_t*)take(2UL * 128 * 1024 * 2);
  p.bias1 = (float*)take(1024 * 4);
  p.hb = (bf16_t*)take((size_t)NTOK * 1024 * 2);
  p.onsa = (float*)p.hb;
  p.P = (bf16_t*)take((size_t)NTOK * PW * 2);
  p.qx = p.P;
  p.ox = p.P + (size_t)NTOK * 1024;
  p.he = p.P;
  p.cat = (bf16_t*)take((size_t)NTOK * 1024 * 2);
  p.memn = (bf16_t*)take(2UL * 1024 * 1024 * 2);
  p.Kmem = (bf16_t*)take(2UL * 1024 * 1024 * 2);
  p.Vmem = (bf16_t*)take(2UL * 1024 * 1024 * 2);
  p.hid = (bf16_t*)take(2UL * 2048 * 256 * 2);
  p.kvc = (bf16_t*)take(2UL * 2048 * 64 * 2);
  p.fgl = (float*)take((size_t)NTOK * 32 * 4);
  p.cum = (float*)take(24UL * SEQ * 4);
  p.tokw = (float*)take((size_t)NTOK * 2 * 4);
  p.mlist = (int*)take(2UL * 24 * NTOK * 4);
  p.selm = (unsigned*)take((size_t)NTOK * 2 * 2 * 4);
  int nj = 0, tile0 = 0;
  auto job = [&](const float* src, bf16_t* dst, long sbs, long dbs, int K, int N, int lds, int ldd, int map, int nbatch) {
    TJob& j = p.jobs[nj++]; j.src = src; j.dst = dst; j.sbs = sbs; j.dbs = dbs; j.K = K; j.N = N; j.lds = lds; j.ldd = ldd; j.map = map;
    j.tpb = (K / 64) * ((N + 63) / 64); j.tile0 = tile0; j.pad = 0; tile0 += j.tpb * nbatch; };
  job(in[26], p.WguT, 1024L * 512, 1024L * 1024, 1024, 512, 512, 1024, 2, 32);
  job(in[27], p.WguT, 1024L * 512, 1024L * 1024, 1024, 512, 512, 1024, 3, 32);
  job(in[28], p.WdT, 512L * 1024, 1024L * 512, 512, 1024, 1024, 512, 0, 32);
  job(in[3], p.WinT, 1024L * 2584, 2688L * 1024, 1024, 2584, 2584, 1024, 1, 2);
  job(in[14], p.WoutT, 1024L * 1024, 1024L * 1024, 1024, 1024, 1024, 1024, 0, 2);
  job(in[17], p.WqT, 1024L * 1024, 1024L * 1024, 1024, 1024, 1024, 1024, 0, 2);
  job(in[18], p.WkT, 1024L * 1024, 1024L * 1024, 1024, 1024, 1024, 1024, 0, 2);
  job(in[19], p.WvT, 1024L * 1024, 1024L * 1024, 1024, 1024, 1024, 1024, 0, 2);
  job(in[20], p.WoT, 1024L * 1024, 1024L * 1024, 1024, 1024, 1024, 1024, 0, 2);
  job(in[9], p.W1T, 2048L * 256, 2L * 256 * 2048, 2048, 256, 256, 2048, 0, 2);
  job(in[11], p.W1T + 256L * 2048, 2048L * 256, 2L * 256 * 2048, 2048, 256, 256, 2048, 0, 2);
  job(in[10], p.W2T, 256L * 64, 2L * 64 * 256, 256, 64, 64, 256, 0, 2);
  job(in[12], p.W2T + 64L * 256, 256L * 64, 2L * 64 * 256, 256, 64, 64, 256, 0, 2);
  job(in[22], p.WrT, 1024L * 4, 128L * 1024, 1024, 4, 4, 1024, 0, 2);
  job(in[24], p.WrT + 4L * 1024, 1024L * 16, 128L * 1024, 1024, 16, 16, 1024, 0, 2);
  p.ttiles = tile0; p.never = 0;
  static int grid_blocks = 0;
  if (!grid_blocks) {
    int dev = 0, cus = 0, per_cu = 0;
    hipGetDevice(&dev);
    hipDeviceGetAttribute(&cus, hipDeviceAttributeMultiprocessorCount, dev);
    hipOccupancyMaxActiveBlocksPerMultiprocessor(&per_cu, fwd_kernel, 256, 0);
    if (per_cu > 2) per_cu = 2;
    if (per_cu < 1) per_cu = 1;
    grid_blocks = cus * per_cu;
  }
  hipMemsetAsync(p.bar, 0, XCD_BAR_WORDS * 4, stream);
  void* args[] = {&p};
  hipError_t e = hipLaunchCooperativeKernel((void*)fwd_kernel, dim3(grid_blocks), dim3(256), args, 0, stream);
  if (e != hipSuccess) fprintf(stderr, "cooperative launch failed: %s (grid %d, ws needed %zu of %zu)\n", hipGetErrorString(e), grid_blocks, off, ws_size);
}
```

```cpp
#define DUPMASK 0
#define SPINMASK 0ull
#define SPINMUL 8
#define QEXP 0
#include <hip/hip_runtime.h>
#include <hip/hip_cooperative_groups.h>
#include <cstdint>
#include <cstdio>
#include <cstring>
namespace cg = cooperative_groups;

#define LAS __attribute__((address_space(3)))
typedef unsigned short bf16_t;
typedef short bf16x8 __attribute__((ext_vector_type(8)));
typedef short s16x4 __attribute__((ext_vector_type(4)));
typedef float f32x16 __attribute__((ext_vector_type(16)));
typedef float f32x4 __attribute__((ext_vector_type(4)));
typedef float f32x2 __attribute__((ext_vector_type(2)));
typedef unsigned u32x4 __attribute__((ext_vector_type(4)));
typedef unsigned u32x2 __attribute__((ext_vector_type(2)));
typedef __bf16 bf16x2_t __attribute__((ext_vector_type(2)));

#define NTOK 16384
#define SEQ 4096
#define DM 1024
#define PW 2560
#define LOG2E 1.4426950408889634f

__device__ __forceinline__ unsigned cvtpk(float lo, float hi) { f32x2 v = {lo, hi}; bf16x2_t b = __builtin_convertvector(v, bf16x2_t); return __builtin_bit_cast(unsigned, b); }
__device__ __forceinline__ bf16_t f2bf(float x) { return (bf16_t)(cvtpk(x, 0.f) & 0xffffu); }
__device__ __forceinline__ float bf2f(bf16_t b) { return __uint_as_float(((unsigned)b) << 16); }
__device__ __forceinline__ int crow(int r, int hi) { return (r & 3) + 8 * (r >> 2) + 4 * hi; }
__device__ __forceinline__ float fexp2(float x) { return __builtin_amdgcn_exp2f(x); }
extern __shared__ __attribute__((aligned(16))) unsigned char lds_dyn[];
#define LDS_XS 131072
#define LDS_XB 135168
#define LDS_TB 135232
#define LDS_BYTES 135424
__device__ __forceinline__ int otid() { int t = threadIdx.x & 255; asm volatile("" : "+v"(t)); return t; }
__device__ __forceinline__ int otid512() { int t = threadIdx.x; asm volatile("" : "+v"(t)); return t; }
__device__ __forceinline__ int team_id() { return __builtin_amdgcn_readfirstlane((int)(threadIdx.x >> 8)); }
__device__ __forceinline__ int vbid() { return blockIdx.x * 2 + team_id(); }
__device__ __forceinline__ int nvb() { return gridDim.x * 2; }
__device__ __forceinline__ void team_sync() {
  asm volatile("s_waitcnt lgkmcnt(0)" ::: "memory");
  LAS unsigned* ctr = (LAS unsigned*)((LAS char*)lds_dyn + LDS_TB + team_id() * 64);
  unsigned old = 0u;
  if ((threadIdx.x & 63) == 0) old = __hip_atomic_fetch_add(ctr, 1u, __ATOMIC_RELAXED, __HIP_MEMORY_SCOPE_WORKGROUP);
  old = __builtin_amdgcn_readfirstlane(old);
  const unsigned tgt = (old & ~3u) + 4u;
  while ((int)(__hip_atomic_load(ctr, __ATOMIC_RELAXED, __HIP_MEMORY_SCOPE_WORKGROUP) - tgt) < 0) __builtin_amdgcn_s_sleep(0);
  asm volatile("" ::: "memory");
}
#define TSYNC() team_sync()
__device__ __forceinline__ float sigmoidf_(float x) { return 1.0f / (1.0f + __expf(-x)); }

struct TJob { const float* src; bf16_t* dst; const float* g; long sbs, dbs; int K, N, lds, ldd, map, tpb, tile0, gdiv; };
#define NJOBS 15
struct Params {
  const float *x_in, *mem, *mix_g, *fox_b, *pool_w, *pool_scale, *pe_k, *pe_v, *w1k, *w1v, *w2k, *w2v, *gate_b;
  const float *xattn_g, *mem_g, *ffn_g, *rc_b, *rf_b, *final_g;
  float* xw;
  bf16_t *WinT, *WoutT, *WqT, *WkT, *WvT, *WoT, *WguT, *WdT, *W1T, *W2T, *WrT;
  float* bias1;
  bf16_t *hb, *P, *cat, *memn, *Kmem, *Vmem, *hid, *kvc, *qx, *ox, *he;
  float *fgl, *cum, *onsa, *tokw, *hidp, *rpart, *ssq;
  int *mlist, *mcnt, *wq;
  unsigned* selm;
  unsigned* bar;
  TJob jobs[NJOBS];
  int ttiles; int never;
};

#define XB_TMO      128
#define XB_XCNT(j)  (256  + 64 * (j))
#define XB_XSUB(j)  (1280 + 64 * (j))
#define XB_XGEN(j)  (2304 + 64 * (j))
#define XB_TOP      3328
#define XB_TOPGEN   3392
#define XCD_BAR_WORDS 3456
#define XB_SPIN_CAP (1u << 22)
__device__ __forceinline__ unsigned xb_ld(unsigned* p)              { return __hip_atomic_load(p, __ATOMIC_RELAXED, __HIP_MEMORY_SCOPE_AGENT); }
__device__ __forceinline__ unsigned xb_add(unsigned* p, unsigned v) { return __hip_atomic_fetch_add(p, v, __ATOMIC_RELAXED, __HIP_MEMORY_SCOPE_AGENT); }
__device__ __forceinline__ unsigned xb_xcc_id() { return (unsigned)__builtin_amdgcn_s_getreg((3 << 11) | 20) & 0xFu; }
#define XB_SPIN(cond, bar) do { unsigned _sp = 0; while (cond) { __builtin_amdgcn_s_sleep(1); \
    if ((++_sp & 255u) == 0u) { if (xb_ld(&(bar)[XB_TMO])) break; if (_sp > XB_SPIN_CAP) { atomicAdd(&(bar)[XB_TMO], 1u); break; } } } } while (0)
struct XcdBarrier { unsigned* bar; unsigned x; volatile LAS unsigned* st; };
__device__ __forceinline__ XcdBarrier xcd_barrier_post(unsigned* bar, volatile LAS unsigned* st) {
    XcdBarrier b; b.bar = bar; b.x = xb_xcc_id(); b.st = st;
    if (threadIdx.x == 0) (void)xb_add(&bar[XB_XCNT(b.x)], 1u);
    return b;
}
__device__ __forceinline__ void xcd_barrier_complete(unsigned* bar, unsigned x, unsigned& nloc, unsigned& nx) {
    const unsigned G = gridDim.x * gridDim.y * gridDim.z;
    unsigned sum, cnt, mine, sp = 0u;
    for (;;) {
        sum = 0u; cnt = 0u; mine = 0u;
#pragma unroll
        for (unsigned j = 0; j < 16; ++j) { const unsigned c = xb_ld(&bar[XB_XCNT(j)]); sum += c; cnt += (c > 0u) ? 1u : 0u; mine = (j == x) ? c : mine; }
        if (sum == G) break;
        __builtin_amdgcn_s_sleep(1);
        if ((++sp & 255u) == 0u) { if (xb_ld(&bar[XB_TMO])) break; if (sp > XB_SPIN_CAP) { atomicAdd(&bar[XB_TMO], 1u); break; } }
    }
    nloc = mine > 0u ? mine : 1u; nx = cnt > 0u ? cnt : 1u;
}
__device__ __forceinline__ void xcd_barrier(const XcdBarrier& b) {
    asm volatile("s_waitcnt vmcnt(0)" ::: "memory");
    __syncthreads();
    if (threadIdx.x == 0) {
        unsigned* bar = b.bar;
        unsigned bx = __builtin_amdgcn_readfirstlane(b.x); asm volatile("" : "+s"(bx));
        __builtin_amdgcn_s_waitcnt(0);
        unsigned nloc = b.st[0], nx = b.st[1];
        if (nloc == 0u) { xcd_barrier_complete(bar, bx, nloc, nx); b.st[0] = nloc; b.st[1] = nx; }
        const unsigned old = xb_add(&bar[XB_XSUB(bx)], 1u);
        const unsigned gen = old / nloc;
        if (old + 1u == (gen + 1u) * nloc) {
            __builtin_amdgcn_fence(__ATOMIC_RELEASE, "agent");
            asm volatile("s_waitcnt vmcnt(0)" ::: "memory");
            const unsigned og = xb_add(&bar[XB_TOP], 1u);
            const unsigned tg = og / nx;
            if (og + 1u == (tg + 1u) * nx) xb_add(&bar[XB_TOPGEN], 1u);
            else XB_SPIN(xb_ld(&bar[XB_TOPGEN]) == tg, bar);
            __builtin_amdgcn_fence(__ATOMIC_ACQUIRE, "agent");
            xb_add(&bar[XB_XGEN(bx)], 1u);
            asm volatile("s_waitcnt vmcnt(0)" ::: "memory");
        } else {
            XB_SPIN(xb_ld(&bar[XB_XGEN(bx)]) == gen, bar);
            __builtin_amdgcn_fence(__ATOMIC_ACQUIRE, "agent");
            asm volatile("s_waitcnt vmcnt(0)" ::: "memory");
        }
    }
    __syncthreads();
}

__device__ __forceinline__ int nmap(int map, int n) {
  if (map == 1) { if (n < 1152) return n; if (n < 1158) return 2560 + (n - 1152); if (n < 2566) return n - 6; return n; }
  if (map == 2) return 64 * (n >> 5) + (n & 31);
  if (map == 3) return 64 * (n >> 5) + 32 + (n & 31);
  return n;
}
__device__ __forceinline__ void transpose_tile(const TJob& j, int t, LAS char* sm) {
  const int tid = otid();
  const int tb = t / j.tpb, tt = t - tb * j.tpb;
  const int nkt = j.K >> 6;
  const int kt = tt % nkt, nt = tt / nkt;
  const float* src = j.src + (long)tb * j.sbs + (long)(kt * 64) * j.lds + nt * 64;
  bf16_t* dst = j.dst + (long)tb * j.dbs;
  LAS float* tile = (LAS float*)sm;
  {
    const int tk = tid >> 4, tn4 = tid & 15;
    const bool ok = (nt * 64 + tn4 * 4) < j.N;
#pragma unroll
    for (int i = 0; i < 4; ++i) {
      const int k = tk + 16 * i;
      f32x4 v = {0.f, 0.f, 0.f, 0.f};
      if (ok) v = *(const f32x4*)(src + (long)k * j.lds + tn4 * 4);
      if (j.g) v *= j.g[(tb / j.gdiv) * DM + kt * 64 + k];
      tile[k * 65 + tn4 * 4 + 0] = v[0]; tile[k * 65 + tn4 * 4 + 1] = v[1]; tile[k * 65 + tn4 * 4 + 2] = v[2]; tile[k * 65 + tn4 * 4 + 3] = v[3];
    }
  }
  TSYNC();
  {
    const int n = tid >> 2, kq = tid & 3, ng = nt * 64 + n;
    if (ng < j.N) {
      const int row = nmap(j.map, ng);
      unsigned w[8];
#pragma unroll
      for (int c = 0; c < 8; ++c) w[c] = cvtpk(tile[(kq * 16 + 2 * c) * 65 + n], tile[(kq * 16 + 2 * c + 1) * 65 + n]);
      bf16_t* d = dst + (long)row * j.ldd + kt * 64 + kq * 16;
      *(u32x4*)d = (u32x4){w[0], w[1], w[2], w[3]};
      *(u32x4*)(d + 8) = (u32x4){w[4], w[5], w[6], w[7]};
    }
  }
  TSYNC();
}

template <bool F32OUT>
__device__ __forceinline__ void rownorm(const float* x, const float* g, void* out, int nrows) {
  const int tid = otid(); const int lane = tid & 63;
  const int gw = vbid() * 4 + (tid >> 6), nw = nvb() * 4;
  for (int row = gw; row < nrows; row += nw) {
    const float* xr = x + (long)row * DM;
    f32x4 v[4]; float ss = 0.f;
#pragma unroll
    for (int i = 0; i < 4; ++i) { v[i] = *(const f32x4*)(xr + i * 256 + lane * 4); ss += v[i][0] * v[i][0] + v[i][1] * v[i][1] + v[i][2] * v[i][2] + v[i][3] * v[i][3]; }
#pragma unroll
    for (int o = 32; o >= 1; o >>= 1) ss += __shfl_xor(ss, o);
    const float rstd = 1.0f / sqrtf(ss * (1.0f / DM) + 1e-6f);
#pragma unroll
    for (int i = 0; i < 4; ++i) {
      const f32x4 gg = *(const f32x4*)(g + i * 256 + lane * 4);
      const f32x4 y = v[i] * rstd * gg;
      if (F32OUT) *(f32x4*)((float*)out + (long)row * DM + i * 256 + lane * 4) = y;
      else { u32x2 w; w.x = cvtpk(y[0], y[1]); w.y = cvtpk(y[2], y[3]); *(u32x2*)((bf16_t*)out + (long)row * DM + i * 256 + lane * 4) = w; }
    }
  }
}

__device__ __forceinline__ float row_rstd(const float* ssq, long row) {
  const f32x4 a = *(const f32x4*)(ssq + row * 16), b = *(const f32x4*)(ssq + row * 16 + 4), c = *(const f32x4*)(ssq + row * 16 + 8), d = *(const f32x4*)(ssq + row * 16 + 12);
  const float t = ((a[0] + a[1]) + (a[2] + a[3])) + ((b[0] + b[1]) + (b[2] + b[3])) + ((c[0] + c[1]) + (c[2] + c[3])) + ((d[0] + d[1]) + (d[2] + d[3]));
  return 1.0f / sqrtf(t * (1.0f / DM) + 1e-6f);
}
__device__ __forceinline__ void rowprep(const float* x, bf16_t* xb, float* ssq, int nrows) {
  const int tid = otid(); const int lane = tid & 63;
  const int gw = vbid() * 4 + (tid >> 6), nw = nvb() * 4;
  for (int row = gw; row < nrows; row += nw) {
    const float* xr = x + (long)row * DM;
    f32x4 v[4]; float ss = 0.f;
#pragma unroll
    for (int i = 0; i < 4; ++i) { v[i] = *(const f32x4*)(xr + i * 256 + lane * 4); ss += v[i][0] * v[i][0] + v[i][1] * v[i][1] + v[i][2] * v[i][2] + v[i][3] * v[i][3]; }
#pragma unroll
    for (int o = 32; o >= 1; o >>= 1) ss += __shfl_xor(ss, o);
#pragma unroll
    for (int i = 0; i < 4; ++i) { u32x2 w; w.x = cvtpk(v[i][0], v[i][1]); w.y = cvtpk(v[i][2], v[i][3]); *(u32x2*)(xb + (long)row * DM + i * 256 + lane * 4) = w; }
    if (lane < 16) ssq[(long)row * 16 + lane] = lane == 0 ? ss : 0.f;
  }
}
struct RowDense { const bf16_t* base; long ld; long ks;
  __device__ __forceinline__ const bf16_t* bptr() const { return base; }
  __device__ __forceinline__ unsigned rowoff(int r) const { return (unsigned)(r * (int)ld); }
  __device__ __forceinline__ long koff(int kt) const { return (long)kt * ks; } };
struct RowGather { const bf16_t* base; long ld; LAS const int* toks;
  __device__ __forceinline__ const bf16_t* bptr() const { return base; }
  __device__ __forceinline__ unsigned rowoff(int r) const { int t = toks[r]; t = t < 0 ? 0 : t; return (unsigned)(t * (int)ld); }
  __device__ __forceinline__ long koff(int kt) const { return (long)kt * 64; } };
struct RowCmp { const bf16_t* base; int r0; int kt0;
  __device__ __forceinline__ const bf16_t* bptr() const { return base; }
  __device__ __forceinline__ unsigned rowoff(int r) const { const int R = r0 + r; const int bg = R >> 8; int c = R & 255; c = c > 254 ? 254 : c;
    return (unsigned)(((bg >> 1) * SEQ + 16 * c) * PW + (bg & 1) * 64); }
  __device__ __forceinline__ long koff(int kt) const { return (long)(kt0 + kt) * PW; } };
struct RowSplit { const bf16_t* base; long ld; long delta;
  __device__ __forceinline__ const bf16_t* bptr() const { return base; }
  __device__ __forceinline__ unsigned rowoff(int r) const { return (unsigned)(r * (int)ld); }
  __device__ __forceinline__ long koff(int kt) const { return kt < 8 ? (long)kt * 64 : delta + (long)(kt - 8) * 64; } };
__device__ __forceinline__ float gelu_tanh(float x) { const float u = 0.7978845608028654f * (x + 0.044715f * x * x * x); return 0.5f * x * (1.0f + tanhf(u)); }
__device__ __forceinline__ void finalnorm(const bf16_t* xb, const float* ssq, const float* g, float* out, int nrows) {
  const int tid = otid(); const int lane = tid & 63;
  const int gw = vbid() * 4 + (tid >> 6), nw = nvb() * 4;
  for (int row = gw; row < nrows; row += nw) {
    const float rs = row_rstd(ssq, row);
#pragma unroll
    for (int i = 0; i < 2; ++i) {
      const u32x4 w = *(const u32x4*)(xb + (long)row * DM + i * 512 + lane * 8);
      const f32x4 g0 = *(const f32x4*)(g + i * 512 + lane * 8), g1 = *(const f32x4*)(g + i * 512 + lane * 8 + 4);
      float* op = out + (long)row * DM + i * 512 + lane * 8;
      *(f32x4*)op = (f32x4){__uint_as_float(w.x << 16) * rs * g0[0], __uint_as_float(w.x & 0xffff0000u) * rs * g0[1], __uint_as_float(w.y << 16) * rs * g0[2], __uint_as_float(w.y & 0xffff0000u) * rs * g0[3]};
      *(f32x4*)(op + 4) = (f32x4){__uint_as_float(w.z << 16) * rs * g1[0], __uint_as_float(w.z & 0xffff0000u) * rs * g1[1], __uint_as_float(w.w << 16) * rs * g1[2], __uint_as_float(w.w & 0xffff0000u) * rs * g1[3]};
    }
  }
}
#define GT_WAITBAR(N) asm volatile("s_waitcnt vmcnt(" #N ")\n\ts_barrier" ::: "memory")
template <class AF, class BF, class EPI, int EXPM = 0>
__device__ __forceinline__ void gemm_tile(LAS char* sm, int nkt, const AF& af, const BF& bfn, const EPI& epi) {
  const int tid = otid512(), lane = tid & 63, wid = __builtin_amdgcn_readfirstlane(tid >> 6), wm = wid >> 2, wn = wid & 3, l31 = lane & 31, hh = lane >> 5;
  const int lrow = tid >> 2;
  const int lkc = (tid & 3) ^ ((tid >> 4) & 3);
  unsigned ao[2], bo[2];
#pragma unroll
  for (int i = 0; i < 2; ++i) { ao[i] = (af.rowoff(lrow + 128 * i) + lkc * 8) * 2u; bo[i] = (bfn.rowoff(lrow + 128 * i) + lkc * 8) * 2u; }
  const char* abase = (const char*)af.bptr(); const char* bbase = (const char*)bfn.bptr();
  const int swz = (l31 >> 2) & 3;
  const int koff0 = ((hh ^ swz) << 4), koff1 = (((2 + hh) ^ swz) << 4);
  const int arow = (wm * 128 + l31) * 64, brow = 16384 + (wn * 64 + l31) * 64;
  f32x16 acc[4][2];
#pragma unroll
  for (int i = 0; i < 4; ++i)
#pragma unroll
    for (int j = 0; j < 2; ++j)
#pragma unroll
      for (int r = 0; r < 16; ++r) acc[i][j][r] = 0.f;
  LAS char* dst0 = sm + wid * 1024;
#define GT_ISSUE(st_) do { const int s__ = (st_); const long ka_ = (af.koff(s__ >> 1) + (s__ & 1) * 32) * 2, kb_ = (bfn.koff(s__ >> 1) + (s__ & 1) * 32) * 2; LAS char* d_ = dst0 + (s__ & 3) * 32768; \
    _Pragma("unroll") for (int i = 0; i < 2; ++i) { \
      __builtin_amdgcn_global_load_lds((const unsigned*)(abase + ka_ + ao[i]), (LAS unsigned*)(d_ + i * 8192), 16, 0, 0); \
      __builtin_amdgcn_global_load_lds((const unsigned*)(bbase + kb_ + bo[i]), (LAS unsigned*)(d_ + 16384 + i * 8192), 16, 0, 0); } } while (0)
  const int nst = 2 * nkt;
  __syncthreads();
  if (!(EXPM & 1)) { GT_ISSUE(0); GT_ISSUE(1); GT_ISSUE(2); }
  for (int st = 0; st < nst; ++st) {
    if (st + 2 < nst) GT_WAITBAR(8); else if (st + 1 < nst) GT_WAITBAR(4); else GT_WAITBAR(0);
    if (st + 3 < nst && !(EXPM & 1)) GT_ISSUE(st + 3);
    const int cur = (st & 3) * 32768;
#pragma unroll
    for (int s2 = 0; s2 < 2; ++s2) {
      const int ko = s2 ? koff1 : koff0;
      bf16x8 af4[4], bf2[2];
#pragma unroll
      for (int i = 0; i < 4; ++i) af4[i] = *(LAS const bf16x8*)(sm + cur + arow + i * 2048 + ko);
#pragma unroll
      for (int j = 0; j < 2; ++j) bf2[j] = *(LAS const bf16x8*)(sm + cur + brow + j * 2048 + ko);
#pragma unroll
      for (int i = 0; i < 4; ++i)
#pragma unroll
        for (int j = 0; j < 2; ++j) acc[i][j] = __builtin_amdgcn_mfma_f32_32x32x16_bf16(bf2[j], af4[i], acc[i][j], 0, 0, 0);
    }
  }
#undef GT_ISSUE
  if (!(EXPM & 2)) epi(acc, wm, wn, lane);
}

struct EpiInproj { bf16_t* P; float* fgl; const float* ssq; int mt, nt;
  __device__ __forceinline__ void operator()(f32x16 (&acc)[4][2], int wm, int wn, int lane) const {
    const int l31 = lane & 31, hh = lane >> 5;
#pragma unroll
    for (int i = 0; i < 4; ++i) {
      const long row = mt * 256 + wm * 128 + i * 32 + l31;
      const float rs = row_rstd(ssq, row);
#pragma unroll
      for (int j = 0; j < 2; ++j)
#pragma unroll
        for (int a = 0; a < 4; ++a) {
          const int col = nt * 256 + wn * 64 + j * 32 + 8 * a + 4 * hh;
          const f32x4 v = (f32x4){acc[i][j][4 * a] * rs, acc[i][j][4 * a + 1] * rs, acc[i][j][4 * a + 2] * rs, acc[i][j][4 * a + 3] * rs};
          if (nt < 10) { u32x2 w; w.x = cvtpk(v[0], v[1]); w.y = cvtpk(v[2], v[3]); *(u32x2*)(P + row * PW + col) = w; }
          else { const int c = col - 2560; if (c < 24) *(f32x4*)(fgl + row * 32 + c) = v; }
        }
    }
  } };
struct EpiBf16 { bf16_t* out; long ld; int row0, col0; const float* ssq;
  __device__ __forceinline__ void operator()(f32x16 (&acc)[4][2], int wm, int wn, int lane) const {
    const int l31 = lane & 31, hh = lane >> 5;
#pragma unroll
    for (int i = 0; i < 4; ++i) {
      const long row = row0 + wm * 128 + i * 32 + l31;
      const float rs = ssq ? row_rstd(ssq, row) : 1.0f;
      bf16_t* rp = out + row * ld + col0 + wn * 64 + 4 * hh;
#pragma unroll
      for (int j = 0; j < 2; ++j)
#pragma unroll
        for (int a = 0; a < 4; ++a) { u32x2 w; w.x = cvtpk(acc[i][j][4 * a] * rs, acc[i][j][4 * a + 1] * rs); w.y = cvtpk(acc[i][j][4 * a + 2] * rs, acc[i][j][4 * a + 3] * rs); *(u32x2*)(rp + j * 32 + 8 * a) = w; }
    }
  } };
struct EpiF32 { float* out; long ld; int row0, col0;
  __device__ __forceinline__ void operator()(f32x16 (&acc)[4][2], int wm, int wn, int lane) const {
    const int l31 = lane & 31, hh = lane >> 5;
#pragma unroll
    for (int i = 0; i < 4; ++i) {
      float* rp = out + (long)(row0 + wm * 128 + i * 32 + l31) * ld + col0 + wn * 64 + 4 * hh;
#pragma unroll
      for (int j = 0; j < 2; ++j)
#pragma unroll
        for (int a = 0; a < 4; ++a) *(f32x4*)(rp + j * 32 + 8 * a) = (f32x4){acc[i][j][4 * a], acc[i][j][4 * a + 1], acc[i][j][4 * a + 2], acc[i][j][4 * a + 3]};
    }
  } };
struct EpiResid { const float* basef; bf16_t* xb; float* ssq; int row0, col0;
  __device__ __forceinline__ void operator()(f32x16 (&acc)[4][2], int wm, int wn, int lane) const {
    const int l31 = lane & 31, hh = lane >> 5;
#pragma unroll
    for (int i = 0; i < 4; ++i) {
      const long row = row0 + wm * 128 + i * 32 + l31;
      const long o0 = row * DM + col0 + wn * 64 + 4 * hh;
      float sq = 0.f;
#pragma unroll
      for (int j = 0; j < 2; ++j) {
        f32x4 bv[4];
        if (basef) {
#pragma unroll
          for (int a = 0; a < 4; ++a) bv[a] = *(const f32x4*)(basef + o0 + j * 32 + 8 * a);
        } else {
#pragma unroll
          for (int a = 0; a < 4; ++a) { const u32x2 w = *(const u32x2*)(xb + o0 + j * 32 + 8 * a);
            bv[a] = (f32x4){__uint_as_float(w.x << 16), __uint_as_float(w.x & 0xffff0000u), __uint_as_float(w.y << 16), __uint_as_float(w.y & 0xffff0000u)}; }
        }
#pragma unroll
        for (int a = 0; a < 4; ++a) { u32x2 w; w.x = cvtpk(bv[a][0] + acc[i][j][4 * a], bv[a][1] + acc[i][j][4 * a + 1]); w.y = cvtpk(bv[a][2] + acc[i][j][4 * a + 2], bv[a][3] + acc[i][j][4 * a + 3]);
          *(u32x2*)(xb + o0 + j * 32 + 8 * a) = w;
          const float v0 = __uint_as_float(w.x << 16), v1 = __uint_as_float(w.x & 0xffff0000u), v2 = __uint_as_float(w.y << 16), v3 = __uint_as_float(w.y & 0xffff0000u);
          sq += (v0 * v0 + v1 * v1) + (v2 * v2 + v3 * v3); }
      }
      sq += __shfl_xor(sq, 32);
      if (hh == 0) ssq[row * 16 + (col0 >> 6) + wn] = sq;
      __builtin_amdgcn_sched_barrier(0);
    }
  } };
struct EpiMoeUp { bf16_t* he; long herow0; int hcol0; LAS const float* wts; LAS const float* rsd;
  __device__ __forceinline__ void operator()(f32x16 (&acc)[4][2], int wm, int wn, int lane) const {
    const int l31 = lane & 31, hh = lane >> 5;
#pragma unroll
    for (int i = 0; i < 4; ++i) {
      const int rl = wm * 128 + i * 32 + l31; const float wt = wts[rl]; const float rs = rsd[rl];
      bf16_t* rp = he + (herow0 + rl) * DM + hcol0 + wn * 32 + 4 * hh;
#pragma unroll
      for (int a = 0; a < 4; ++a) {
        float v[4];
#pragma unroll
        for (int e = 0; e < 4; ++e) { const float gte = acc[i][0][4 * a + e] * rs, up = acc[i][1][4 * a + e] * rs; v[e] = gte * sigmoidf_(gte) * up * wt; }
        u32x2 w; w.x = cvtpk(v[0], v[1]); w.y = cvtpk(v[2], v[3]); *(u32x2*)(rp + 8 * a) = w;
      }
      __builtin_amdgcn_sched_barrier(0);
    }
  } };
struct EpiMoeDown { bf16_t* xb; float* ssq; int col0; LAS const int* toks;
  __device__ __forceinline__ void operator()(f32x16 (&acc)[4][2], int wm, int wn, int lane) const {
    const int l31 = lane & 31, hh = lane >> 5;
#pragma unroll
    for (int i = 0; i < 4; ++i) {
      const int tok = toks[wm * 128 + i * 32 + l31];
      const long o0 = (long)(tok < 0 ? 0 : tok) * DM + col0 + wn * 64 + 4 * hh;
      float sq = 0.f;
#pragma unroll
      for (int j = 0; j < 2; ++j) {
        u32x2 bw[4];
#pragma unroll
        for (int a = 0; a < 4; ++a) bw[a] = *(const u32x2*)(xb + o0 + j * 32 + 8 * a);
#pragma unroll
        for (int a = 0; a < 4; ++a) {
          u32x2 w; w.x = cvtpk(__uint_as_float(bw[a].x << 16) + acc[i][j][4 * a], __uint_as_float(bw[a].x & 0xffff0000u) + acc[i][j][4 * a + 1]);
          w.y = cvtpk(__uint_as_float(bw[a].y << 16) + acc[i][j][4 * a + 2], __uint_as_float(bw[a].y & 0xffff0000u) + acc[i][j][4 * a + 3]);
          if (tok >= 0) *(u32x2*)(xb + o0 + j * 32 + 8 * a) = w;
          const float v0 = __uint_as_float(w.x << 16), v1 = __uint_as_float(w.x & 0xffff0000u), v2 = __uint_as_float(w.y << 16), v3 = __uint_as_float(w.y & 0xffff0000u);
          sq += (v0 * v0 + v1 * v1) + (v2 * v2 + v3 * v3); }
      }
      sq += __shfl_xor(sq, 32);
      if (hh == 0 && tok >= 0) ssq[(long)tok * 16 + (col0 >> 6) + wn] = sq;
      __builtin_amdgcn_sched_barrier(0);
    }
  } };
struct EpiRouterPart { float* part; int row0;
  __device__ __forceinline__ void operator()(f32x16 (&acc)[4][2], int wm, int wn, int lane) const {
    const int l31 = lane & 31, hh = lane >> 5;
    if (wn != 0) return;
#pragma unroll
    for (int i = 0; i < 4; ++i) {
      float* rp = part + (long)(row0 + wm * 128 + i * 32 + l31) * 32 + 4 * hh;
#pragma unroll
      for (int a = 0; a < 3; ++a) *(f32x4*)(rp + 8 * a) = (f32x4){acc[i][0][4 * a], acc[i][0][4 * a + 1], acc[i][0][4 * a + 2], acc[i][0][4 * a + 3]};
    }
  } };

template <int NKS> __device__ __forceinline__ int kswz(int kc, int row) {
  if (NKS == 4) return kc ^ ((row >> 1) & 7);
  return (kc & 16) | ((kc & 15) ^ (row & 15));
}
template <int NKS, int NDT, class SM>
__device__ __forceinline__ void flash_step(const bf16x8* qf, LAS const char* Ks, LAS const char* Vs, float& m, float& l, f32x16* O, const SM& smod, int kv0, int lane) {
  const int l31 = lane & 31, hh = lane >> 5;
  f32x16 p0, p1;
#pragma unroll
  for (int r = 0; r < 16; ++r) { p0[r] = 0.f; p1[r] = 0.f; }
  if (NKS == 4) {
#pragma unroll
    for (int ds = 0; ds < NKS; ++ds) {
      const int so = kswz<NKS>(2 * ds + hh, l31) << 4;
      const bf16x8 k0 = *(LAS const bf16x8*)(Ks + l31 * (NKS * 32) + so);
      const bf16x8 k1 = *(LAS const bf16x8*)(Ks + (32 + l31) * (NKS * 32) + so);
      p0 = __builtin_amdgcn_mfma_f32_32x32x16_bf16(k0, qf[ds], p0, 0, 0, 0);
      p1 = __builtin_amdgcn_mfma_f32_32x32x16_bf16(k1, qf[ds], p1, 0, 0, 0);
    }
  } else {
    const bf16_t* qg = (const bf16_t*)__builtin_bit_cast(const void*, (u32x2){(unsigned)qf[0][0] & 0xffffu | ((unsigned)qf[0][1] << 16), (unsigned)qf[0][2] & 0xffffu | ((unsigned)qf[0][3] << 16)});
    bf16x8 qa[4], qn[4];
#pragma unroll
    for (int i = 0; i < 4; ++i) qa[i] = *(const bf16x8*)(qg + i * 16);
#pragma unroll 1
    for (int g4 = 0; g4 < NKS; g4 += 4) {
      if (g4 + 4 < NKS) {
#pragma unroll
        for (int i = 0; i < 4; ++i) qn[i] = *(const bf16x8*)(qg + (g4 + 4 + i) * 16);
      }
#pragma unroll
      for (int i = 0; i < 4; ++i) {
        const int so = kswz<NKS>(2 * (g4 + i) + hh, l31) << 4;
        const bf16x8 k0 = *(LAS const bf16x8*)(Ks + l31 * (NKS * 32) + so);
        const bf16x8 k1 = *(LAS const bf16x8*)(Ks + (32 + l31) * (NKS * 32) + so);
        p0 = __builtin_amdgcn_mfma_f32_32x32x16_bf16(k0, qa[i], p0, 0, 0, 0);
        p1 = __builtin_amdgcn_mfma_f32_32x32x16_bf16(k1, qa[i], p1, 0, 0, 0);
      }
#pragma unroll
      for (int i = 0; i < 4; ++i) qa[i] = qn[i];
    }
  }
  smod.apply(p0, p1, kv0, lane);
  float mx = p0[0];
#pragma unroll
  for (int r = 1; r < 16; ++r) mx = fmaxf(mx, p0[r]);
#pragma unroll
  for (int r = 0; r < 16; ++r) mx = fmaxf(mx, p1[r]);
  mx = fmaxf(mx, __shfl_xor(mx, 32));
  const float mn = fmaxf(m, mx);
  const float mu = (mn == -INFINITY) ? 0.f : mn;
  const float alpha = fexp2(m - mu);
  float rs = 0.f;
#pragma unroll
  for (int r = 0; r < 16; ++r) { p0[r] = fexp2(p0[r] - mu); rs += p0[r]; }
#pragma unroll
  for (int r = 0; r < 16; ++r) { p1[r] = fexp2(p1[r] - mu); rs += p1[r]; }
  l = l * alpha + rs; m = mn;
#pragma unroll
  for (int dt = 0; dt < NDT; ++dt)
#pragma unroll
    for (int r = 0; r < 16; ++r) O[dt][r] *= alpha;
  bf16x8 pb[4];
  { u32x4 w;
    w = (u32x4){cvtpk(p0[0], p0[1]), cvtpk(p0[2], p0[3]), cvtpk(p0[4], p0[5]), cvtpk(p0[6], p0[7])}; pb[0] = __builtin_bit_cast(bf16x8, w);
    w = (u32x4){cvtpk(p0[8], p0[9]), cvtpk(p0[10], p0[11]), cvtpk(p0[12], p0[13]), cvtpk(p0[14], p0[15])}; pb[1] = __builtin_bit_cast(bf16x8, w);
    w = (u32x4){cvtpk(p1[0], p1[1]), cvtpk(p1[2], p1[3]), cvtpk(p1[4], p1[5]), cvtpk(p1[6], p1[7])}; pb[2] = __builtin_bit_cast(bf16x8, w);
    w = (u32x4){cvtpk(p1[8], p1[9]), cvtpk(p1[10], p1[11]), cvtpk(p1[12], p1[13]), cvtpk(p1[14], p1[15])}; pb[3] = __builtin_bit_cast(bf16x8, w); }
  const int vlane = (4 * hh + ((lane & 15) >> 2)) * 64 + (((lane >> 4) & 1) * 16 + (lane & 3) * 4) * 2;
#pragma unroll
  for (int dt = 0; dt < NDT; ++dt)
#pragma unroll
    for (int ks = 0; ks < 4; ++ks) {
      LAS const char* vp = Vs + dt * 4096 + ks * 16 * 64 + vlane;
      const s16x4 lo = __builtin_amdgcn_ds_read_tr16_b64_v4i16((LAS s16x4*)vp);
      const s16x4 hi = __builtin_amdgcn_ds_read_tr16_b64_v4i16((LAS s16x4*)(vp + 8 * 64));
      const bf16x8 vf = (bf16x8){lo[0], lo[1], lo[2], lo[3], hi[0], hi[1], hi[2], hi[3]};
      O[dt] = __builtin_amdgcn_mfma_f32_32x32x16_bf16(vf, pb[ks], O[dt], 0, 0, 0);
    }
}

template <int NKS, int NDT>
struct TileRegs { u32x4 k[NKS / 2]; u32x4 v[NDT]; };
template <int NKS, int NDT>
__device__ __forceinline__ void tile_load(TileRegs<NKS, NDT>& t, const bf16_t* Kb, long ldk, const bf16_t* Vb, long ldv, int kv0) {
  const int tid = otid();
#pragma unroll
  for (int i = 0; i < NKS / 2; ++i) { const int p = tid + 256 * i; const int row = p / (NKS * 2), kc = p % (NKS * 2);
    t.k[i] = *(const u32x4*)(Kb + (long)(kv0 + row) * ldk + kc * 8); }
#pragma unroll
  for (int i = 0; i < NDT; ++i) { const int p = tid + 256 * i; const int kv = (p & 255) >> 2, cp = (p >> 8) * 4 + (p & 3);
    t.v[i] = *(const u32x4*)(Vb + (long)(kv0 + kv) * ldv + cp * 8); }
}
template <int NKS, int NDT>
__device__ __forceinline__ void tile_store(const TileRegs<NKS, NDT>& t, LAS char* Ks, LAS char* Vs) {
  const int tid = otid();
#pragma unroll
  for (int i = 0; i < NKS / 2; ++i) { const int p = tid + 256 * i; const int row = p / (NKS * 2), kc = p % (NKS * 2);
    *(LAS u32x4*)(Ks + row * (NKS * 32) + (kswz<NKS>(kc, row) << 4)) = t.k[i]; }
#pragma unroll
  for (int i = 0; i < NDT; ++i) { const int p = tid + 256 * i; *(LAS u32x4*)(Vs + p * 16) = t.v[i]; }
}
struct TLRange { int n, kv_first; __device__ __forceinline__ int count() const { return n; } __device__ __forceinline__ int kv0(int i) const { return kv_first + 64 * i; } };
struct TLList { int n; LAS const int* lst; __device__ __forceinline__ int count() const { return n; } __device__ __forceinline__ int kv0(int i) const { return lst[i]; } };

template <int NKS, int NDT, bool PF, class SM, class TL>
__device__ __forceinline__ void flash_run(LAS char* Ks, LAS char* Vs, const bf16x8* qf, const bf16_t* Kb, long ldk, const bf16_t* Vb, long ldv,
                                          const TL& tl, const SM& smod, float& m, float& l, f32x16* O) {
  const int n = tl.count(); const int lane = threadIdx.x & 63;
  if (n <= 0) return;
  TileRegs<NKS, NDT> t; f32x4 xr = {0.f, 0.f, 0.f, 0.f}; const int tid_ = otid();
  if (PF) { tile_load<NKS, NDT>(t, Kb, ldk, Vb, ldv, tl.kv0(0)); if (SM::EXTRA) xr = smod.xload(tl.kv0(0), tid_); }
  for (int it = 0; it < n; ++it) {
    const int kvc = tl.kv0(it);
    TSYNC();
    if (!PF) {
#pragma unroll 1
      for (int c0 = 0; c0 < NKS / 2; c0 += 4) {
        u32x4 r4[4];
#pragma unroll
        for (int i = 0; i < 4; ++i) { const int pp = tid_ + 256 * (c0 + i); const int row = pp / (NKS * 2), kc = pp % (NKS * 2); r4[i] = *(const u32x4*)(Kb + (long)(kvc + row) * ldk + kc * 8); }
#pragma unroll
        for (int i = 0; i < 4; ++i) { const int pp = tid_ + 256 * (c0 + i); const int row = pp / (NKS * 2), kc = pp % (NKS * 2); *(LAS u32x4*)(Ks + row * (NKS * 32) + (kswz<NKS>(kc, row) << 4)) = r4[i]; }
      }
      { u32x4 r4[NDT];
#pragma unroll
        for (int i = 0; i < NDT; ++i) { const int pp = tid_ + 256 * i; const int kv = (pp & 255) >> 2, cp = (pp >> 8) * 4 + (pp & 3); r4[i] = *(const u32x4*)(Vb + (long)(kvc + kv) * ldv + cp * 8); }
#pragma unroll
        for (int i = 0; i < NDT; ++i) { const int pp = tid_ + 256 * i; *(LAS u32x4*)(Vs + pp * 16) = r4[i]; } }
    } else { tile_store<NKS, NDT>(t, Ks, Vs); if (SM::EXTRA) smod.xstore(xr, tid_); }
    TSYNC();
    if (PF && it + 1 < n) { tile_load<NKS, NDT>(t, Kb, ldk, Vb, ldv, tl.kv0(it + 1)); if (SM::EXTRA) xr = smod.xload(tl.kv0(it + 1), tid_); }
    if (smod.active(kvc)) flash_step<NKS, NDT, SM>(qf, Ks, Vs, m, l, O, smod, kvc, lane);
  }
}

struct SMFox { float cq; const float* ck; int tq; int tqmax; LAS const float* ckl;
  static constexpr bool EXTRA = true;
  __device__ __forceinline__ bool active(int kv0) const { return kv0 <= tqmax; }
  __device__ __forceinline__ f32x4 xload(int kv0, int tid) const { f32x4 v = {0.f, 0.f, 0.f, 0.f}; if (tid < 16) v = *(const f32x4*)(ck + kv0 + 4 * tid); return v; }
  __device__ __forceinline__ void xstore(const f32x4& v, int tid) const { if (tid < 16) *(LAS f32x4*)(ckl + 4 * tid) = v; }
  __device__ __forceinline__ void apply(f32x16& p0, f32x16& p1, int kv0, int lane) const {
    const int hh = lane >> 5; const float C = 0.125f * LOG2E;
    const int db = tq - kv0 - 4 * hh;
    LAS const float* cp = ckl + 4 * hh;
#pragma unroll
    for (int a = 0; a < 4; ++a) {
      const f32x4 c0 = *(LAS const f32x4*)(cp + 8 * a);
      const f32x4 c1 = *(LAS const f32x4*)(cp + 32 + 8 * a);
#pragma unroll
      for (int e = 0; e < 4; ++e) {
        const int c = 8 * a + e;
        p0[4 * a + e] = (db >= c) ? __builtin_fmaf(p0[4 * a + e], C, cq - c0[e]) : -INFINITY;
        p1[4 * a + e] = (db >= c + 32) ? __builtin_fmaf(p1[4 * a + e], C, cq - c1[e]) : -INFINITY;
      }
    }
  } };
struct SMWin { int tq; float slope2; int tqmax;
  static constexpr bool EXTRA = false;
  __device__ __forceinline__ f32x4 xload(int, int) const { return (f32x4){0.f, 0.f, 0.f, 0.f}; }
  __device__ __forceinline__ void xstore(const f32x4&, int) const {}
  __device__ __forceinline__ bool active(int kv0) const { return kv0 <= tqmax && kv0 + 63 + 512 > tqmax - 31; }
  __device__ __forceinline__ void apply(f32x16& p0, f32x16& p1, int kv0, int lane) const {
    const int hh = lane >> 5; const float C = 0.125f * LOG2E;
    const int db = tq - kv0 - 4 * hh; const float sb = -slope2 * (float)db;
#pragma unroll
    for (int r = 0; r < 16; ++r) {
      const int c = (r & 3) + 8 * (r >> 2);
      const int d0 = db - c, d1 = db - c - 32;
      p0[r] = (d0 >= 0 && d0 < 512) ? __builtin_fmaf(p0[r], C, __builtin_fmaf(slope2, (float)c, sb)) : -INFINITY;
      p1[r] = (d1 >= 0 && d1 < 512) ? __builtin_fmaf(p1[r], C, __builtin_fmaf(slope2, (float)(c + 32), sb)) : -INFINITY;
    }
  } };
struct SMSel { int tq; float slope2; unsigned mlo, mhi; int tqmax;
  static constexpr bool EXTRA = false;
  __device__ __forceinline__ f32x4 xload(int, int) const { return (f32x4){0.f, 0.f, 0.f, 0.f}; }
  __device__ __forceinline__ void xstore(const f32x4&, int) const {}
  __device__ __forceinline__ bool active(int kv0) const { const int j = kv0 >> 6; const bool sel = ((j < 32 ? (mlo >> j) : (mhi >> (j - 32))) & 1u) != 0u;
    return kv0 <= tqmax && __builtin_amdgcn_ballot_w64(sel) != 0ull; }
  __device__ __forceinline__ void apply(f32x16& p0, f32x16& p1, int kv0, int lane) const {
    const int hh = lane >> 5; const float C = 0.125f * LOG2E;
    const int j = kv0 >> 6;
    const bool sel = ((j < 32 ? (mlo >> j) : (mhi >> (j - 32))) & 1u) != 0u;
    const int db = sel ? (tq - kv0 - 4 * hh) : -1; const float sb = -slope2 * (float)db;
#pragma unroll
    for (int r = 0; r < 16; ++r) {
      const int c = (r & 3) + 8 * (r >> 2);
      p0[r] = (db >= c) ? __builtin_fmaf(p0[r], C, __builtin_fmaf(slope2, (float)c, sb)) : -INFINITY;
      p1[r] = (db >= c + 32) ? __builtin_fmaf(p1[r], C, __builtin_fmaf(slope2, (float)(c + 32), sb)) : -INFINITY;
    }
  } };
struct SMCmp { int tq; float slope2; int tqmax;
  static constexpr bool EXTRA = false;
  __device__ __forceinline__ f32x4 xload(int, int) const { return (f32x4){0.f, 0.f, 0.f, 0.f}; }
  __device__ __forceinline__ void xstore(const f32x4&, int) const {}
  __device__ __forceinline__ bool active(int kv0) const { return 16 * kv0 + 31 <= tqmax; }
  __device__ __forceinline__ void apply(f32x16& p0, f32x16& p1, int kv0, int lane) const {
    const int hh = lane >> 5; const float C = 0.125f * LOG2E;
    const int db = tq - 31 - 16 * kv0 - 64 * hh; const float sb = -slope2 * (float)db;
#pragma unroll
    for (int r = 0; r < 16; ++r) {
      const int c = 16 * ((r & 3) + 8 * (r >> 2));
      p0[r] = (db >= c) ? __builtin_fmaf(p0[r], C, __builtin_fmaf(slope2, (float)c, sb)) : -INFINITY;
      p1[r] = (db >= c + 512) ? __builtin_fmaf(p1[r], C, __builtin_fmaf(slope2, (float)(c + 512), sb)) : -INFINITY;
    }
  } };
struct SMNone { float C;
  static constexpr bool EXTRA = false;
  __device__ __forceinline__ f32x4 xload(int, int) const { return (f32x4){0.f, 0.f, 0.f, 0.f}; }
  __device__ __forceinline__ void xstore(const f32x4&, int) const {}
  __device__ __forceinline__ bool active(int kv0) const { return true; }
  __device__ __forceinline__ void apply(f32x16& p0, f32x16& p1, int kv0, int lane) const {
#pragma unroll
    for (int r = 0; r < 16; ++r) { p0[r] *= C; p1[r] *= C; }
  } };

__device__ __forceinline__ void fox_unit(const Params& p, int b, int h, int qb, LAS char* sm) {
  const int tid = otid(), lane = tid & 63, w = tid >> 6, l31 = lane & 31, hh = lane >> 5;
  const int tq = qb * 128 + w * 32 + l31; const long tok = (long)b * SEQ + tq;
  const bf16_t* Pb = p.P + (long)b * SEQ * PW;
  bf16x8 qf[4];
#pragma unroll
  for (int ds = 0; ds < 4; ++ds) qf[ds] = *(const bf16x8*)(p.P + tok * PW + h * 64 + ds * 16 + hh * 8);
  const float* ck = p.cum + (long)(b * 6 + h) * SEQ;
  SMFox smod; smod.cq = ck[tq]; smod.ck = ck; smod.tq = tq; smod.tqmax = qb * 128 + w * 32 + 31; smod.ckl = (LAS const float*)(sm + 16384);
  float m = -INFINITY, l = 0.f; f32x16 O[2];
#pragma unroll
  for (int r = 0; r < 16; ++r) { O[0][r] = 0.f; O[1][r] = 0.f; }
  TLRange tl; tl.n = 2 * qb + 2; tl.kv_first = 0;
  flash_run<4, 2, true>(sm, sm + 8192, qf, Pb + 384 + h * 64, PW, Pb + 768 + h * 64, PW, tl, smod, m, l, O);
  const float lt = l + __shfl_xor(l, 32); const float inv = lt > 0.f ? 1.0f / lt : 0.f;
  bf16_t* op = p.cat + tok * DM + h * 64;
#pragma unroll
  for (int dt = 0; dt < 2; ++dt)
#pragma unroll
    for (int a = 0; a < 4; ++a) { u32x2 wv; wv.x = cvtpk(O[dt][4 * a] * inv, O[dt][4 * a + 1] * inv); wv.y = cvtpk(O[dt][4 * a + 2] * inv, O[dt][4 * a + 3] * inv);
      *(u32x2*)(op + dt * 32 + 8 * a + 4 * hh) = wv; }
}

__device__ __forceinline__ void xattn_unit(const Params& p, int layer, int b, int hd, int qb, int dh, LAS char* sm) {
  const int tid = otid(), lane = tid & 63, w = tid >> 6, l31 = lane & 31, hh = lane >> 5;
  const int tq = qb * 128 + w * 32 + l31; const long tok = (long)b * SEQ + tq;
  bf16x8 qf[1];
  { const bf16_t* qg = p.qx + tok * DM + hd * 256 + hh * 8; const u32x2 pw = __builtin_bit_cast(u32x2, (const void*)qg);
    qf[0] = (bf16x8){(short)(pw.x & 0xffffu), (short)(pw.x >> 16), (short)(pw.y & 0xffffu), (short)(pw.y >> 16), 0, 0, 0, 0}; }
  SMNone smod; smod.C = 0.0625f * LOG2E;
  float m = -INFINITY, l = 0.f; f32x16 O[4];
#pragma unroll
  for (int dt = 0; dt < 4; ++dt)
#pragma unroll
    for (int r = 0; r < 16; ++r) O[dt][r] = 0.f;
  TLRange tl; tl.n = 4; tl.kv_first = 0;
  const bf16_t* Kb = p.Kmem + ((long)layer * 1024 + b * 256) * DM + hd * 256;
  const bf16_t* Vb = p.Vmem + ((long)layer * 1024 + b * 256) * DM + hd * 256 + dh * 128;
  flash_run<16, 4, false>(sm, sm + 32768, qf, Kb, DM, Vb, DM, tl, smod, m, l, O);
  const float lt = l + __shfl_xor(l, 32); const float inv = 1.0f / lt;
  bf16_t* op = p.ox + tok * DM + hd * 256 + dh * 128;
#pragma unroll
  for (int dt = 0; dt < 4; ++dt)
#pragma unroll
    for (int a = 0; a < 4; ++a) { u32x2 wv; wv.x = cvtpk(O[dt][4 * a] * inv, O[dt][4 * a + 1] * inv); wv.y = cvtpk(O[dt][4 * a + 2] * inv, O[dt][4 * a + 3] * inv);
      *(u32x2*)(op + dt * 32 + 8 * a + 4 * hh) = wv; }
}

#define NSA_SC 16384
#define NSA_UNI 49664
#define NSA_TL 49680
__device__ __forceinline__ void nsa_stageA(const Params& p, int layer, int b, int g, int qb, LAS char* sm) {
  const int tid = otid(), lane = tid & 63, w = tid >> 6, l31 = lane & 31, hh = lane >> 5;
  const int tq = qb * 128 + w * 32 + l31; const long tok = (long)b * SEQ + tq;
  const bf16_t* Pb = p.P + (long)b * SEQ * PW;
  LAS char* Ks = sm; LAS char* Vs = sm + 8192;
  LAS float* sc = (LAS float*)(sm + NSA_SC);
  LAS unsigned* uni = (LAS unsigned*)(sm + NSA_UNI);
  LAS int* tll = (LAS int*)(sm + NSA_TL);
  const bf16_t* kcb = p.kvc + (long)(0 * 8 + b * 2 + g) * 256 * 64;
  const bf16_t* vcb = p.kvc + (long)(1 * 8 + b * 2 + g) * 256 * 64;
  const int ntc = min(4, (8 * qb + 6) / 64 + 1);
  LAS float* myrow = sc + (w * 32 + l31) * 65;
  TSYNC();
#pragma unroll
  for (int i = 0; i < 32; ++i) myrow[2 * i + hh] = 0.f;
  const float* glp = p.fgl + tok * 32 + 6;
  const float* gbp = p.gate_b + layer * 18;
#pragma unroll 1
  for (int r3 = 0; r3 < 3; ++r3) {
    const int head = 3 * g + r3;
    const float slope2 = exp2f(-8.0f * (float)(head + 1) / 6.0f) * LOG2E;
    bf16x8 qf[4];
#pragma unroll
    for (int ds = 0; ds < 4; ++ds) qf[ds] = *(const bf16x8*)(p.P + tok * PW + 1408 + head * 64 + ds * 16 + hh * 8);
    SMCmp smod; smod.tq = tq; smod.slope2 = slope2; smod.tqmax = qb * 128 + w * 32 + 31;
    float m = -INFINITY, l = 0.f; f32x16 O[2];
#pragma unroll
    for (int r = 0; r < 16; ++r) { O[0][r] = 0.f; O[1][r] = 0.f; }
    TLRange tl; tl.n = ntc; tl.kv_first = 0;
    flash_run<4, 2, true>(Ks, Vs, qf, kcb, 64, vcb, 64, tl, smod, m, l, O);
    const float lt = l + __shfl_xor(l, 32); const float inv = lt > 0.f ? 1.0f / lt : 0.f;
    const float gc = sigmoidf_(glp[head * 3 + 0] + gbp[head * 3 + 0]) * inv;
    float* ob = p.onsa + tok * 384 + head * 64;
#pragma unroll
    for (int dt = 0; dt < 2; ++dt)
#pragma unroll
      for (int a = 0; a < 4; ++a) *(f32x4*)(ob + dt * 32 + 8 * a + 4 * hh) = (f32x4){O[dt][4 * a] * gc, O[dt][4 * a + 1] * gc, O[dt][4 * a + 2] * gc, O[dt][4 * a + 3] * gc};
    const float mu = (m == -INFINITY) ? 0.f : m;
    float e_prev = 0.f;
#pragma unroll
    for (int it = 0; it < 4; ++it) {
      if (it < ntc) {
        TSYNC();
        { const int pp = tid, pp2 = tid + 256;
          const u32x4 k0 = *(const u32x4*)(kcb + (long)(64 * it + (pp >> 3)) * 64 + (pp & 7) * 8);
          const u32x4 k1 = *(const u32x4*)(kcb + (long)(64 * it + (pp2 >> 3)) * 64 + (pp2 & 7) * 8);
          *(LAS u32x4*)(Ks + (pp >> 3) * 128 + (kswz<4>(pp & 7, pp >> 3) << 4)) = k0;
          *(LAS u32x4*)(Ks + (pp2 >> 3) * 128 + (kswz<4>(pp2 & 7, pp2 >> 3) << 4)) = k1; }
        TSYNC();
        f32x16 p0, p1;
#pragma unroll
        for (int r = 0; r < 16; ++r) { p0[r] = 0.f; p1[r] = 0.f; }
#pragma unroll
        for (int ds = 0; ds < 4; ++ds) {
          const int so = kswz<4>(2 * ds + hh, l31) << 4;
          const bf16x8 k0 = *(LAS const bf16x8*)(Ks + l31 * 128 + so);
          const bf16x8 k1 = *(LAS const bf16x8*)(Ks + (32 + l31) * 128 + so);
          p0 = __builtin_amdgcn_mfma_f32_32x32x16_bf16(k0, qf[ds], p0, 0, 0, 0);
          p1 = __builtin_amdgcn_mfma_f32_32x32x16_bf16(k1, qf[ds], p1, 0, 0, 0);
        }
        smod.apply(p0, p1, 64 * it, lane);
#pragma unroll
        for (int r = 0; r < 16; ++r) { p0[r] = fexp2(p0[r] - mu) * inv; p1[r] = fexp2(p1[r] - mu) * inv; }
#pragma unroll
        for (int pi = 0; pi < 2; ++pi)
#pragma unroll
          for (int a = 0; a < 4; ++a) {
            const float q0 = pi ? p1[4 * a] : p0[4 * a], q1 = pi ? p1[4 * a + 1] : p0[4 * a + 1], q2 = pi ? p1[4 * a + 2] : p0[4 * a + 2], q3 = pi ? p1[4 * a + 3] : p0[4 * a + 3];
            const float ex = __shfl_xor(q3, 32);
            myrow[2 * (8 * it + 4 * pi + a) + hh] += (q0 + q1) + (q2 + q3) + (hh ? ex : e_prev);
            e_prev = ex;
          }
      }
    }
  }
  TSYNC();
  {
    const int cur = tq >> 6;
#pragma unroll
    for (int mi = 0; mi < 32; ++mi) {
      const int j = 2 * mi + hh;
      const bool forced = (j == 0) || (j == cur) || (j == cur - 1);
      const float iv = myrow[j];
      myrow[j] = forced ? 1.0e4f : (j <= cur ? iv : -1.0f);
    }
  }
  TSYNC();
  unsigned mlo = 0u, mhi = 0u;
  if (hh == 0) {
    LAS float* row = sc + (w * 32 + l31) * 65;
    for (int itk = 0; itk < 16; ++itk) {
      float best = -INFINITY; int bi = 0;
      for (int j = 0; j < 64; ++j) { const float v = row[j]; if (v > best) { best = v; bi = j; } }
      row[bi] = -INFINITY;
      if (bi < 32) mlo |= (1u << bi); else mhi |= (1u << (bi - 32));
    }
    *(u32x2*)(p.selm + (tok * 2 + g) * 2) = (u32x2){mlo, mhi};
  }
  TSYNC();
}

__device__ __forceinline__ void nsa_stageB(const Params& p, int layer, int b, int head, int qb, LAS char* sm) {
  const int tid = otid(), lane = tid & 63, w = tid >> 6, l31 = lane & 31, hh = lane >> 5;
  const int g = head / 3;
  const int tq = qb * 128 + w * 32 + l31; const long tok = (long)b * SEQ + tq;
  const bf16_t* Pb = p.P + (long)b * SEQ * PW;
  LAS char* Ks = sm; LAS char* Vs = sm + 8192;
  LAS unsigned* uni = (LAS unsigned*)(sm + NSA_UNI);
  LAS int* tll = (LAS int*)(sm + NSA_TL);
  const float* glp = p.fgl + tok * 32 + 6;
  const float* gbp = p.gate_b + layer * 18;
  const u32x2 mk = *(const u32x2*)(p.selm + (tok * 2 + g) * 2);
  const unsigned mlo = mk.x, mhi = mk.y;
  TSYNC();
  if (tid < 2) uni[tid] = 0u;
  TSYNC();
  if (hh == 0) { __hip_atomic_fetch_or(uni, mlo, __ATOMIC_RELAXED, __HIP_MEMORY_SCOPE_WORKGROUP); __hip_atomic_fetch_or(uni + 1, mhi, __ATOMIC_RELAXED, __HIP_MEMORY_SCOPE_WORKGROUP); }
  TSYNC();
  if (tid == 0) {
    unsigned long long u = ((unsigned long long)uni[1] << 32) | (unsigned long long)uni[0];
    const int jmax = (qb * 128 + 127) >> 6;
    int n = 0;
    for (int j = 0; j <= jmax; ++j) if ((u >> j) & 1ull) tll[1 + n++] = 64 * j;
    tll[0] = n;
  }
  TSYNC();
  const int nsel = tll[0];
  const int tqmax = qb * 128 + w * 32 + 31;
  {
    const float slope2 = exp2f(-8.0f * (float)(head + 1) / 6.0f) * LOG2E;
    bf16x8 qf[4];
#pragma unroll
    for (int ds = 0; ds < 4; ++ds) qf[ds] = *(const bf16x8*)(p.P + tok * PW + 1408 + head * 64 + ds * 16 + hh * 8);
    f32x16 acc[2];
    {
      SMSel smod; smod.tq = tq; smod.slope2 = slope2; smod.mlo = mlo; smod.mhi = mhi; smod.tqmax = tqmax;
      float m = -INFINITY, l = 0.f; f32x16 O[2];
#pragma unroll
      for (int r = 0; r < 16; ++r) { O[0][r] = 0.f; O[1][r] = 0.f; }
      TLList tl; tl.n = nsel; tl.lst = tll + 1;
      flash_run<4, 2, true>(Ks, Vs, qf, Pb + 2048 + g * 64, PW, Pb + 2176 + g * 64, PW, tl, smod, m, l, O);
      const float lt = l + __shfl_xor(l, 32); const float inv = lt > 0.f ? 1.0f / lt : 0.f;
      const float gs = sigmoidf_(glp[head * 3 + 1] + gbp[head * 3 + 1]) * inv;
#pragma unroll
      for (int r = 0; r < 16; ++r) { acc[0][r] = O[0][r] * gs; acc[1][r] = O[1][r] * gs; }
    }
    {
      SMWin smod; smod.tq = tq; smod.slope2 = slope2; smod.tqmax = tqmax;
      float m = -INFINITY, l = 0.f; f32x16 O[2];
#pragma unroll
      for (int r = 0; r < 16; ++r) { O[0][r] = 0.f; O[1][r] = 0.f; }
      const int kvf = max(0, qb * 128 - 512);
      TLRange tl; tl.kv_first = kvf; tl.n = (qb * 128 + 128 - kvf) >> 6;
      flash_run<4, 2, true>(Ks, Vs, qf, Pb + 2304 + g * 64, PW, Pb + 2432 + g * 64, PW, tl, smod, m, l, O);
      const float lt = l + __shfl_xor(l, 32); const float inv = lt > 0.f ? 1.0f / lt : 0.f;
      const float gw = sigmoidf_(glp[head * 3 + 2] + gbp[head * 3 + 2]) * inv;
      const float* ob = p.onsa + tok * 384 + head * 64;
      bf16_t* op = p.cat + tok * DM + 640 + head * 64;
#pragma unroll
      for (int dt = 0; dt < 2; ++dt)
#pragma unroll
        for (int a = 0; a < 4; ++a) {
          const f32x4 oc = *(const f32x4*)(ob + dt * 32 + 8 * a + 4 * hh);
          u32x2 wv; wv.x = cvtpk(O[dt][4 * a] * gw + acc[dt][4 * a] + oc[0], O[dt][4 * a + 1] * gw + acc[dt][4 * a + 1] + oc[1]);
          wv.y = cvtpk(O[dt][4 * a + 2] * gw + acc[dt][4 * a + 2] + oc[2], O[dt][4 * a + 3] * gw + acc[dt][4 * a + 3] + oc[3]);
          *(u32x2*)(op + dt * 32 + 8 * a + 4 * hh) = wv;
        }
    }
  }
  TSYNC();
}

__device__ __forceinline__ void pool_unit(const Params& p, int layer, int b, int tb, int g, LAS char* sm) {
  const int tid = otid();
  LAS float* u = (LAS float*)sm;
  LAS float* W = (LAS float*)(sm + 20480);
  LAS float* pl = (LAS float*)(sm + 36864);
  const int t0 = tb * 64;
  const int wsz = 2 << g;
  TSYNC();
#pragma unroll
  for (int i3 = 0; i3 < 3; ++i3) { const int pi = tid + 256 * i3; if (pi < 79 * 8) { const int rr = pi >> 3, c8 = (pi & 7) * 8; const int t = t0 - 15 + rr;
      u32x4 v = {0u, 0u, 0u, 0u}; if (t >= 0) v = *(const u32x4*)(p.P + ((long)b * SEQ + t) * PW + 1152 + g * 64 + c8);
      *(LAS f32x4*)(u + rr * 64 + c8) = (f32x4){__uint_as_float(v.x << 16), __uint_as_float(v.x & 0xffff0000u), __uint_as_float(v.y << 16), __uint_as_float(v.y & 0xffff0000u)};
      *(LAS f32x4*)(u + rr * 64 + c8 + 4) = (f32x4){__uint_as_float(v.z << 16), __uint_as_float(v.z & 0xffff0000u), __uint_as_float(v.w << 16), __uint_as_float(v.w & 0xffff0000u)}; } }
#pragma unroll
  for (int i4 = 0; i4 < 4; ++i4) { const int i = (tid + 256 * i4) * 4; *(LAS f32x4*)(W + i) = *(const f32x4*)(p.pool_w + ((long)layer * 4 + g) * 4096 + i); }
  TSYNC();
  for (int i = tid; i < 4096; i += 256) { const int tl = i >> 6, c = i & 63; const int t = t0 + tl;
    float s = 0.f; for (int k = 0; k < wsz; ++k) s += u[(tl + 15 - k) * 64 + c];
    const float cnt = (float)min(t + 1, wsz);
    pl[i] = s / cnt - u[(tl + 15) * 64 + c]; }
  TSYNC();
  { const int d = tid & 63, tg = tid >> 6;
    const float scl = p.pool_scale[layer * 256 + g * 64 + d];
    float o[16];
#pragma unroll
    for (int i = 0; i < 16; ++i) o[i] = 0.f;
    for (int c = 0; c < 64; ++c) { const float wv = W[c * 64 + d];
#pragma unroll
      for (int i = 0; i < 16; ++i) o[i] += pl[(tg * 16 + i) * 64 + c] * wv; }
#pragma unroll
    for (int i = 0; i < 16; ++i) p.cat[((long)b * SEQ + t0 + tg * 16 + i) * DM + 384 + g * 64 + d] = f2bf(o[i] * scl); }
}

__device__ __forceinline__ void cum_unit(const Params& p, int layer, int b, int h, LAS char* sm) {
  const int tid = otid();
  LAS float* part = (LAS float*)sm;
  const float bf = p.fox_b[layer * 6 + h];
  float v[16]; float s = 0.f;
#pragma unroll
  for (int i = 0; i < 16; ++i) { const int t = tid * 16 + i; const float z = p.fgl[((long)b * SEQ + t) * 32 + h] + bf;
    const float ls = fminf(z, 0.f) - log1pf(__expf(-fabsf(z))); s += ls; v[i] = s; }
  TSYNC();
  part[tid] = s;
  TSYNC();
  if (tid == 0) { float a = 0.f; for (int i = 0; i < 256; ++i) { const float t = part[i]; part[i] = a; a += t; } }
  TSYNC();
  const float base = part[tid];
#pragma unroll
  for (int i = 0; i < 16; ++i) p.cum[(long)(b * 6 + h) * SEQ + tid * 16 + i] = (base + v[i]) * LOG2E;
  TSYNC();
}

__device__ __forceinline__ void cmp2_unit(const Params& p, int layer, int kv, int rb, LAS char* sm) {
  const int tid = otid();
  LAS float* hs = (LAS float*)sm;
  const float* bias = p.bias1 + (layer * 2 + kv) * 256;
  const float* part = p.hidp + (long)kv * 2048 * 256;
  TSYNC();
#pragma unroll
  for (int i4 = 0; i4 < 4; ++i4) { const int i = (tid + 256 * i4) * 4; const int r = i >> 8, k = i & 255; const long o = (long)(rb * 16 + r) * 256 + k;
    f32x4 v = *(const f32x4*)(bias + k);
#pragma unroll
    for (int sI = 0; sI < 8; ++sI) v += *(const f32x4*)(part + o + (long)sI * 4096 * 256);
    *(LAS f32x4*)(hs + i) = (f32x4){gelu_tanh(v[0]), gelu_tanh(v[1]), gelu_tanh(v[2]), gelu_tanh(v[3])}; }
  TSYNC();
  const int n = tid & 63, rg = tid >> 6;
  const float* w2 = (kv ? p.w2v : p.w2k) + (long)layer * 256 * 64 + n;
  float acc[4] = {0.f, 0.f, 0.f, 0.f};
#pragma unroll 1
  for (int k0 = 0; k0 < 256; k0 += 16) {
    float wv[16];
#pragma unroll
    for (int q = 0; q < 16; ++q) wv[q] = w2[(k0 + q) * 64];
#pragma unroll
    for (int q = 0; q < 16; q += 4)
#pragma unroll
      for (int j = 0; j < 4; ++j) { const f32x4 h4 = *(LAS const f32x4*)(hs + (rg * 4 + j) * 256 + k0 + q);
        acc[j] += h4[0] * wv[q] + h4[1] * wv[q + 1] + h4[2] * wv[q + 2] + h4[3] * wv[q + 3]; }
  }
#pragma unroll
  for (int j = 0; j < 4; ++j) { const int row = rb * 16 + rg * 4 + j; p.kvc[((long)kv * 2048 + row) * 64 + n] = ((row & 255) == 255) ? (bf16_t)0 : f2bf(acc[j]); }
}

#define GSYNC() xcd_barrier(xb)
#define GSYNCK(k) do { xcd_barrier(xb); if (SPINMASK != 0ull && bid == 0 && tid5 == 0) { ((unsigned long long*)(xb.bar + 4096))[(k)] = __builtin_amdgcn_s_memrealtime(); } } while (0)
#ifndef SKIPMASK
#define SKIPMASK 0
#endif
#define PH(n) if (!((SKIPMASK >> (n)) & 1))
#define REP(n) for (int rep_ = 0; rep_ < ((((DUPMASK) >> (n)) & 1) ? 2 : 1); ++rep_)
__global__ void __launch_bounds__(512, 2) fwd_kernel(Params p) {
  LAS char* smfull = (LAS char*)lds_dyn;
  const int tid5 = otid512();
  const int tid = otid();
  const int team = team_id();
  LAS char* sm = smfull + team * 65536;
  LAS int* xs = (LAS int*)(smfull + LDS_XS + team * 2048);
  LAS int* xsg = (LAS int*)(smfull + LDS_XS);
  const int bid = blockIdx.x, nb = gridDim.x;
  const int vb = vbid(), nv = nvb();
  if (p.never) cg::this_grid().sync();
  if (tid5 < 64) ((LAS unsigned*)(smfull + LDS_XB))[tid5] = 0u;
  __syncthreads();
  XcdBarrier xb = xcd_barrier_post(p.bar, (volatile LAS unsigned*)(smfull + LDS_XB));
  if (SPINMASK != 0ull && bid == 0 && tid5 == 0) ((unsigned long long*)(xb.bar + 4096))[0] = __builtin_amdgcn_s_memrealtime();

  REP(0) PH(0) for (int t = vb; t < p.ttiles; t += nv) {
    int ji = 0;
#pragma unroll
    for (int q = 1; q < NJOBS; ++q) if (t >= p.jobs[q].tile0) ji = q;
    transpose_tile(p.jobs[ji], t - p.jobs[ji].tile0, sm);
  }
  PH(1) {
    const long gt = (long)vb * 256 + tid, gs = (long)nv * 256;
    for (long i = gt; i < 2L * 232 * 128; i += gs) { const long l = i / (232 * 128), rem = i % (232 * 128); *(u32x4*)(p.WinT + (l * 2816 + 2584) * 1024 + rem * 8) = (u32x4){0u, 0u, 0u, 0u}; }
    for (long i = gt; i < 2L * 236 * 128; i += gs) { const long l = i / (236 * 128), rem = i % (236 * 128); *(u32x4*)(p.WrT + (l * 256 + 20) * 1024 + rem * 8) = (u32x4){0u, 0u, 0u, 0u}; }
    if (gt < 64) { p.mcnt[gt] = 0; p.wq[gt] = 0; }
    if (gt < 1024) { const int l = (int)(gt >> 9), kv = (int)((gt >> 8) & 1), n = (int)(gt & 255);
      const float* pe = (kv ? p.pe_v : p.pe_k) + l * 2048; const float* w1 = (kv ? p.w1v : p.w1k) + (long)l * 2048 * 256 + n;
      float s = 0.f; for (int k = 0; k < 2048; ++k) s += pe[k] * w1[(long)k * 256];
      p.bias1[gt] = s; }
  }
  PH(2) rownorm<false>(p.mem, p.mem_g, p.memn, 1024);
  rownorm<false>(p.mem, p.mem_g + DM, p.memn + 1024 * DM, 1024);
  rowprep(p.x_in, p.hb, p.ssq, NTOK);
  GSYNCK(1);

  for (int layer = 0; layer < 2; ++layer) {
    REP(3) PH(3) {
      const int nmain = 64 * 11, nextra = layer == 0 ? 64 : 0;
      for (int it = bid; it < nmain + nextra; it += nb) {
        if (it < nmain) {
          const int nt = it / 64, mt = it % 64;
          RowDense af{p.hb + (long)mt * 256 * DM, DM, 64};
          RowDense bf{p.WinT + ((long)layer * 2816 + nt * 256) * DM, DM, 64};
          EpiInproj ep{p.P, p.fgl, p.ssq, mt, nt};
          gemm_tile(smfull, 16, af, bf, ep);
        } else {
          const int e = it - nmain; const int l2 = e >> 5, kv = (e >> 4) & 1, mt = (e >> 2) & 3, nt = e & 3;
          RowDense af{p.memn + ((long)l2 * 1024 + mt * 256) * DM, DM, 64};
          RowDense bf{(kv ? p.WvT : p.WkT) + ((long)l2 * 1024 + nt * 256) * DM, DM, 64};
          EpiBf16 ep{(kv ? p.Vmem : p.Kmem) + (long)l2 * 1024 * DM, DM, mt * 256, nt * 256, nullptr};
          gemm_tile(smfull, 16, af, bf, ep);
        }
      }
    }
    GSYNCK(2 + layer * 12);
    REP(4) PH(4) {
      for (int it = bid; it < 128; it += nb) {
        const int ks = it & 7, mt = (it >> 3) & 7, kv = it >> 6;
        RowCmp af{p.P + (kv ? 1920 : 1792), mt * 256, ks * 4};
        RowDense bf{p.W1T + ((long)layer * 2 + kv) * 256 * 2048 + ks * 256, 2048, 64};
        EpiF32 ep{p.hidp + ((long)ks * 4096 + kv * 2048) * 256, 256, mt * 256, 0};
        gemm_tile(smfull, 4, af, bf, ep);
      }
      __syncthreads();
      for (int it = vb; it < 24 + 1024; it += nv) {
        if (it < 24) cum_unit(p, layer, it / 6, it % 6, sm);
        else { const int e = it - 24; pool_unit(p, layer, e >> 8, (e >> 2) & 63, e & 3, sm); }
      }
    }
    GSYNCK(3 + layer * 12);
    PH(5) for (int it = vb; it < 256; it += nv) cmp2_unit(p, layer, it >> 7, it & 127, sm);
    GSYNCK(4 + layer * 12);
    REP(6) {
      int* ctr = p.wq + layer * 8 + rep_ * 2;
      for (;;) {
        TSYNC();
        if (tid == 0) xs[0] = atomicAdd(ctr, 1);
        TSYNC();
        const int it = xs[0];
        if (it >= 784) break;
        if (it < 312) { const int qb = 31 - it / 24, bh = it % 24; fox_unit(p, bh / 6, bh % 6, qb, sm); }
        else if (it < 568) { const int e = it - 312; const int qb = 31 - (e >> 3), bg = e & 7; nsa_stageA(p, layer, bg >> 1, bg & 1, qb, sm); }
        else { const int e = it - 568; const int qb = 18 - e / 24, bh = e % 24; fox_unit(p, bh / 6, bh % 6, qb, sm); }
      }
    }
    GSYNCK(5 + layer * 12);
    REP(6) {
      int* ctr = p.wq + layer * 8 + 4 + rep_ * 2;
      for (;;) {
        TSYNC();
        if (tid == 0) xs[0] = atomicAdd(ctr, 1);
        TSYNC();
        const int it = xs[0];
        if (it >= 1008) break;
        if (it < 384) { const int qb = 31 - it / 12, e = it % 12; nsa_stageB(p, layer, e / 3, 3 + e % 3, qb, sm); }
        else if (it < 768) { const int e2 = it - 384; const int qb = 31 - e2 / 12, e = e2 % 12; nsa_stageB(p, layer, e / 3, e % 3, qb, sm); }
        else { const int e = it - 768; const int qb = 9 - e / 24, bh = e % 24; fox_unit(p, bh / 6, bh % 6, qb, sm); }
      }
    }
    GSYNCK(6 + layer * 12);
    PH(7) for (int it = bid; it < 256; it += nb) {
      const int nt = it >> 6, mt = it & 63;
      RowDense af{p.cat + (long)mt * 256 * DM, DM, 64};
      RowDense bf{p.WoutT + ((long)layer * 1024 + nt * 256) * DM, DM, 64};
      EpiResid ep{layer == 0 ? p.x_in : nullptr, p.hb, p.ssq, mt * 256, nt * 256};
      gemm_tile(smfull, 16, af, bf, ep);
    }
    GSYNCK(7 + layer * 12);
    REP(8) PH(8) for (int it = bid; it < 256; it += nb) {
      const int nt = it >> 6, mt = it & 63;
      RowDense af{p.hb + (long)mt * 256 * DM, DM, 64};
      RowDense bf{p.WqT + ((long)layer * 1024 + nt * 256) * DM, DM, 64};
      EpiBf16 ep{p.qx, DM, mt * 256, nt * 256, p.ssq};
#if QEXP == 4
      if (rep_ == 0) { RowDense af0{p.hb, DM, 64}; RowDense bf0{p.WqT + (long)layer * 1024 * DM, DM, 64}; gemm_tile<RowDense, RowDense, EpiBf16, 2>(smfull, 16, af0, bf0, ep); } else
#elif QEXP == 5
      if (rep_ == 0) { RowDense af0{p.hb, 1056, 64}; RowDense bf0{p.WqT + (long)layer * 1024 * DM, 1056, 64}; gemm_tile<RowDense, RowDense, EpiBf16, 2>(smfull, 16, af0, bf0, ep); } else
#elif QEXP == 6
      if (rep_ == 0) { RowDense af0{p.hb + (long)mt * 256 * 1056, 1056, 64}; RowDense bf0{p.WguT + (long)nt * 256 * 1056, 1056, 64}; gemm_tile<RowDense, RowDense, EpiBf16, 2>(smfull, 16, af0, bf0, ep); } else
#elif QEXP == 2
      if (rep_ == 0) gemm_tile<RowDense, RowDense, EpiBf16, 2>(smfull, 16, af, bf, ep); else
#elif QEXP == 3
      if (rep_ == 0) gemm_tile<RowDense, RowDense, EpiBf16, 3>(smfull, 16, af, bf, ep); else
#endif
      gemm_tile(smfull, 16, af, bf, ep);
    }
    GSYNCK(8 + layer * 12);
    REP(5) { __syncthreads(); for (int it = vb; it < 1024; it += nv) { const int dh = it & 1, hd = (it >> 1) & 3, b = (it >> 3) & 3, qb = it >> 5; xattn_unit(p, layer, b, hd, qb, dh, sm); } }
    GSYNCK(9 + layer * 12);
    PH(9) for (int it = bid; it < 256; it += nb) {
      const int nt = it >> 6, mt = it & 63;
      RowDense af{p.ox + (long)mt * 256 * DM, DM, 64};
      RowDense bf{p.WoT + ((long)layer * 1024 + nt * 256) * DM, DM, 64};
      EpiResid ep{nullptr, p.hb, p.ssq, mt * 256, nt * 256};
      gemm_tile(smfull, 16, af, bf, ep);
    }
    GSYNCK(10 + layer * 12);
    PH(10) for (int it = bid; it < 256; it += nb) {
      const int ks = it & 3, mt = it >> 2;
      RowDense af{p.hb + (long)mt * 256 * DM + ks * 256, DM, 64};
      RowDense bf{p.WrT + (long)layer * 256 * DM + ks * 256, DM, 64};
      EpiRouterPart ep{p.rpart + (long)ks * NTOK * 32, mt * 256};
      gemm_tile(smfull, 4, af, bf, ep);
    }
    GSYNC();
    PH(10) if (vb < 64) {
      const int tid = otid();
      const int tok = vb * 256 + tid;
      TSYNC();
      if (tid < 32) xs[tid] = 0;
      TSYNC();
      float lg[20];
#pragma unroll
      for (int q4 = 0; q4 < 5; ++q4) {
        f32x4 v = *(const f32x4*)(p.rpart + (long)tok * 32 + q4 * 4);
#pragma unroll
        for (int sI = 1; sI < 4; ++sI) v += *(const f32x4*)(p.rpart + ((long)sI * NTOK + tok) * 32 + q4 * 4);
        lg[q4 * 4] = v[0]; lg[q4 * 4 + 1] = v[1]; lg[q4 * 4 + 2] = v[2]; lg[q4 * 4 + 3] = v[3];
      }
      { const float rs = row_rstd(p.ssq, tok);
#pragma unroll
        for (int q = 0; q < 20; ++q) lg[q] *= rs; }
      float c[4], f[4];
#pragma unroll
      for (int i = 0; i < 4; ++i) c[i] = lg[i] + p.rc_b[layer * 4 + i];
      int grp = 0; float cm = c[0];
#pragma unroll
      for (int i = 1; i < 4; ++i) if (c[i] > cm) { cm = c[i]; grp = i; }
      float cs = 0.f;
#pragma unroll
      for (int i = 0; i < 4; ++i) cs += __expf(c[i] - cm);
      const float wgrp = 1.0f / cs;
#pragma unroll
      for (int i = 0; i < 4; ++i) { const float l0 = lg[4 + i], l1 = lg[8 + i], l2 = lg[12 + i], l3 = lg[16 + i];
        f[i] = (grp == 0 ? l0 : grp == 1 ? l1 : grp == 2 ? l2 : l3) + p.rf_b[layer * 16 + grp * 4 + i]; }
      int i1 = 0; float f1 = f[0];
#pragma unroll
      for (int i = 1; i < 4; ++i) if (f[i] > f1) { f1 = f[i]; i1 = i; }
      int i2 = -1; float f2 = -INFINITY;
#pragma unroll
      for (int i = 0; i < 4; ++i) if (i != i1 && f[i] > f2) { f2 = f[i]; i2 = i; }
      const float e2 = __expf(f2 - f1);
      const float w1 = wgrp / (1.0f + e2), w2 = wgrp * e2 / (1.0f + e2);
      const int a = i1 < i2 ? i1 : i2, bq = i1 < i2 ? i2 : i1;
      const float wa = i1 < i2 ? w1 : w2, wb = i1 < i2 ? w2 : w1;
      const int pairidx = (a == 0) ? (bq - 1) : (a == 1 ? bq + 1 : 5);
      const int cls = grp * 6 + pairidx;
      const int lpos = __hip_atomic_fetch_add(xs + cls, 1, __ATOMIC_RELAXED, __HIP_MEMORY_SCOPE_WORKGROUP);
      TSYNC();
      if (tid < 24) xs[32 + tid] = atomicAdd(&p.mcnt[layer * 32 + tid], xs[tid]);
      TSYNC();
      const int pos = xs[32 + cls] + lpos;
      p.mlist[((long)layer * 24 + cls) * NTOK + pos] = tok;
      p.tokw[tok * 2 + 0] = wa; p.tokw[tok * 2 + 1] = wb;
    }
    GSYNCK(11 + layer * 12);
    PH(11) {
      LAS int* tstart = xsg;
      LAS int* ccnt = xsg + 32;
      LAS int* toks = xsg + 64;
      LAS float* wts = (LAS float*)xsg + 320;
      LAS float* rsd = (LAS float*)xsg + 576;
      __syncthreads();
      if (tid5 == 0) { int a = 0; for (int c = 0; c < 24; ++c) { const int n = p.mcnt[layer * 32 + c]; ccnt[c] = n; tstart[c] = a; a += (n + 255) >> 8; } tstart[24] = a; }
      __syncthreads();
      const int nrt = tstart[24];
      for (int pass = 0; pass < 2; ++pass) {
        const int nct = pass == 0 ? 8 : 4;
        for (int it = bid; it < nrt * nct; it += nb) {
          const int rt = it / nct, ct = it % nct;
          int cls = 0;
          for (int c = 1; c < 24; ++c) if (rt >= tstart[c]) cls = c;
          const int rtl = rt - tstart[cls];
          const int grp = cls / 6, pi = cls % 6;
          const int ea = grp * 4 + (pi < 3 ? 0 : (pi < 5 ? 1 : 2)), eb = grp * 4 + (pi < 3 ? pi + 1 : (pi < 5 ? pi - 1 : 3));
          __syncthreads();
          const int tid5 = otid512();
          if (tid5 < 256) { const int idx = rtl * 256 + tid5; const bool ok = idx < ccnt[cls];
            const int tk = ok ? p.mlist[((long)layer * 24 + cls) * NTOK + idx] : -1; toks[tid5] = tk;
            wts[tid5] = ok ? p.tokw[tk * 2 + (ct < 4 ? 0 : 1)] : 0.f; rsd[tid5] = ok ? row_rstd(p.ssq, tk) : 0.f; }
          __syncthreads();
          if (pass == 0) {
            const int ex = ct < 4 ? ea : eb;
            RowGather af{p.hb, DM, toks};
            RowDense bf{p.WguT + (((long)layer * 16 + ex) * 1024 + (ct & 3) * 256) * DM, DM, 64};
            EpiMoeUp ep{p.he, (long)rt * 256, (ct < 4 ? 0 : 512) + (ct & 3) * 128, wts, rsd};
            gemm_tile(smfull, 16, af, bf, ep);
          } else {
            RowDense af{p.he + (long)rt * 256 * DM, DM, 64};
            const bf16_t* ba = p.WdT + (((long)layer * 16 + ea) * 1024 + ct * 256) * 512;
            const bf16_t* bb = p.WdT + (((long)layer * 16 + eb) * 1024 + ct * 256) * 512;
            RowSplit bf{ba, 512, (long)(bb - ba)};
            EpiMoeDown ep{p.hb, p.ssq, ct * 256, toks};
            gemm_tile(smfull, 16, af, bf, ep);
          }
        }
        GSYNCK(12 + pass + layer * 12);
      }
    }
  }
  finalnorm(p.hb, p.ssq, p.final_g, p.xw, NTOK);
  if (SPINMASK != 0ull && bid == 0 && tid5 == 0) {
    unsigned long long tot = 0;
    for (int k = 0; k < 25; ++k) if ((SPINMASK >> k) & 1ull) tot += ((unsigned long long*)(xb.bar + 4096))[k + 1] - ((unsigned long long*)(xb.bar + 4096))[k];
    const unsigned long long t0 = __builtin_amdgcn_s_memrealtime();
    while (__builtin_amdgcn_s_memrealtime() - t0 < tot * SPINMUL) __builtin_amdgcn_s_sleep(8);
  }
}

static inline size_t al256(size_t x) { return (x + 255) & ~(size_t)255; }
extern "C" void kernel_launch(void* const* d_in, const int* in_sizes, int n_in, void* d_out, int out_size, void* d_ws, size_t ws_size, hipStream_t stream) {
  Params p; memset(&p, 0, sizeof(p));
  const float* const* in = (const float* const*)d_in;
  p.x_in = in[0]; p.mem = in[1]; p.mix_g = in[2]; p.fox_b = in[4]; p.pool_w = in[5]; p.pool_scale = in[6]; p.pe_k = in[7]; p.pe_v = in[8];
  p.w1k = in[9]; p.w1v = in[11]; p.w2k = in[10]; p.w2v = in[12]; p.gate_b = in[13]; p.xattn_g = in[15]; p.mem_g = in[16]; p.ffn_g = in[21]; p.rc_b = in[23]; p.rf_b = in[25]; p.final_g = in[29];
  p.xw = (float*)d_out;
  char* ws = (char*)d_ws; size_t off = 0;
  auto take = [&](size_t bytes) { char* r = ws + off; off = al256(off + bytes); return r; };
  p.bar = (unsigned*)take(4096 * 4 + 128 * 8);
  p.mcnt = (int*)take(64 * 4);
  p.wq = (int*)take(64 * 4);
  p.WinT = (bf16_t*)take(2UL * 2816 * 1024 * 2);
  p.WoutT = (bf16_t*)take(2UL * 1024 * 1024 * 2);
  p.WqT = (bf16_t*)take(2UL * 1024 * 1024 * 2);
  p.WkT = (bf16_t*)take(2UL * 1024 * 1024 * 2);
  p.WvT = (bf16_t*)take(2UL * 1024 * 1024 * 2);
  p.WoT = (bf16_t*)take(2UL * 1024 * 1024 * 2);
  p.WguT = (bf16_t*)take(2UL * 16 * 1024 * 1024 * 2);
  p.WdT = (bf16_t*)take(2UL * 16 * 1024 * 512 * 2);
  p.W1T = (bf16_t*)take(2UL * 2 * 256 * 2048 * 2);
  p.W2T = (bf16_t*)take(2UL * 2 * 64 * 256 * 2);
  p.WrT = (bf16_t*)take(2UL * 256 * 1024 * 2);
  p.bias1 = (float*)take(1024 * 4);
  p.hb = (bf16_t*)take((size_t)NTOK * 1024 * 2);
  p.onsa = (float*)d_out; p.hidp = (float*)d_out;
  p.P = (bf16_t*)take((size_t)NTOK * PW * 2);
  p.qx = p.P;
  p.ox = p.P + (size_t)NTOK * 1024;
  p.he = p.P;
  p.rpart = (float*)(p.P + (size_t)NTOK * 2048);
  p.cat = (bf16_t*)take((size_t)NTOK * 1024 * 2);
  p.memn = (bf16_t*)take(2UL * 1024 * 1024 * 2);
  p.Kmem = (bf16_t*)take(2UL * 1024 * 1024 * 2);
  p.Vmem = (bf16_t*)take(2UL * 1024 * 1024 * 2);
  p.hid = (bf16_t*)take(2UL * 2048 * 256 * 2);
  p.kvc = (bf16_t*)take(2UL * 2048 * 64 * 2);
  p.fgl = (float*)take((size_t)NTOK * 32 * 4);
  p.cum = (float*)take(24UL * SEQ * 4);
  p.tokw = (float*)take((size_t)NTOK * 2 * 4);
  p.ssq = (float*)take((size_t)NTOK * 16 * 4);
  p.mlist = (int*)take(2UL * 24 * NTOK * 4);
  p.selm = (unsigned*)take((size_t)NTOK * 2 * 2 * 4);
  int nj = 0, tile0 = 0;
  auto job = [&](const float* src, bf16_t* dst, long sbs, long dbs, int K, int N, int lds, int ldd, int map, int nbatch, const float* g = nullptr, int gdiv = 1) {
    TJob& j = p.jobs[nj++]; j.src = src; j.dst = dst; j.g = g; j.sbs = sbs; j.dbs = dbs; j.K = K; j.N = N; j.lds = lds; j.ldd = ldd; j.map = map;
    j.tpb = (K / 64) * ((N + 63) / 64); j.tile0 = tile0; j.gdiv = gdiv; tile0 += j.tpb * nbatch; };
  job(in[26], p.WguT, 1024L * 512, 1024L * 1024, 1024, 512, 512, 1024, 2, 32, in[21], 16);
  job(in[27], p.WguT, 1024L * 512, 1024L * 1024, 1024, 512, 512, 1024, 3, 32, in[21], 16);
  job(in[28], p.WdT, 512L * 1024, 1024L * 512, 512, 1024, 1024, 512, 0, 32);
  job(in[3], p.WinT, 1024L * 2584, 2816L * 1024, 1024, 2584, 2584, 1024, 1, 2, in[2], 1);
  job(in[14], p.WoutT, 1024L * 1024, 1024L * 1024, 1024, 1024, 1024, 1024, 0, 2);
  job(in[17], p.WqT, 1024L * 1024, 1024L * 1024, 1024, 1024, 1024, 1024, 0, 2, in[15], 1);
  job(in[18], p.WkT, 1024L * 1024, 1024L * 1024, 1024, 1024, 1024, 1024, 0, 2);
  job(in[19], p.WvT, 1024L * 1024, 1024L * 1024, 1024, 1024, 1024, 1024, 0, 2);
  job(in[20], p.WoT, 1024L * 1024, 1024L * 1024, 1024, 1024, 1024, 1024, 0, 2);
  job(in[9], p.W1T, 2048L * 256, 2L * 256 * 2048, 2048, 256, 256, 2048, 0, 2);
  job(in[11], p.W1T + 256L * 2048, 2048L * 256, 2L * 256 * 2048, 2048, 256, 256, 2048, 0, 2);
  job(in[10], p.W2T, 256L * 64, 2L * 64 * 256, 256, 64, 64, 256, 0, 2);
  job(in[12], p.W2T + 64L * 256, 256L * 64, 2L * 64 * 256, 256, 64, 64, 256, 0, 2);
  job(in[22], p.WrT, 1024L * 4, 256L * 1024, 1024, 4, 4, 1024, 0, 2, in[21], 1);
  job(in[24], p.WrT + 4L * 1024, 1024L * 16, 256L * 1024, 1024, 16, 16, 1024, 0, 2, in[21], 1);
  p.ttiles = tile0; p.never = 0;
  static int grid_blocks = 0;
  if (!grid_blocks) {
    int dev = 0, cus = 0, per_cu = 0;
    (void)hipGetDevice(&dev);
    (void)hipDeviceGetAttribute(&cus, hipDeviceAttributeMultiprocessorCount, dev);
    if (hipFuncSetAttribute((const void*)fwd_kernel, hipFuncAttributeMaxDynamicSharedMemorySize, LDS_BYTES) != hipSuccess) fprintf(stderr, "hipFuncSetAttribute(dynamic LDS %d) failed\n", LDS_BYTES);
    (void)hipOccupancyMaxActiveBlocksPerMultiprocessor(&per_cu, fwd_kernel, 512, LDS_BYTES);
    (void)hipGetLastError();
    grid_blocks = cus;
  }
  (void)hipMemsetAsync(p.bar, 0, XCD_BAR_WORDS * 4, stream);
  void* args[] = {&p};
  hipError_t e = hipLaunchCooperativeKernel((void*)fwd_kernel, dim3(grid_blocks), dim3(512), args, LDS_BYTES, stream);
  if (e != hipSuccess) fprintf(stderr, "cooperative launch failed: %s (grid %d, ws needed %zu of %zu)\n", hipGetErrorString(e), grid_blocks, off, ws_size);
}
```

```cpp
#define DUPMASK 0
#define FLEXP 0
#define SPINMASK 0ull
#define SPINMUL 8
#define QEXP 0
#include <hip/hip_runtime.h>
#include <hip/hip_cooperative_groups.h>
#include <cstdint>
#include <cstdio>
#include <cstring>
namespace cg = cooperative_groups;

#define LAS __attribute__((address_space(3)))
typedef unsigned short bf16_t;
typedef short bf16x8 __attribute__((ext_vector_type(8)));
typedef short s16x4 __attribute__((ext_vector_type(4)));
typedef float f32x16 __attribute__((ext_vector_type(16)));
typedef float f32x4 __attribute__((ext_vector_type(4)));
typedef float f32x2 __attribute__((ext_vector_type(2)));
typedef unsigned u32x4 __attribute__((ext_vector_type(4)));
typedef unsigned u32x2 __attribute__((ext_vector_type(2)));
typedef __bf16 bf16x2_t __attribute__((ext_vector_type(2)));

#define NTOK 16384
#define SEQ 4096
#define DM 1024
#define PW 2560
#define LOG2E 1.4426950408889634f

__device__ __forceinline__ unsigned cvtpk(float lo, float hi) { f32x2 v = {lo, hi}; bf16x2_t b = __builtin_convertvector(v, bf16x2_t); return __builtin_bit_cast(unsigned, b); }
__device__ __forceinline__ bf16_t f2bf(float x) { return (bf16_t)(cvtpk(x, 0.f) & 0xffffu); }
__device__ __forceinline__ float bf2f(bf16_t b) { return __uint_as_float(((unsigned)b) << 16); }
__device__ __forceinline__ long kbo(long R, long r, int k) { return ((long)(k >> 5) * R + r) * 32 + (k & 31); }
#define HE_ROWS 22528
__device__ __forceinline__ int crow(int r, int hi) { return (r & 3) + 8 * (r >> 2) + 4 * hi; }
__device__ __forceinline__ float fexp2(float x) { return __builtin_amdgcn_exp2f(x); }
extern __shared__ __attribute__((aligned(16))) unsigned char lds_dyn[];
#define LDS_XS 131072
#define LDS_XB 135168
#define LDS_TB 135232
#define LDS_BYTES 135424
__device__ __forceinline__ int otid() { int t = threadIdx.x & 255; asm volatile("" : "+v"(t)); return t; }
__device__ __forceinline__ int otid512() { int t = threadIdx.x; asm volatile("" : "+v"(t)); return t; }
__device__ __forceinline__ int team_id() { return __builtin_amdgcn_readfirstlane((int)(threadIdx.x >> 8)); }
__device__ __forceinline__ int vbid() { return blockIdx.x * 2 + team_id(); }
__device__ __forceinline__ int nvb() { return gridDim.x * 2; }
__device__ __forceinline__ void team_sync() {
  asm volatile("s_waitcnt lgkmcnt(0)" ::: "memory");
  LAS unsigned* ctr = (LAS unsigned*)((LAS char*)lds_dyn + LDS_TB + team_id() * 64);
  unsigned old = 0u;
  if ((threadIdx.x & 63) == 0) old = __hip_atomic_fetch_add(ctr, 1u, __ATOMIC_RELAXED, __HIP_MEMORY_SCOPE_WORKGROUP);
  old = __builtin_amdgcn_readfirstlane(old);
  const unsigned tgt = (old & ~3u) + 4u;
  while ((int)(__hip_atomic_load(ctr, __ATOMIC_RELAXED, __HIP_MEMORY_SCOPE_WORKGROUP) - tgt) < 0) __builtin_amdgcn_s_sleep(0);
  asm volatile("" ::: "memory");
}
#define TSYNC() team_sync()
__device__ __forceinline__ float sigmoidf_(float x) { return 1.0f / (1.0f + __expf(-x)); }

struct TJob { const float* src; bf16_t* dst; const float* g; long sbs, dbs; int K, N, lds, R, map, tpb, tile0, gdiv; };
#define NJOBS 13
struct Params {
  const float *x_in, *mem, *mix_g, *fox_b, *pool_w, *pool_scale, *pe_k, *pe_v, *w1k, *w1v, *w2k, *w2v, *gate_b;
  const float *xattn_g, *mem_g, *ffn_g, *rc_b, *rf_b, *final_g;
  float* xw;
  bf16_t *WinT, *WoutT, *WqT, *WkT, *WvT, *WoT, *WguT, *WdT, *W1T, *W2T, *WrT;
  float* bias1;
  bf16_t *hb, *P, *cat, *memn, *Kmem, *Vmem, *hid, *kvc, *qx, *ox, *he;
  float *fgl, *cum, *onsa, *tokw, *hidp, *rpart, *ssq;
  int *mlist, *mcnt, *wq;
  unsigned* selm;
  unsigned* bar;
  TJob jobs[NJOBS];
  int ttiles; int never;
};

#define XB_TMO      128
#define XB_XCNT(j)  (256  + 64 * (j))
#define XB_XSUB(j)  (1280 + 64 * (j))
#define XB_XGEN(j)  (2304 + 64 * (j))
#define XB_TOP      3328
#define XB_TOPGEN   3392
#define XCD_BAR_WORDS 3456
#define XB_SPIN_CAP (1u << 22)
__device__ __forceinline__ unsigned xb_ld(unsigned* p)              { return __hip_atomic_load(p, __ATOMIC_RELAXED, __HIP_MEMORY_SCOPE_AGENT); }
__device__ __forceinline__ unsigned xb_add(unsigned* p, unsigned v) { return __hip_atomic_fetch_add(p, v, __ATOMIC_RELAXED, __HIP_MEMORY_SCOPE_AGENT); }
__device__ __forceinline__ unsigned xb_xcc_id() { return (unsigned)__builtin_amdgcn_s_getreg((3 << 11) | 20) & 0xFu; }
#define XB_SPIN(cond, bar) do { unsigned _sp = 0; while (cond) { __builtin_amdgcn_s_sleep(1); \
    if ((++_sp & 255u) == 0u) { if (xb_ld(&(bar)[XB_TMO])) break; if (_sp > XB_SPIN_CAP) { atomicAdd(&(bar)[XB_TMO], 1u); break; } } } } while (0)
struct XcdBarrier { unsigned* bar; unsigned x; volatile LAS unsigned* st; };
__device__ __forceinline__ XcdBarrier xcd_barrier_post(unsigned* bar, volatile LAS unsigned* st) {
    XcdBarrier b; b.bar = bar; b.x = xb_xcc_id(); b.st = st;
    if (threadIdx.x == 0) (void)xb_add(&bar[XB_XCNT(b.x)], 1u);
    return b;
}
__device__ __forceinline__ void xcd_barrier_complete(unsigned* bar, unsigned x, unsigned& nloc, unsigned& nx) {
    const unsigned G = gridDim.x * gridDim.y * gridDim.z;
    unsigned sum, cnt, mine, sp = 0u;
    for (;;) {
        sum = 0u; cnt = 0u; mine = 0u;
#pragma unroll
        for (unsigned j = 0; j < 16; ++j) { const unsigned c = xb_ld(&bar[XB_XCNT(j)]); sum += c; cnt += (c > 0u) ? 1u : 0u; mine = (j == x) ? c : mine; }
        if (sum == G) break;
        __builtin_amdgcn_s_sleep(1);
        if ((++sp & 255u) == 0u) { if (xb_ld(&bar[XB_TMO])) break; if (sp > XB_SPIN_CAP) { atomicAdd(&bar[XB_TMO], 1u); break; } }
    }
    nloc = mine > 0u ? mine : 1u; nx = cnt > 0u ? cnt : 1u;
}
__device__ __forceinline__ void xcd_barrier(const XcdBarrier& b) {
    asm volatile("s_waitcnt vmcnt(0)" ::: "memory");
    __syncthreads();
    if (threadIdx.x == 0) {
        unsigned* bar = b.bar;
        unsigned bx = __builtin_amdgcn_readfirstlane(b.x); asm volatile("" : "+s"(bx));
        __builtin_amdgcn_s_waitcnt(0);
        unsigned nloc = b.st[0], nx = b.st[1];
        if (nloc == 0u) { xcd_barrier_complete(bar, bx, nloc, nx); b.st[0] = nloc; b.st[1] = nx; }
        const unsigned old = xb_add(&bar[XB_XSUB(bx)], 1u);
        const unsigned gen = old / nloc;
        if (old + 1u == (gen + 1u) * nloc) {
            __builtin_amdgcn_fence(__ATOMIC_RELEASE, "agent");
            asm volatile("s_waitcnt vmcnt(0)" ::: "memory");
            const unsigned og = xb_add(&bar[XB_TOP], 1u);
            const unsigned tg = og / nx;
            if (og + 1u == (tg + 1u) * nx) xb_add(&bar[XB_TOPGEN], 1u);
            else XB_SPIN(xb_ld(&bar[XB_TOPGEN]) == tg, bar);
            __builtin_amdgcn_fence(__ATOMIC_ACQUIRE, "agent");
            xb_add(&bar[XB_XGEN(bx)], 1u);
            asm volatile("s_waitcnt vmcnt(0)" ::: "memory");
        } else {
            XB_SPIN(xb_ld(&bar[XB_XGEN(bx)]) == gen, bar);
            __builtin_amdgcn_fence(__ATOMIC_ACQUIRE, "agent");
            asm volatile("s_waitcnt vmcnt(0)" ::: "memory");
        }
    }
    __syncthreads();
}

__device__ __forceinline__ int nmap(int map, int n) {
  if (map == 1) { if (n < 1152) return n; if (n < 1158) return 2560 + (n - 1152); if (n < 2566) return n - 6; return n; }
  if (map == 2) return 64 * (n >> 5) + (n & 31);
  if (map == 3) return 64 * (n >> 5) + 32 + (n & 31);
  return n;
}
__device__ __forceinline__ void transpose_tile(const TJob& j, int t, LAS char* sm) {
  const int tid = otid();
  const int tb = t / j.tpb, tt = t - tb * j.tpb;
  const int nkt = j.K >> 6;
  const int kt = tt % nkt, nt = tt / nkt;
  const float* src = j.src + (long)tb * j.sbs + (long)(kt * 64) * j.lds + nt * 64;
  bf16_t* dst = j.dst + (long)tb * j.dbs;
  LAS float* tile = (LAS float*)sm;
  {
    const int tk = tid >> 4, tn4 = tid & 15;
    const bool ok = (nt * 64 + tn4 * 4) < j.N;
#pragma unroll
    for (int i = 0; i < 4; ++i) {
      const int k = tk + 16 * i;
      f32x4 v = {0.f, 0.f, 0.f, 0.f};
      if (ok) v = *(const f32x4*)(src + (long)k * j.lds + tn4 * 4);
      if (j.g) v *= j.g[(tb / j.gdiv) * DM + kt * 64 + k];
      tile[k * 65 + tn4 * 4 + 0] = v[0]; tile[k * 65 + tn4 * 4 + 1] = v[1]; tile[k * 65 + tn4 * 4 + 2] = v[2]; tile[k * 65 + tn4 * 4 + 3] = v[3];
    }
  }
  TSYNC();
  {
    const int n = tid >> 2, kq = tid & 3, ng = nt * 64 + n;
    if (ng < j.N) {
      const int row = nmap(j.map, ng);
      unsigned w[8];
#pragma unroll
      for (int c = 0; c < 8; ++c) w[c] = cvtpk(tile[(kq * 16 + 2 * c) * 65 + n], tile[(kq * 16 + 2 * c + 1) * 65 + n]);
      bf16_t* d = dst + kbo(j.R, row, kt * 64 + kq * 16);
      *(u32x4*)d = (u32x4){w[0], w[1], w[2], w[3]};
      *(u32x4*)(d + 8) = (u32x4){w[4], w[5], w[6], w[7]};
    }
  }
  TSYNC();
}

template <bool F32OUT>
__device__ __forceinline__ void rownorm(const float* x, const float* g, void* out, int nrows) {
  const int tid = otid(); const int lane = tid & 63;
  const int gw = vbid() * 4 + (tid >> 6), nw = nvb() * 4;
  for (int row = gw; row < nrows; row += nw) {
    const float* xr = x + (long)row * DM;
    f32x4 v[4]; float ss = 0.f;
#pragma unroll
    for (int i = 0; i < 4; ++i) { v[i] = *(const f32x4*)(xr + i * 256 + lane * 4); ss += v[i][0] * v[i][0] + v[i][1] * v[i][1] + v[i][2] * v[i][2] + v[i][3] * v[i][3]; }
#pragma unroll
    for (int o = 32; o >= 1; o >>= 1) ss += __shfl_xor(ss, o);
    const float rstd = 1.0f / sqrtf(ss * (1.0f / DM) + 1e-6f);
#pragma unroll
    for (int i = 0; i < 4; ++i) {
      const f32x4 gg = *(const f32x4*)(g + i * 256 + lane * 4);
      const f32x4 y = v[i] * rstd * gg;
      if (F32OUT) *(f32x4*)((float*)out + (long)row * DM + i * 256 + lane * 4) = y;
      else { u32x2 w; w.x = cvtpk(y[0], y[1]); w.y = cvtpk(y[2], y[3]); *(u32x2*)((bf16_t*)out + kbo(nrows, row, i * 256 + lane * 4)) = w; }
    }
  }
}

__device__ __forceinline__ float row_rstd(const float* ssq, long row) {
  const f32x4 a = *(const f32x4*)(ssq + row * 16), b = *(const f32x4*)(ssq + row * 16 + 4), c = *(const f32x4*)(ssq + row * 16 + 8), d = *(const f32x4*)(ssq + row * 16 + 12);
  const float t = ((a[0] + a[1]) + (a[2] + a[3])) + ((b[0] + b[1]) + (b[2] + b[3])) + ((c[0] + c[1]) + (c[2] + c[3])) + ((d[0] + d[1]) + (d[2] + d[3]));
  return 1.0f / sqrtf(t * (1.0f / DM) + 1e-6f);
}
__device__ __forceinline__ void rowprep(const float* x, bf16_t* xb, float* ssq, int nrows) {
  const int tid = otid(); const int lane = tid & 63;
  const int gw = vbid() * 4 + (tid >> 6), nw = nvb() * 4;
  for (int row = gw; row < nrows; row += nw) {
    const float* xr = x + (long)row * DM;
    f32x4 v[4]; float ss = 0.f;
#pragma unroll
    for (int i = 0; i < 4; ++i) { v[i] = *(const f32x4*)(xr + i * 256 + lane * 4); ss += v[i][0] * v[i][0] + v[i][1] * v[i][1] + v[i][2] * v[i][2] + v[i][3] * v[i][3]; }
#pragma unroll
    for (int o = 32; o >= 1; o >>= 1) ss += __shfl_xor(ss, o);
#pragma unroll
    for (int i = 0; i < 4; ++i) { u32x2 w; w.x = cvtpk(v[i][0], v[i][1]); w.y = cvtpk(v[i][2], v[i][3]); *(u32x2*)(xb + kbo(NTOK, row, i * 256 + lane * 4)) = w; }
    if (lane < 16) ssq[(long)row * 16 + lane] = lane == 0 ? ss : 0.f;
  }
}
struct RowKB { const bf16_t* base; long R; int r0; int s0;
  __device__ __forceinline__ const bf16_t* bptr() const { return base; }
  __device__ __forceinline__ unsigned rowoff(int r) const { return (unsigned)((r0 + r) * 32); }
  __device__ __forceinline__ long soff(int s) const { return (long)(s0 + s) * R * 32; } };
struct RowGather { const bf16_t* base; long R; LAS const int* toks;
  __device__ __forceinline__ const bf16_t* bptr() const { return base; }
  __device__ __forceinline__ unsigned rowoff(int r) const { int t = toks[r]; t = t < 0 ? 0 : t; return (unsigned)(t * 32); }
  __device__ __forceinline__ long soff(int s) const { return (long)s * R * 32; } };
struct RowCmp { const bf16_t* base; int r0; int kt0;
  __device__ __forceinline__ const bf16_t* bptr() const { return base; }
  __device__ __forceinline__ unsigned rowoff(int r) const { const int R = r0 + r; const int bg = R >> 8; int c = R & 255; c = c > 254 ? 254 : c;
    return (unsigned)(((bg >> 1) * SEQ + 16 * c) * PW + (bg & 1) * 64); }
  __device__ __forceinline__ long soff(int s) const { return (long)(kt0 + (s >> 1)) * PW + (s & 1) * 32; } };
struct RowSplitKB { const bf16_t* base; long R; int r0; long delta;
  __device__ __forceinline__ const bf16_t* bptr() const { return base; }
  __device__ __forceinline__ unsigned rowoff(int r) const { return (unsigned)((r0 + r) * 32); }
  __device__ __forceinline__ long soff(int s) const { return s < 16 ? (long)s * R * 32 : delta + (long)(s - 16) * R * 32; } };
__device__ __forceinline__ float gelu_tanh(float x) { const float u = 0.7978845608028654f * (x + 0.044715f * x * x * x); return 0.5f * x * (1.0f + tanhf(u)); }
__device__ __forceinline__ void finalnorm(const bf16_t* xb, const float* ssq, const float* g, float* out, int nrows) {
  const int tid = otid(); const int lane = tid & 63;
  const int gw = vbid() * 4 + (tid >> 6), nw = nvb() * 4;
  for (int row = gw; row < nrows; row += nw) {
    const float rs = row_rstd(ssq, row);
#pragma unroll
    for (int i = 0; i < 2; ++i) {
      const u32x4 w = *(const u32x4*)(xb + kbo(NTOK, row, i * 512 + lane * 8));
      const f32x4 g0 = *(const f32x4*)(g + i * 512 + lane * 8), g1 = *(const f32x4*)(g + i * 512 + lane * 8 + 4);
      float* op = out + (long)row * DM + i * 512 + lane * 8;
      *(f32x4*)op = (f32x4){__uint_as_float(w.x << 16) * rs * g0[0], __uint_as_float(w.x & 0xffff0000u) * rs * g0[1], __uint_as_float(w.y << 16) * rs * g0[2], __uint_as_float(w.y & 0xffff0000u) * rs * g0[3]};
      *(f32x4*)(op + 4) = (f32x4){__uint_as_float(w.z << 16) * rs * g1[0], __uint_as_float(w.z & 0xffff0000u) * rs * g1[1], __uint_as_float(w.w << 16) * rs * g1[2], __uint_as_float(w.w & 0xffff0000u) * rs * g1[3]};
    }
  }
}
#define GT_WAITBAR(N) asm volatile("s_waitcnt vmcnt(" #N ")\n\ts_barrier" ::: "memory")
template <class AF, class BF, class EPI, int EXPM = 0>
__device__ __forceinline__ void gemm_tile(LAS char* sm, int nkt, const AF& af, const BF& bfn, const EPI& epi) {
  const int tid = otid512(), lane = tid & 63, wid = __builtin_amdgcn_readfirstlane(tid >> 6), wm = wid >> 2, wn = wid & 3, l31 = lane & 31, hh = lane >> 5;
  const int lrow = tid >> 2;
  const int lkc = (tid & 3) ^ ((tid >> 4) & 3);
  unsigned ao[2], bo[2];
#pragma unroll
  for (int i = 0; i < 2; ++i) { ao[i] = (af.rowoff(lrow + 128 * i) + lkc * 8) * 2u; bo[i] = (bfn.rowoff(lrow + 128 * i) + lkc * 8) * 2u; }
  const char* abase = (const char*)af.bptr(); const char* bbase = (const char*)bfn.bptr();
  const int swz = (l31 >> 2) & 3;
  const int koff0 = ((hh ^ swz) << 4), koff1 = (((2 + hh) ^ swz) << 4);
  const int arow = (wm * 128 + l31) * 64, brow = 16384 + (wn * 64 + l31) * 64;
  f32x16 acc[4][2];
#pragma unroll
  for (int i = 0; i < 4; ++i)
#pragma unroll
    for (int j = 0; j < 2; ++j)
#pragma unroll
      for (int r = 0; r < 16; ++r) acc[i][j][r] = 0.f;
  LAS char* dst0 = sm + wid * 1024;
#define GT_ISSUE(st_) do { const int s__ = (st_); const long ka_ = af.soff(s__) * 2, kb_ = bfn.soff(s__) * 2; LAS char* d_ = dst0 + (s__ & 3) * 32768; \
    _Pragma("unroll") for (int i = 0; i < 2; ++i) { \
      __builtin_amdgcn_global_load_lds((const unsigned*)(abase + ka_ + ao[i]), (LAS unsigned*)(d_ + i * 8192), 16, 0, 0); \
      __builtin_amdgcn_global_load_lds((const unsigned*)(bbase + kb_ + bo[i]), (LAS unsigned*)(d_ + 16384 + i * 8192), 16, 0, 0); } } while (0)
  const int nst = 2 * nkt;
  __syncthreads();
  if (!(EXPM & 1)) { GT_ISSUE(0); GT_ISSUE(1); GT_ISSUE(2); }
  for (int st = 0; st < nst; ++st) {
    if (st + 2 < nst) GT_WAITBAR(8); else if (st + 1 < nst) GT_WAITBAR(4); else GT_WAITBAR(0);
    if (st + 3 < nst && !(EXPM & 1)) GT_ISSUE(st + 3);
    const int cur = (st & 3) * 32768;
#pragma unroll
    for (int s2 = 0; s2 < 2; ++s2) {
      const int ko = s2 ? koff1 : koff0;
      bf16x8 af4[4], bf2[2];
#pragma unroll
      for (int i = 0; i < 4; ++i) af4[i] = *(LAS const bf16x8*)(sm + cur + arow + i * 2048 + ko);
#pragma unroll
      for (int j = 0; j < 2; ++j) bf2[j] = *(LAS const bf16x8*)(sm + cur + brow + j * 2048 + ko);
#pragma unroll
      for (int i = 0; i < 4; ++i)
#pragma unroll
        for (int j = 0; j < 2; ++j) acc[i][j] = __builtin_amdgcn_mfma_f32_32x32x16_bf16(bf2[j], af4[i], acc[i][j], 0, 0, 0);
    }
  }
#undef GT_ISSUE
  if (!(EXPM & 2)) epi(acc, wm, wn, lane);
}

struct EpiInproj { bf16_t* P; float* fgl; const float* ssq; int mt, nt;
  __device__ __forceinline__ void operator()(f32x16 (&acc)[4][2], int wm, int wn, int lane) const {
    const int l31 = lane & 31, hh = lane >> 5;
#pragma unroll
    for (int i = 0; i < 4; ++i) {
      const long row = mt * 256 + wm * 128 + i * 32 + l31;
      const float rs = row_rstd(ssq, row);
#pragma unroll
      for (int j = 0; j < 2; ++j)
#pragma unroll
        for (int a = 0; a < 4; ++a) {
          const int col = nt * 256 + wn * 64 + j * 32 + 8 * a + 4 * hh;
          const f32x4 v = (f32x4){acc[i][j][4 * a] * rs, acc[i][j][4 * a + 1] * rs, acc[i][j][4 * a + 2] * rs, acc[i][j][4 * a + 3] * rs};
          if (nt < 10) { u32x2 w; w.x = cvtpk(v[0], v[1]); w.y = cvtpk(v[2], v[3]); *(u32x2*)(P + row * PW + col) = w; }
          else { const int c = col - 2560; if (c < 24) *(f32x4*)(fgl + row * 32 + c) = v; }
        }
    }
  } };
struct EpiBf16 { bf16_t* out; long ld; int row0, col0; const float* ssq;
  __device__ __forceinline__ void operator()(f32x16 (&acc)[4][2], int wm, int wn, int lane) const {
    const int l31 = lane & 31, hh = lane >> 5;
#pragma unroll
    for (int i = 0; i < 4; ++i) {
      const long row = row0 + wm * 128 + i * 32 + l31;
      const float rs = ssq ? row_rstd(ssq, row) : 1.0f;
      bf16_t* rp = out + row * ld + col0 + wn * 64 + 4 * hh;
#pragma unroll
      for (int j = 0; j < 2; ++j)
#pragma unroll
        for (int a = 0; a < 4; ++a) { u32x2 w; w.x = cvtpk(acc[i][j][4 * a] * rs, acc[i][j][4 * a + 1] * rs); w.y = cvtpk(acc[i][j][4 * a + 2] * rs, acc[i][j][4 * a + 3] * rs); *(u32x2*)(rp + j * 32 + 8 * a) = w; }
    }
  } };
struct EpiF32 { float* out; long ld; int row0, col0;
  __device__ __forceinline__ void operator()(f32x16 (&acc)[4][2], int wm, int wn, int lane) const {
    const int l31 = lane & 31, hh = lane >> 5;
#pragma unroll
    for (int i = 0; i < 4; ++i) {
      float* rp = out + (long)(row0 + wm * 128 + i * 32 + l31) * ld + col0 + wn * 64 + 4 * hh;
#pragma unroll
      for (int j = 0; j < 2; ++j)
#pragma unroll
        for (int a = 0; a < 4; ++a) *(f32x4*)(rp + j * 32 + 8 * a) = (f32x4){acc[i][j][4 * a], acc[i][j][4 * a + 1], acc[i][j][4 * a + 2], acc[i][j][4 * a + 3]};
    }
  } };
struct EpiResid { const float* basef; bf16_t* xb; float* ssq; int row0, col0;
  __device__ __forceinline__ void operator()(f32x16 (&acc)[4][2], int wm, int wn, int lane) const {
    const int l31 = lane & 31, hh = lane >> 5;
#pragma unroll
    for (int i = 0; i < 4; ++i) {
      const long row = row0 + wm * 128 + i * 32 + l31;
      const int c0 = col0 + wn * 64 + 4 * hh; const long o0 = row * DM + c0;
      float sq = 0.f;
#pragma unroll
      for (int j = 0; j < 2; ++j) {
        f32x4 bv[4];
        if (basef) {
#pragma unroll
          for (int a = 0; a < 4; ++a) bv[a] = *(const f32x4*)(basef + o0 + j * 32 + 8 * a);
        } else {
#pragma unroll
          for (int a = 0; a < 4; ++a) { const u32x2 w = *(const u32x2*)(xb + kbo(NTOK, row, c0 + j * 32 + 8 * a));
            bv[a] = (f32x4){__uint_as_float(w.x << 16), __uint_as_float(w.x & 0xffff0000u), __uint_as_float(w.y << 16), __uint_as_float(w.y & 0xffff0000u)}; }
        }
#pragma unroll
        for (int a = 0; a < 4; ++a) { u32x2 w; w.x = cvtpk(bv[a][0] + acc[i][j][4 * a], bv[a][1] + acc[i][j][4 * a + 1]); w.y = cvtpk(bv[a][2] + acc[i][j][4 * a + 2], bv[a][3] + acc[i][j][4 * a + 3]);
          *(u32x2*)(xb + kbo(NTOK, row, c0 + j * 32 + 8 * a)) = w;
          const float v0 = __uint_as_float(w.x << 16), v1 = __uint_as_float(w.x & 0xffff0000u), v2 = __uint_as_float(w.y << 16), v3 = __uint_as_float(w.y & 0xffff0000u);
          sq += (v0 * v0 + v1 * v1) + (v2 * v2 + v3 * v3); }
      }
      sq += __shfl_xor(sq, 32);
      if (hh == 0) ssq[row * 16 + (col0 >> 6) + wn] = sq;
      __builtin_amdgcn_sched_barrier(0);
    }
  } };
struct EpiMoeUp { bf16_t* he; long herow0; int hcol0; LAS const float* wts; LAS const float* rsd;
  __device__ __forceinline__ void operator()(f32x16 (&acc)[4][2], int wm, int wn, int lane) const {
    const int l31 = lane & 31, hh = lane >> 5;
#pragma unroll
    for (int i = 0; i < 4; ++i) {
      const int rl = wm * 128 + i * 32 + l31; const float wt = wts[rl]; const float rs = rsd[rl];
      const long hrow = herow0 + rl; const int hc0 = hcol0 + wn * 32 + 4 * hh;
#pragma unroll
      for (int a = 0; a < 4; ++a) {
        float v[4];
#pragma unroll
        for (int e = 0; e < 4; ++e) { const float gte = acc[i][0][4 * a + e] * rs, up = acc[i][1][4 * a + e] * rs; v[e] = gte * sigmoidf_(gte) * up * wt; }
        u32x2 w; w.x = cvtpk(v[0], v[1]); w.y = cvtpk(v[2], v[3]); *(u32x2*)(he + kbo(HE_ROWS, hrow, hc0 + 8 * a)) = w;
      }
      __builtin_amdgcn_sched_barrier(0);
    }
  } };
struct EpiMoeDown { bf16_t* xb; float* ssq; int col0; LAS const int* toks;
  __device__ __forceinline__ void operator()(f32x16 (&acc)[4][2], int wm, int wn, int lane) const {
    const int l31 = lane & 31, hh = lane >> 5;
#pragma unroll
    for (int i = 0; i < 4; ++i) {
      const int tok = toks[wm * 128 + i * 32 + l31];
      const long trow = tok < 0 ? 0 : tok; const int c0 = col0 + wn * 64 + 4 * hh;
      float sq = 0.f;
#pragma unroll
      for (int j = 0; j < 2; ++j) {
        u32x2 bw[4];
#pragma unroll
        for (int a = 0; a < 4; ++a) bw[a] = *(const u32x2*)(xb + kbo(NTOK, trow, c0 + j * 32 + 8 * a));
#pragma unroll
        for (int a = 0; a < 4; ++a) {
          u32x2 w; w.x = cvtpk(__uint_as_float(bw[a].x << 16) + acc[i][j][4 * a], __uint_as_float(bw[a].x & 0xffff0000u) + acc[i][j][4 * a + 1]);
          w.y = cvtpk(__uint_as_float(bw[a].y << 16) + acc[i][j][4 * a + 2], __uint_as_float(bw[a].y & 0xffff0000u) + acc[i][j][4 * a + 3]);
          if (tok >= 0) *(u32x2*)(xb + kbo(NTOK, trow, c0 + j * 32 + 8 * a)) = w;
          const float v0 = __uint_as_float(w.x << 16), v1 = __uint_as_float(w.x & 0xffff0000u), v2 = __uint_as_float(w.y << 16), v3 = __uint_as_float(w.y & 0xffff0000u);
          sq += (v0 * v0 + v1 * v1) + (v2 * v2 + v3 * v3); }
      }
      sq += __shfl_xor(sq, 32);
      if (hh == 0 && tok >= 0) ssq[(long)tok * 16 + (col0 >> 6) + wn] = sq;
      __builtin_amdgcn_sched_barrier(0);
    }
  } };
struct EpiRouterPart { float* part; int row0;
  __device__ __forceinline__ void operator()(f32x16 (&acc)[4][2], int wm, int wn, int lane) const {
    const int l31 = lane & 31, hh = lane >> 5;
    if (wn != 0) return;
#pragma unroll
    for (int i = 0; i < 4; ++i) {
      float* rp = part + (long)(row0 + wm * 128 + i * 32 + l31) * 32 + 4 * hh;
#pragma unroll
      for (int a = 0; a < 3; ++a) *(f32x4*)(rp + 8 * a) = (f32x4){acc[i][0][4 * a], acc[i][0][4 * a + 1], acc[i][0][4 * a + 2], acc[i][0][4 * a + 3]};
    }
  } };

template <int NKS> __device__ __forceinline__ int kswz(int kc, int row) {
  if (NKS == 4) return kc ^ ((row >> 1) & 7);
  return (kc & 16) | ((kc & 15) ^ (row & 15));
}
__device__ __forceinline__ void qk_tile64(f32x16& p0, f32x16& p1, const bf16x8* qf, LAS const char* Ks, int lane) {
  const int l31 = lane & 31, hh = lane >> 5;
#pragma unroll
  for (int r = 0; r < 16; ++r) { p0[r] = 0.f; p1[r] = 0.f; }
#pragma unroll
  for (int ds = 0; ds < 4; ++ds) {
    const int so = kswz<4>(2 * ds + hh, l31) << 4;
    const bf16x8 k0 = *(LAS const bf16x8*)(Ks + l31 * 128 + so);
    const bf16x8 k1 = *(LAS const bf16x8*)(Ks + (32 + l31) * 128 + so);
    p0 = __builtin_amdgcn_mfma_f32_32x32x16_bf16(k0, qf[ds], p0, 0, 0, 0);
    p1 = __builtin_amdgcn_mfma_f32_32x32x16_bf16(k1, qf[ds], p1, 0, 0, 0);
  }
}
__device__ __forceinline__ void qk_tile256(f32x16& p0, f32x16& p1, const bf16_t* qg, LAS const char* Ks, int lane) {
  const int l31 = lane & 31, hh = lane >> 5;
#pragma unroll
  for (int r = 0; r < 16; ++r) { p0[r] = 0.f; p1[r] = 0.f; }
  bf16x8 qa[4], qn[4];
#pragma unroll
  for (int i = 0; i < 4; ++i) qa[i] = *(const bf16x8*)(qg + i * 16);
#pragma unroll 1
  for (int g4 = 0; g4 < 16; g4 += 4) {
    if (g4 + 4 < 16) {
#pragma unroll
      for (int i = 0; i < 4; ++i) qn[i] = *(const bf16x8*)(qg + (g4 + 4 + i) * 16);
    }
#pragma unroll
    for (int i = 0; i < 4; ++i) {
      const int so = kswz<16>(2 * (g4 + i) + hh, l31) << 4;
      const bf16x8 k0 = *(LAS const bf16x8*)(Ks + l31 * 512 + so);
      const bf16x8 k1 = *(LAS const bf16x8*)(Ks + (32 + l31) * 512 + so);
      p0 = __builtin_amdgcn_mfma_f32_32x32x16_bf16(k0, qa[i], p0, 0, 0, 0);
      p1 = __builtin_amdgcn_mfma_f32_32x32x16_bf16(k1, qa[i], p1, 0, 0, 0);
    }
#pragma unroll
    for (int i = 0; i < 4; ++i) qa[i] = qn[i];
  }
}
template <int NDT>
__device__ __forceinline__ void softmax_tile(f32x16& p0, f32x16& p1, float& m, float& l, f32x16* O, bf16x8* pb) {
  float mx = fmaxf(p0[0], p1[0]);
#pragma unroll
  for (int r = 1; r < 16; ++r) mx = fmaxf(mx, fmaxf(p0[r], p1[r]));
  mx = fmaxf(mx, __shfl_xor(mx, 32));
  if (__builtin_amdgcn_ballot_w64(mx > m) != 0ull) {
    const float mn = fmaxf(m, mx);
    const float mu = (mn == -INFINITY) ? 0.f : mn;
    const float alpha = fexp2(m - mu);
    l *= alpha; m = mn;
#pragma unroll
    for (int dt = 0; dt < NDT; ++dt)
#pragma unroll
      for (int r = 0; r < 16; ++r) O[dt][r] *= alpha;
  }
  const float mu = (m == -INFINITY) ? 0.f : m;
  float rs = 0.f;
#pragma unroll
  for (int r = 0; r < 16; ++r) { p0[r] = fexp2(p0[r] - mu); rs += p0[r]; }
#pragma unroll
  for (int r = 0; r < 16; ++r) { p1[r] = fexp2(p1[r] - mu); rs += p1[r]; }
  l += rs;
  u32x4 w;
  w = (u32x4){cvtpk(p0[0], p0[1]), cvtpk(p0[2], p0[3]), cvtpk(p0[4], p0[5]), cvtpk(p0[6], p0[7])}; pb[0] = __builtin_bit_cast(bf16x8, w);
  w = (u32x4){cvtpk(p0[8], p0[9]), cvtpk(p0[10], p0[11]), cvtpk(p0[12], p0[13]), cvtpk(p0[14], p0[15])}; pb[1] = __builtin_bit_cast(bf16x8, w);
  w = (u32x4){cvtpk(p1[0], p1[1]), cvtpk(p1[2], p1[3]), cvtpk(p1[4], p1[5]), cvtpk(p1[6], p1[7])}; pb[2] = __builtin_bit_cast(bf16x8, w);
  w = (u32x4){cvtpk(p1[8], p1[9]), cvtpk(p1[10], p1[11]), cvtpk(p1[12], p1[13]), cvtpk(p1[14], p1[15])}; pb[3] = __builtin_bit_cast(bf16x8, w);
}
template <int NDT>
__device__ __forceinline__ void pv_tile(f32x16* O, const bf16x8* pb, LAS const char* Vs, int lane) {
  const int hh = lane >> 5;
  const int vlane = (4 * hh + ((lane & 15) >> 2)) * 64 + (((lane >> 4) & 1) * 16 + (lane & 3) * 4) * 2;
#pragma unroll
  for (int dt = 0; dt < NDT; dt += 2) {
    s16x4 lo[2][4], hi[2][4];
#pragma unroll
    for (int d2 = 0; d2 < 2; ++d2)
#pragma unroll
      for (int ks = 0; ks < 4; ++ks) {
        LAS const char* vp = Vs + (dt + d2) * 4096 + ks * 16 * 64 + vlane;
        lo[d2][ks] = __builtin_amdgcn_ds_read_tr16_b64_v4i16((LAS s16x4*)vp);
        hi[d2][ks] = __builtin_amdgcn_ds_read_tr16_b64_v4i16((LAS s16x4*)(vp + 8 * 64));
      }
    __builtin_amdgcn_sched_barrier(0);
#pragma unroll
    for (int ks = 0; ks < 4; ++ks)
#pragma unroll
      for (int d2 = 0; d2 < 2; ++d2) {
        const bf16x8 vf = (bf16x8){lo[d2][ks][0], lo[d2][ks][1], lo[d2][ks][2], lo[d2][ks][3], hi[d2][ks][0], hi[d2][ks][1], hi[d2][ks][2], hi[d2][ks][3]};
        O[dt + d2] = __builtin_amdgcn_mfma_f32_32x32x16_bf16(vf, pb[ks], O[dt + d2], 0, 0, 0);
      }
  }
}
struct TLRange { int n, kv_last; __device__ __forceinline__ int count() const { return n; } __device__ __forceinline__ int kv0(int i) const { return kv_last - 64 * i; } };
struct TLList { int n; LAS const int* lst; __device__ __forceinline__ int count() const { return n; } __device__ __forceinline__ int kv0(int i) const { return lst[i]; } };

struct SMFox { float cq; const float* ck; int tq; int tqmax;
  static constexpr bool EXTRA = true;
  __device__ __forceinline__ bool active(int kv0) const { return kv0 <= tqmax; }
  __device__ __forceinline__ bool full(int kv0) const { return kv0 + 63 <= tqmax - 31; }
  __device__ __forceinline__ const float* xsrc(int kv0, int lane) const { return ck + kv0 + lane; }
  template <bool MASK> __device__ __forceinline__ void apply(f32x16& p0, f32x16& p1, int kv0, int lane, LAS const char* xs_) const {
    const int hh = lane >> 5; const float C = 0.125f * LOG2E;
    const int db = tq - kv0 - 4 * hh;
    LAS const float* cp = (LAS const float*)xs_ + 4 * hh;
#pragma unroll
    for (int a = 0; a < 4; ++a) {
      const f32x4 c0 = *(LAS const f32x4*)(cp + 8 * a);
      const f32x4 c1 = *(LAS const f32x4*)(cp + 32 + 8 * a);
#pragma unroll
      for (int e = 0; e < 4; ++e) {
        const int c = 8 * a + e;
        const float s0 = __builtin_fmaf(p0[4 * a + e], C, cq - c0[e]), s1 = __builtin_fmaf(p1[4 * a + e], C, cq - c1[e]);
        p0[4 * a + e] = (!MASK || db >= c) ? s0 : -INFINITY;
        p1[4 * a + e] = (!MASK || db >= c + 32) ? s1 : -INFINITY;
      }
    }
  } };
struct SMWin { int tq; float slope2; int tqmax;
  static constexpr bool EXTRA = false;
  __device__ __forceinline__ const float* xsrc(int, int) const { return nullptr; }
  __device__ __forceinline__ bool active(int kv0) const { return kv0 <= tqmax && kv0 + 63 + 512 > tqmax - 31; }
  __device__ __forceinline__ bool full(int kv0) const { return kv0 + 63 <= tqmax - 31 && tqmax - kv0 < 512; }
  template <bool MASK> __device__ __forceinline__ void apply(f32x16& p0, f32x16& p1, int kv0, int lane, LAS const char*) const {
    const int hh = lane >> 5; const float C = 0.125f * LOG2E;
    const int db = tq - kv0 - 4 * hh; const float sb = -slope2 * (float)db;
#pragma unroll
    for (int r = 0; r < 16; ++r) {
      const int c = (r & 3) + 8 * (r >> 2);
      const int d0 = db - c, d1 = db - c - 32;
      const float s0 = __builtin_fmaf(p0[r], C, __builtin_fmaf(slope2, (float)c, sb)), s1 = __builtin_fmaf(p1[r], C, __builtin_fmaf(slope2, (float)(c + 32), sb));
      p0[r] = (!MASK || (d0 >= 0 && d0 < 512)) ? s0 : -INFINITY;
      p1[r] = (!MASK || (d1 >= 0 && d1 < 512)) ? s1 : -INFINITY;
    }
  } };
struct SMSel { int tq; float slope2; unsigned mlo, mhi; int tqmax;
  static constexpr bool EXTRA = false;
  __device__ __forceinline__ const float* xsrc(int, int) const { return nullptr; }
  __device__ __forceinline__ bool selbit(int kv0) const { const int j = kv0 >> 6; return ((j < 32 ? (mlo >> j) : (mhi >> (j - 32))) & 1u) != 0u; }
  __device__ __forceinline__ bool active(int kv0) const { return kv0 <= tqmax && __builtin_amdgcn_ballot_w64(selbit(kv0)) != 0ull; }
  __device__ __forceinline__ bool full(int kv0) const { return kv0 + 63 <= tqmax - 31 && __builtin_amdgcn_ballot_w64(!selbit(kv0)) == 0ull; }
  template <bool MASK> __device__ __forceinline__ void apply(f32x16& p0, f32x16& p1, int kv0, int lane, LAS const char*) const {
    const int hh = lane >> 5; const float C = 0.125f * LOG2E;
    const int dbr = tq - kv0 - 4 * hh;
    const int db = (!MASK || selbit(kv0)) ? dbr : -1; const float sb = -slope2 * (float)dbr;
#pragma unroll
    for (int r = 0; r < 16; ++r) {
      const int c = (r & 3) + 8 * (r >> 2);
      const float s0 = __builtin_fmaf(p0[r], C, __builtin_fmaf(slope2, (float)c, sb)), s1 = __builtin_fmaf(p1[r], C, __builtin_fmaf(slope2, (float)(c + 32), sb));
      p0[r] = (!MASK || db >= c) ? s0 : -INFINITY;
      p1[r] = (!MASK || db >= c + 32) ? s1 : -INFINITY;
    }
  } };
struct SMCmp { int tq; float slope2; int tqmax;
  static constexpr bool EXTRA = false;
  __device__ __forceinline__ const float* xsrc(int, int) const { return nullptr; }
  __device__ __forceinline__ bool active(int kv0) const { return 16 * kv0 + 31 <= tqmax; }
  __device__ __forceinline__ bool full(int kv0) const { return 16 * (kv0 + 63) + 31 <= tqmax - 31; }
  template <bool MASK> __device__ __forceinline__ void apply(f32x16& p0, f32x16& p1, int kv0, int lane, LAS const char*) const {
    const int hh = lane >> 5; const float C = 0.125f * LOG2E;
    const int db = tq - 31 - 16 * kv0 - 64 * hh; const float sb = -slope2 * (float)db;
#pragma unroll
    for (int r = 0; r < 16; ++r) {
      const int c = 16 * ((r & 3) + 8 * (r >> 2));
      const float s0 = __builtin_fmaf(p0[r], C, __builtin_fmaf(slope2, (float)c, sb)), s1 = __builtin_fmaf(p1[r], C, __builtin_fmaf(slope2, (float)(c + 512), sb));
      p0[r] = (!MASK || db >= c) ? s0 : -INFINITY;
      p1[r] = (!MASK || db >= c + 512) ? s1 : -INFINITY;
    }
  } };

#define FL_STAGE 16896
#define g_flx (((LAS const int*)((LAS const char*)lds_dyn + LDS_XS))[500] != 0)
template <int N> __device__ __forceinline__ void fl_waitbar() {
  if (N == 0) asm volatile("s_waitcnt vmcnt(0)\n\ts_barrier" ::: "memory");
  else if (N == 2) asm volatile("s_waitcnt vmcnt(2)\n\ts_barrier" ::: "memory");
  else if (N == 3) asm volatile("s_waitcnt vmcnt(3)\n\ts_barrier" ::: "memory");
  else if (N == 4) asm volatile("s_waitcnt vmcnt(4)\n\ts_barrier" ::: "memory");
  else asm volatile("s_waitcnt vmcnt(6)\n\ts_barrier" ::: "memory");
}
template <int NSTG, class SM, class TL>
__device__ __forceinline__ void flash_run64(LAS char* sm, const bf16x8* qf, const bf16_t* Kb, long ldk, const bf16_t* Vb, long ldv,
                                            const TL& tl, const SM& smod, float& m, float& l, f32x16* O) {
  const int n = tl.count();
  if (n <= 0) return;
  constexpr int DPT = SM::EXTRA ? 3 : 2;
  const int tid = otid512(), lane = tid & 63, wid = __builtin_amdgcn_readfirstlane(tid >> 6);
  const int krow = tid >> 3;
  const bf16_t* ksrc = Kb + (long)krow * ldk + (((tid & 7) ^ ((krow >> 1) & 7)) * 8);
  const bf16_t* vsrc = Vb + (long)((tid & 255) >> 2) * ldv + (((tid >> 8) * 4 + (tid & 3)) * 8);
  LAS char* kd0 = sm + wid * 1024;
#define FL_ISSUE(i_) do { if ((FLEXP & 16) && g_flx) break; const int i__ = (i_); const int kv__ = tl.kv0(i__); LAS char* d__ = kd0 + (i__ % NSTG) * FL_STAGE; \
    __builtin_amdgcn_global_load_lds((const unsigned*)(ksrc + (long)kv__ * ldk), (LAS unsigned*)d__, 16, 0, 0); \
    __builtin_amdgcn_global_load_lds((const unsigned*)(vsrc + (long)kv__ * ldv), (LAS unsigned*)(d__ + 8192), 16, 0, 0); \
    if (SM::EXTRA) __builtin_amdgcn_global_load_lds((const unsigned*)(smod.xsrc(kv__, lane)), (LAS unsigned*)(sm + (i__ % NSTG) * FL_STAGE + 16384), 4, 0, 0); } while (0)
  __syncthreads();
#pragma unroll
  for (int i = 0; i < NSTG - 1; ++i) if (i < n) FL_ISSUE(i);
  { const int later = min(n - 1, NSTG - 2);
    if (later >= 2) fl_waitbar<2 * DPT>(); else if (later == 1) fl_waitbar<DPT>(); else fl_waitbar<0>(); }
  if (NSTG - 1 < n) FL_ISSUE(NSTG - 1);
  f32x16 pc0, pc1, pn0, pn1;
  int kv_cur = tl.kv0(0);
  bool act_cur = smod.active(kv_cur), act_next = false;
  if (act_cur) qk_tile64(pc0, pc1, qf, sm, lane);
  int st_cur = 0;
  for (int it = 0; it < n; ++it) {
    const int st_next = st_cur == NSTG - 1 ? 0 : st_cur + 1;
    int kv_next = 0;
    if (it + 1 < n) {
      kv_next = tl.kv0(it + 1);
      const int later = min(n - 1, it + NSTG - 2) - (it + 1);
      if (NSTG >= 4 && later >= 1) fl_waitbar<DPT>(); else fl_waitbar<0>();
      if (it + NSTG - 1 < n && it > 0) FL_ISSUE(it + NSTG - 1);
    }
    act_next = false;
    if (it + 1 < n) { act_next = smod.active(kv_next); if (act_next) { if ((FLEXP & 8) && g_flx) { pn0 = pc0; pn1 = pc1; } else qk_tile64(pn0, pn1, qf, sm + st_next * FL_STAGE, lane); } }
    if (act_cur) {
      LAS const char* sb_ = sm + st_cur * FL_STAGE;
      if (!((FLEXP & 4) && g_flx)) { if (smod.full(kv_cur)) smod.template apply<false>(pc0, pc1, kv_cur, lane, sb_ + 16384); else smod.template apply<true>(pc0, pc1, kv_cur, lane, sb_ + 16384); }
      bf16x8 pb[4];
      if ((FLEXP & 1) && g_flx) { u32x4 w_ = {cvtpk(pc0[0], pc0[1]), cvtpk(pc0[2], pc0[3]), cvtpk(pc1[0], pc1[1]), cvtpk(pc1[2], pc1[3])}; pb[0] = pb[1] = pb[2] = pb[3] = __builtin_bit_cast(bf16x8, w_); }
      else softmax_tile<2>(pc0, pc1, m, l, O, pb);
      if ((FLEXP & 2) && g_flx) { const u32x4 w0 = __builtin_bit_cast(u32x4, pb[0]), w1 = __builtin_bit_cast(u32x4, pb[3]); O[0][0] += __uint_as_float((w0.x ^ w1.y) & 0x3fffffffu); }
      else pv_tile<2>(O, pb, sb_ + 8192, lane);
    }
    pc0 = pn0; pc1 = pn1; act_cur = act_next; kv_cur = kv_next; st_cur = st_next;
  }
#undef FL_ISSUE
}

__device__ __forceinline__ void fox_unit(const Params& p, int b, int h, int qb, LAS char* sm) {
  const int tid = otid512(), lane = tid & 63, w = tid >> 6, l31 = lane & 31, hh = lane >> 5;
  const int tq = qb * 256 + w * 32 + l31; const long tok = (long)b * SEQ + tq;
  const bf16_t* Pb = p.P + (long)b * SEQ * PW;
  bf16x8 qf[4];
#pragma unroll
  for (int ds = 0; ds < 4; ++ds) qf[ds] = *(const bf16x8*)(p.P + tok * PW + h * 64 + ds * 16 + hh * 8);
  const float* ck = p.cum + (long)(b * 6 + h) * SEQ;
  SMFox smod; smod.cq = ck[tq]; smod.ck = ck; smod.tq = tq; smod.tqmax = qb * 256 + w * 32 + 31;
  float m = -INFINITY, l = 0.f; f32x16 O[2];
#pragma unroll
  for (int r = 0; r < 16; ++r) { O[0][r] = 0.f; O[1][r] = 0.f; }
  TLRange tl; tl.n = 4 * qb + 4; tl.kv_last = qb * 256 + 192;
  flash_run64<4>(sm, qf, Pb + 384 + h * 64, PW, Pb + 768 + h * 64, PW, tl, smod, m, l, O);
  const float lt = l + __shfl_xor(l, 32); const float inv = lt > 0.f ? 1.0f / lt : 0.f;
#pragma unroll
  for (int dt = 0; dt < 2; ++dt)
#pragma unroll
    for (int a = 0; a < 4; ++a) { u32x2 wv; wv.x = cvtpk(O[dt][4 * a] * inv, O[dt][4 * a + 1] * inv); wv.y = cvtpk(O[dt][4 * a + 2] * inv, O[dt][4 * a + 3] * inv);
      *(u32x2*)(p.cat + kbo(NTOK, tok, h * 64 + dt * 32 + 8 * a + 4 * hh)) = wv; }
}

__device__ __forceinline__ void xattn_unit(const Params& p, int layer, int b, int hd, int qb, int dh, LAS char* sm) {
  const int tid = otid512(), lane = tid & 63, w = tid >> 6, l31 = lane & 31, hh = lane >> 5;
  const int tq = qb * 256 + w * 32 + l31; const long tok = (long)b * SEQ + tq;
  const bf16_t* qg = p.qx + tok * DM + hd * 256 + hh * 8;
  const float C = 0.0625f * LOG2E;
  float m = -INFINITY, l = 0.f; f32x16 O[4];
#pragma unroll
  for (int dt = 0; dt < 4; ++dt)
#pragma unroll
    for (int r = 0; r < 16; ++r) O[dt][r] = 0.f;
  const bf16_t* Kb = p.Kmem + ((long)layer * 1024 + b * 256) * DM + hd * 256;
  const bf16_t* Vb = p.Vmem + ((long)layer * 1024 + b * 256) * DM + hd * 256 + dh * 128;
  u32x4 kr[4], vr[2];
#define XA_LOAD(kv_) do { const int kv__ = (kv_); _Pragma("unroll") for (int i = 0; i < 4; ++i) { const int pp = tid + 512 * i; kr[i] = *(const u32x4*)(Kb + (long)(kv__ + (pp >> 5)) * DM + (pp & 31) * 8); } \
    _Pragma("unroll") for (int i = 0; i < 2; ++i) { const int pp = tid + 512 * i; vr[i] = *(const u32x4*)(Vb + (long)(kv__ + ((pp & 255) >> 2)) * DM + ((pp >> 8) * 4 + (pp & 3)) * 8); } } while (0)
#define XA_STORE(st_) do { LAS char* b__ = sm + (st_) * 49152; _Pragma("unroll") for (int i = 0; i < 4; ++i) { const int pp = tid + 512 * i; const int row = pp >> 5, kc = pp & 31; *(LAS u32x4*)(b__ + row * 512 + (kswz<16>(kc, row) << 4)) = kr[i]; } \
    _Pragma("unroll") for (int i = 0; i < 2; ++i) { const int pp = tid + 512 * i; *(LAS u32x4*)(b__ + 32768 + pp * 16) = vr[i]; } } while (0)
  __syncthreads();
  XA_LOAD(0); XA_STORE(0);
  __syncthreads();
#pragma unroll 1
  for (int it = 0; it < 4; ++it) {
    if (it + 1 < 4) XA_LOAD(64 * (it + 1));
    LAS const char* sb_ = sm + (it & 1) * 49152;
    f32x16 p0, p1;
    qk_tile256(p0, p1, qg, sb_, lane);
#pragma unroll
    for (int r = 0; r < 16; ++r) { p0[r] *= C; p1[r] *= C; }
    bf16x8 pb[4];
    softmax_tile<4>(p0, p1, m, l, O, pb);
    pv_tile<4>(O, pb, sb_ + 32768, lane);
    if (it + 1 < 4) XA_STORE((it + 1) & 1);
    __syncthreads();
  }
#undef XA_LOAD
#undef XA_STORE
  const float lt = l + __shfl_xor(l, 32); const float inv = 1.0f / lt;
#pragma unroll
  for (int dt = 0; dt < 4; ++dt)
#pragma unroll
    for (int a = 0; a < 4; ++a) { u32x2 wv; wv.x = cvtpk(O[dt][4 * a] * inv, O[dt][4 * a + 1] * inv); wv.y = cvtpk(O[dt][4 * a + 2] * inv, O[dt][4 * a + 3] * inv);
      *(u32x2*)(p.ox + kbo(NTOK, tok, hd * 256 + dh * 128 + dt * 32 + 8 * a + 4 * hh)) = wv; }
}

#define NSA_SC 51200
#define NSA_UNI 122880
#define NSA_TL 122896
__device__ __forceinline__ void nsa_stageA(const Params& p, int layer, int b, int g, int qb, LAS char* sm) {
  const int tid = otid512(), lane = tid & 63, w = tid >> 6, l31 = lane & 31, hh = lane >> 5;
  const int tq = qb * 256 + w * 32 + l31; const long tok = (long)b * SEQ + tq;
  LAS float* sc = (LAS float*)(sm + NSA_SC);
  const bf16_t* kcb = p.kvc + (long)(0 * 8 + b * 2 + g) * 256 * 64;
  const bf16_t* vcb = p.kvc + (long)(1 * 8 + b * 2 + g) * 256 * 64;
  const int ntc = min(4, (16 * qb + 14) / 64 + 1);
  LAS float* myrow = sc + (w * 32 + l31) * 68;
  __syncthreads();
#pragma unroll
  for (int i = 0; i < 32; ++i) myrow[2 * i + hh] = 0.f;
  const float* glp = p.fgl + tok * 32 + 6;
  const float* gbp = p.gate_b + layer * 18;
#pragma unroll 1
  for (int r3 = 0; r3 < 3; ++r3) {
    const int head = 3 * g + r3;
    const float slope2 = exp2f(-8.0f * (float)(head + 1) / 6.0f) * LOG2E;
    bf16x8 qf[4];
#pragma unroll
    for (int ds = 0; ds < 4; ++ds) qf[ds] = *(const bf16x8*)(p.P + tok * PW + 1408 + head * 64 + ds * 16 + hh * 8);
    SMCmp smod; smod.tq = tq; smod.slope2 = slope2; smod.tqmax = qb * 256 + w * 32 + 31;
    float m = -INFINITY, l = 0.f; f32x16 O[2];
#pragma unroll
    for (int r = 0; r < 16; ++r) { O[0][r] = 0.f; O[1][r] = 0.f; }
    TLRange tl; tl.n = ntc; tl.kv_last = 64 * (ntc - 1);
    flash_run64<3>(sm, qf, kcb, 64, vcb, 64, tl, smod, m, l, O);
    const float lt = l + __shfl_xor(l, 32); const float inv = lt > 0.f ? 1.0f / lt : 0.f;
    const float gc = sigmoidf_(glp[head * 3 + 0] + gbp[head * 3 + 0]) * inv;
    float* ob = p.onsa + tok * 384 + head * 64;
#pragma unroll
    for (int dt = 0; dt < 2; ++dt)
#pragma unroll
      for (int a = 0; a < 4; ++a) *(f32x4*)(ob + dt * 32 + 8 * a + 4 * hh) = (f32x4){O[dt][4 * a] * gc, O[dt][4 * a + 1] * gc, O[dt][4 * a + 2] * gc, O[dt][4 * a + 3] * gc};
    const float mu = (m == -INFINITY) ? 0.f : m;
    float e_prev = 0.f;
#pragma unroll
    for (int it = 0; it < 4; ++it) {
      if (it < ntc) {
        __syncthreads();
        { const int row = tid >> 3, kc = tid & 7;
          const u32x4 k0 = *(const u32x4*)(kcb + (long)(64 * it + row) * 64 + kc * 8);
          *(LAS u32x4*)(sm + row * 128 + (kswz<4>(kc, row) << 4)) = k0; }
        __syncthreads();
        f32x16 p0, p1;
        qk_tile64(p0, p1, qf, sm, lane);
        smod.template apply<true>(p0, p1, 64 * it, lane, sm);
#pragma unroll
        for (int r = 0; r < 16; ++r) { p0[r] = fexp2(p0[r] - mu) * inv; p1[r] = fexp2(p1[r] - mu) * inv; }
#pragma unroll
        for (int pi = 0; pi < 2; ++pi)
#pragma unroll
          for (int a = 0; a < 4; ++a) {
            const float q0 = pi ? p1[4 * a] : p0[4 * a], q1 = pi ? p1[4 * a + 1] : p0[4 * a + 1], q2 = pi ? p1[4 * a + 2] : p0[4 * a + 2], q3 = pi ? p1[4 * a + 3] : p0[4 * a + 3];
            const float ex = __shfl_xor(q3, 32);
            myrow[2 * (8 * it + 4 * pi + a) + hh] += (q0 + q1) + (q2 + q3) + (hh ? ex : e_prev);
            e_prev = ex;
          }
      }
    }
  }
  __syncthreads();
  {
    const int cur = tq >> 6;
#pragma unroll
    for (int mi = 0; mi < 32; ++mi) {
      const int j = 2 * mi + hh;
      const bool forced = (j == 0) || (j == cur) || (j == cur - 1);
      const float iv = myrow[j];
      myrow[j] = forced ? 1.0e4f : (j <= cur ? iv : -1.0f);
    }
  }
  __syncthreads();
  {
    float v[32];
#pragma unroll
    for (int i = 0; i < 8; ++i) { const f32x4 t = *(LAS const f32x4*)(myrow + 32 * hh + 4 * i); v[4 * i] = t[0]; v[4 * i + 1] = t[1]; v[4 * i + 2] = t[2]; v[4 * i + 3] = t[3]; }
    unsigned mym = 0u;
#pragma unroll 1
    for (int itk = 0; itk < 16; ++itk) {
      float best = v[0]; int bi = 0;
#pragma unroll
      for (int i = 1; i < 32; ++i) { const bool gt = v[i] > best; best = gt ? v[i] : best; bi = gt ? i : bi; }
      const float ob = __shfl_xor(best, 32);
      const bool mine = hh == 0 ? (best >= ob) : (best > ob);
      if (mine) {
        mym |= 1u << bi;
#pragma unroll
        for (int i = 0; i < 32; ++i) v[i] = (i == bi) ? -INFINITY : v[i];
      }
    }
    const unsigned oth = __shfl_xor(mym, 32);
    if (hh == 0) *(u32x2*)(p.selm + (tok * 2 + g) * 2) = (u32x2){mym, oth};
  }
  __syncthreads();
}

__device__ __forceinline__ void nsa_stageB(const Params& p, int layer, int b, int head, int qb, LAS char* sm) {
  const int tid = otid512(), lane = tid & 63, w = tid >> 6, l31 = lane & 31, hh = lane >> 5;
  const int g = head / 3;
  const int tq = qb * 256 + w * 32 + l31; const long tok = (long)b * SEQ + tq;
  const bf16_t* Pb = p.P + (long)b * SEQ * PW;
  LAS unsigned* uni = (LAS unsigned*)(sm + NSA_UNI);
  LAS int* tll = (LAS int*)(sm + NSA_TL);
  const float* glp = p.fgl + tok * 32 + 6;
  const float* gbp = p.gate_b + layer * 18;
  const u32x2 mk = *(const u32x2*)(p.selm + (tok * 2 + g) * 2);
  const unsigned mlo = mk.x, mhi = mk.y;
  __syncthreads();
  if (tid < 2) uni[tid] = 0u;
  __syncthreads();
  if (hh == 0) { __hip_atomic_fetch_or(uni, mlo, __ATOMIC_RELAXED, __HIP_MEMORY_SCOPE_WORKGROUP); __hip_atomic_fetch_or(uni + 1, mhi, __ATOMIC_RELAXED, __HIP_MEMORY_SCOPE_WORKGROUP); }
  __syncthreads();
  if (tid == 0) {
    unsigned long long u = ((unsigned long long)uni[1] << 32) | (unsigned long long)uni[0];
    const int jmax = (qb * 256 + 255) >> 6;
    int n = 0;
    for (int j = jmax; j >= 0; --j) if ((u >> j) & 1ull) tll[1 + n++] = 64 * j;
    tll[0] = n;
  }
  __syncthreads();
  const int nsel = tll[0];
  const int tqmax = qb * 256 + w * 32 + 31;
  const float slope2 = exp2f(-8.0f * (float)(head + 1) / 6.0f) * LOG2E;
  bf16x8 qf[4];
#pragma unroll
  for (int ds = 0; ds < 4; ++ds) qf[ds] = *(const bf16x8*)(p.P + tok * PW + 1408 + head * 64 + ds * 16 + hh * 8);
  f32x16 acc[2];
  {
    SMSel smod; smod.tq = tq; smod.slope2 = slope2; smod.mlo = mlo; smod.mhi = mhi; smod.tqmax = tqmax;
    float m = -INFINITY, l = 0.f; f32x16 O[2];
#pragma unroll
    for (int r = 0; r < 16; ++r) { O[0][r] = 0.f; O[1][r] = 0.f; }
    TLList tl; tl.n = nsel; tl.lst = tll + 1;
    flash_run64<4>(sm, qf, Pb + 2048 + g * 64, PW, Pb + 2176 + g * 64, PW, tl, smod, m, l, O);
    const float lt = l + __shfl_xor(l, 32); const float inv = lt > 0.f ? 1.0f / lt : 0.f;
    const float gs = sigmoidf_(glp[head * 3 + 1] + gbp[head * 3 + 1]) * inv;
#pragma unroll
    for (int r = 0; r < 16; ++r) { acc[0][r] = O[0][r] * gs; acc[1][r] = O[1][r] * gs; }
  }
  {
    SMWin smod; smod.tq = tq; smod.slope2 = slope2; smod.tqmax = tqmax;
    float m = -INFINITY, l = 0.f; f32x16 O[2];
#pragma unroll
    for (int r = 0; r < 16; ++r) { O[0][r] = 0.f; O[1][r] = 0.f; }
    const int kvf = max(0, qb * 256 - 512);
    TLRange tl; tl.kv_last = qb * 256 + 192; tl.n = (qb * 256 + 256 - kvf) >> 6;
    flash_run64<4>(sm, qf, Pb + 2304 + g * 64, PW, Pb + 2432 + g * 64, PW, tl, smod, m, l, O);
    const float lt = l + __shfl_xor(l, 32); const float inv = lt > 0.f ? 1.0f / lt : 0.f;
    const float gw = sigmoidf_(glp[head * 3 + 2] + gbp[head * 3 + 2]) * inv;
    const float* ob = p.onsa + tok * 384 + head * 64;
#pragma unroll
    for (int dt = 0; dt < 2; ++dt)
#pragma unroll
      for (int a = 0; a < 4; ++a) {
        const f32x4 oc = *(const f32x4*)(ob + dt * 32 + 8 * a + 4 * hh);
        u32x2 wv; wv.x = cvtpk(O[dt][4 * a] * gw + acc[dt][4 * a] + oc[0], O[dt][4 * a + 1] * gw + acc[dt][4 * a + 1] + oc[1]);
        wv.y = cvtpk(O[dt][4 * a + 2] * gw + acc[dt][4 * a + 2] + oc[2], O[dt][4 * a + 3] * gw + acc[dt][4 * a + 3] + oc[3]);
        *(u32x2*)(p.cat + kbo(NTOK, tok, 640 + head * 64 + dt * 32 + 8 * a + 4 * hh)) = wv;
      }
  }
  __syncthreads();
}

__device__ __forceinline__ void pool_unit(const Params& p, int layer, int b, int tb, int g, LAS char* sm) {
  const int tid = otid();
  LAS float* u = (LAS float*)sm;
  LAS float* W = (LAS float*)(sm + 20480);
  LAS float* pl = (LAS float*)(sm + 36864);
  const int t0 = tb * 64;
  const int wsz = 2 << g;
  TSYNC();
#pragma unroll
  for (int i3 = 0; i3 < 3; ++i3) { const int pi = tid + 256 * i3; if (pi < 79 * 8) { const int rr = pi >> 3, c8 = (pi & 7) * 8; const int t = t0 - 15 + rr;
      u32x4 v = {0u, 0u, 0u, 0u}; if (t >= 0) v = *(const u32x4*)(p.P + ((long)b * SEQ + t) * PW + 1152 + g * 64 + c8);
      *(LAS f32x4*)(u + rr * 64 + c8) = (f32x4){__uint_as_float(v.x << 16), __uint_as_float(v.x & 0xffff0000u), __uint_as_float(v.y << 16), __uint_as_float(v.y & 0xffff0000u)};
      *(LAS f32x4*)(u + rr * 64 + c8 + 4) = (f32x4){__uint_as_float(v.z << 16), __uint_as_float(v.z & 0xffff0000u), __uint_as_float(v.w << 16), __uint_as_float(v.w & 0xffff0000u)}; } }
#pragma unroll
  for (int i4 = 0; i4 < 4; ++i4) { const int i = (tid + 256 * i4) * 4; *(LAS f32x4*)(W + i) = *(const f32x4*)(p.pool_w + ((long)layer * 4 + g) * 4096 + i); }
  TSYNC();
  for (int i = tid; i < 4096; i += 256) { const int tl = i >> 6, c = i & 63; const int t = t0 + tl;
    float s = 0.f; for (int k = 0; k < wsz; ++k) s += u[(tl + 15 - k) * 64 + c];
    const float cnt = (float)min(t + 1, wsz);
    pl[i] = s / cnt - u[(tl + 15) * 64 + c]; }
  TSYNC();
  { const int d = tid & 63, tg = tid >> 6;
    const float scl = p.pool_scale[layer * 256 + g * 64 + d];
    float o[16];
#pragma unroll
    for (int i = 0; i < 16; ++i) o[i] = 0.f;
    for (int c = 0; c < 64; ++c) { const float wv = W[c * 64 + d];
#pragma unroll
      for (int i = 0; i < 16; ++i) o[i] += pl[(tg * 16 + i) * 64 + c] * wv; }
#pragma unroll
    for (int i = 0; i < 16; ++i) p.cat[kbo(NTOK, (long)b * SEQ + t0 + tg * 16 + i, 384 + g * 64 + d)] = f2bf(o[i] * scl); }
}

__device__ __forceinline__ void cum_unit(const Params& p, int layer, int b, int h, LAS char* sm) {
  const int tid = otid();
  LAS float* part = (LAS float*)sm;
  const float bf = p.fox_b[layer * 6 + h];
  float v[16]; float s = 0.f;
#pragma unroll
  for (int i = 0; i < 16; ++i) { const int t = tid * 16 + i; const float z = p.fgl[((long)b * SEQ + t) * 32 + h] + bf;
    const float ls = fminf(z, 0.f) - log1pf(__expf(-fabsf(z))); s += ls; v[i] = s; }
  TSYNC();
  part[tid] = s;
  TSYNC();
  if (tid < 64) {
    const f32x4 q = *(LAS const f32x4*)(part + 4 * tid);
    const float s0 = q[0], s1 = s0 + q[1], s2 = s1 + q[2], s3 = s2 + q[3];
    float inc = s3;
#pragma unroll
    for (int o = 1; o < 64; o <<= 1) { const float t = __shfl_up(inc, o); if (tid >= o) inc += t; }
    const float ex = inc - s3;
    *(LAS f32x4*)(part + 4 * tid) = (f32x4){ex, ex + s0, ex + s1, ex + s2};
  }
  TSYNC();
  const float base = part[tid];
#pragma unroll
  for (int i = 0; i < 16; ++i) p.cum[(long)(b * 6 + h) * SEQ + tid * 16 + i] = (base + v[i]) * LOG2E;
  TSYNC();
}

__device__ __forceinline__ void cmp2_unit(const Params& p, int layer, int kv, int rb, LAS char* sm) {
  const int tid = otid();
  LAS float* hs = (LAS float*)sm;
  const float* bias = p.bias1 + (layer * 2 + kv) * 256;
  const float* part = p.hidp + (long)kv * 2048 * 256;
  TSYNC();
#pragma unroll
  for (int i4 = 0; i4 < 4; ++i4) { const int i = (tid + 256 * i4) * 4; const int r = i >> 8, k = i & 255; const long o = (long)(rb * 16 + r) * 256 + k;
    f32x4 v = *(const f32x4*)(bias + k);
#pragma unroll
    for (int sI = 1; sI < 16; ++sI) v += *(const f32x4*)(bias + sI * 1024 + k);
#pragma unroll
    for (int sI = 0; sI < 8; ++sI) v += *(const f32x4*)(part + o + (long)sI * 4096 * 256);
    *(LAS f32x4*)(hs + i) = (f32x4){gelu_tanh(v[0]), gelu_tanh(v[1]), gelu_tanh(v[2]), gelu_tanh(v[3])}; }
  TSYNC();
  const int n = tid & 63, rg = tid >> 6;
  const float* w2 = (kv ? p.w2v : p.w2k) + (long)layer * 256 * 64 + n;
  float acc[4] = {0.f, 0.f, 0.f, 0.f};
#pragma unroll 1
  for (int k0 = 0; k0 < 256; k0 += 16) {
    float wv[16];
#pragma unroll
    for (int q = 0; q < 16; ++q) wv[q] = w2[(k0 + q) * 64];
#pragma unroll
    for (int q = 0; q < 16; q += 4)
#pragma unroll
      for (int j = 0; j < 4; ++j) { const f32x4 h4 = *(LAS const f32x4*)(hs + (rg * 4 + j) * 256 + k0 + q);
        acc[j] += h4[0] * wv[q] + h4[1] * wv[q + 1] + h4[2] * wv[q + 2] + h4[3] * wv[q + 3]; }
  }
#pragma unroll
  for (int j = 0; j < 4; ++j) { const int row = rb * 16 + rg * 4 + j; p.kvc[((long)kv * 2048 + row) * 64 + n] = ((row & 255) == 255) ? (bf16_t)0 : f2bf(acc[j]); }
}

#define GSYNC() xcd_barrier(xb)
#define GSYNCK(k) do { xcd_barrier(xb); if (SPINMASK != 0ull && bid == 0 && tid5 == 0) { ((unsigned long long*)(xb.bar + 4096))[(k)] = __builtin_amdgcn_s_memrealtime(); } } while (0)
#ifndef SKIPMASK
#define SKIPMASK 0
#endif
#define PH(n) if (!((SKIPMASK >> (n)) & 1))
#define REP(n) for (int rep_ = 0; rep_ < ((((DUPMASK) >> (n)) & 1) ? 2 : 1); ++rep_)
__global__ void __launch_bounds__(512, 2) fwd_kernel(Params p) {
  LAS char* smfull = (LAS char*)lds_dyn;
  const int tid5 = otid512();
  const int tid = otid();
  const int team = team_id();
  LAS char* sm = smfull + team * 65536;
  LAS int* xs = (LAS int*)(smfull + LDS_XS + team * 2048);
  LAS int* xsg = (LAS int*)(smfull + LDS_XS);
  const int bid = blockIdx.x, nb = gridDim.x;
  const int vb = vbid(), nv = nvb();
  if (p.never) cg::this_grid().sync();
  if (tid5 < 64) ((LAS unsigned*)(smfull + LDS_XB))[tid5] = 0u;
  __syncthreads();
  XcdBarrier xb = xcd_barrier_post(p.bar, (volatile LAS unsigned*)(smfull + LDS_XB));
  if (SPINMASK != 0ull && bid == 0 && tid5 == 0) ((unsigned long long*)(xb.bar + 4096))[0] = __builtin_amdgcn_s_memrealtime();

  REP(0) PH(0) for (int t = vb; t < p.ttiles; t += nv) {
    int ji = 0;
#pragma unroll
    for (int q = 1; q < NJOBS; ++q) if (t >= p.jobs[q].tile0) ji = q;
    transpose_tile(p.jobs[ji], t - p.jobs[ji].tile0, sm);
  }
  PH(1) {
    const long gt = (long)vb * 256 + tid, gs = (long)nv * 256;
    for (long i = gt; i < 2L * 32 * 232 * 4; i += gs) { const long l = i / (32 * 232 * 4); long rem = i % (32 * 232 * 4); const long kb = rem / (232 * 4); rem %= (232 * 4);
      *(u32x4*)(p.WinT + l * 2816 * 1024 + (kb * 2816 + 2584) * 32 + rem * 8) = (u32x4){0u, 0u, 0u, 0u}; }
    for (long i = gt; i < 2L * 32 * 236 * 4; i += gs) { const long l = i / (32 * 236 * 4); long rem = i % (32 * 236 * 4); const long kb = rem / (236 * 4); rem %= (236 * 4);
      *(u32x4*)(p.WrT + l * 256 * 1024 + (kb * 256 + 20) * 32 + rem * 8) = (u32x4){0u, 0u, 0u, 0u}; }
    if (gt < 64) { p.mcnt[gt] = 0; p.wq[gt] = 0; }
    if (gt < 16384) { const int kc = (int)(gt >> 10), l = (int)((gt >> 9) & 1), kv = (int)((gt >> 8) & 1), n = (int)(gt & 255);
      const float* pe = (kv ? p.pe_v : p.pe_k) + l * 2048 + kc * 128; const float* w1 = (kv ? p.w1v : p.w1k) + (long)l * 2048 * 256 + (long)kc * 128 * 256 + n;
      float s = 0.f;
#pragma unroll 16
      for (int k = 0; k < 128; ++k) s += pe[k] * w1[(long)k * 256];
      p.bias1[gt] = s; }
  }
  PH(2) rownorm<false>(p.mem, p.mem_g, p.memn, 1024);
  rownorm<false>(p.mem, p.mem_g + DM, p.memn + 1024 * DM, 1024);
  rowprep(p.x_in, p.hb, p.ssq, NTOK);
  GSYNCK(1);

  for (int layer = 0; layer < 2; ++layer) {
    REP(3) PH(3) {
      const int nmain = 64 * 11, nextra = layer == 0 ? 64 : 0;
      for (int it = bid; it < nmain + nextra; it += nb) {
        if (it < nmain) {
          const int nt = it / 64, mt = it % 64;
          RowKB af{p.hb, NTOK, mt * 256, 0};
          RowKB bf{p.WinT + (long)layer * 2816 * DM, 2816, nt * 256, 0};
          EpiInproj ep{p.P, p.fgl, p.ssq, mt, nt};
          gemm_tile(smfull, 16, af, bf, ep);
        } else {
          const int e = it - nmain; const int l2 = e >> 5, kv = (e >> 4) & 1, mt = (e >> 2) & 3, nt = e & 3;
          RowKB af{p.memn + (long)l2 * 1024 * DM, 1024, mt * 256, 0};
          RowKB bf{(kv ? p.WvT : p.WkT) + (long)l2 * 1024 * DM, 1024, nt * 256, 0};
          EpiBf16 ep{(kv ? p.Vmem : p.Kmem) + (long)l2 * 1024 * DM, DM, mt * 256, nt * 256, nullptr};
          gemm_tile(smfull, 16, af, bf, ep);
        }
      }
    }
    GSYNCK(2 + layer * 12);
    REP(4) PH(4) {
      for (int it = bid; it < 128; it += nb) {
        const int ks = it & 7, mt = (it >> 3) & 7, kv = it >> 6;
        RowCmp af{p.P + (kv ? 1920 : 1792), mt * 256, ks * 4};
        RowKB bf{p.W1T + ((long)layer * 2 + kv) * 256 * 2048, 256, 0, ks * 8};
        EpiF32 ep{p.hidp + ((long)ks * 4096 + kv * 2048) * 256, 256, mt * 256, 0};
        gemm_tile(smfull, 4, af, bf, ep);
      }
      __syncthreads();
      for (int e = vb; e < 1024; e += nv) pool_unit(p, layer, e >> 8, (e >> 2) & 63, e & 3, sm);
      if (vb >= nv - 24) { const int e = nv - 1 - vb; cum_unit(p, layer, e / 6, e % 6, sm); }
    }
    GSYNCK(3 + layer * 12);
    PH(5) for (int it = vb; it < 256; it += nv) cmp2_unit(p, layer, it >> 7, it & 127, sm);
    GSYNCK(4 + layer * 12);
    REP(6) {
      if (FLEXP) { __syncthreads(); if (tid5 == 0) xsg[500] = (rep_ == 0 && ((DUPMASK >> 6) & 1)) ? 1 : 0; __syncthreads(); }
      int* ctr = p.wq + layer * 8 + rep_ * 2;
      for (;;) {
        __syncthreads();
        if (tid5 == 0) xsg[0] = atomicAdd(ctr, 1);
        __syncthreads();
        const int it = xsg[0];
        if (it >= 416) break;
        if (it < 216) { const int qb = 15 - it / 24, bh = it % 24; fox_unit(p, bh / 6, bh % 6, qb, smfull); }
        else if (it < 344) { const int e = it - 216; const int qb = 15 - (e >> 3), bg = e & 7; nsa_stageA(p, layer, bg >> 1, bg & 1, qb, smfull); }
        else { const int e = it - 344; const int qb = 6 - e / 24, bh = e % 24; fox_unit(p, bh / 6, bh % 6, qb, smfull); }
      }
    }
    GSYNCK(5 + layer * 12);
    REP(6) {
      if (FLEXP) { __syncthreads(); if (tid5 == 0) xsg[500] = (rep_ == 0 && ((DUPMASK >> 6) & 1)) ? 1 : 0; __syncthreads(); }
      int* ctr = p.wq + layer * 8 + 4 + rep_ * 2;
      for (;;) {
        __syncthreads();
        if (tid5 == 0) xsg[0] = atomicAdd(ctr, 1);
        __syncthreads();
        const int it = xsg[0];
        if (it >= 480) break;
        if (it < 192) { const int qb = 15 - it / 12, e = it % 12; nsa_stageB(p, layer, e / 3, 3 + e % 3, qb, smfull); }
        else if (it < 384) { const int e2 = it - 192; const int qb = 15 - e2 / 12, e = e2 % 12; nsa_stageB(p, layer, e / 3, e % 3, qb, smfull); }
        else { const int e = it - 384; const int qb = 3 - e / 24, bh = e % 24; fox_unit(p, bh / 6, bh % 6, qb, smfull); }
      }
    }
    GSYNCK(6 + layer * 12);
    PH(7) for (int it = bid; it < 256; it += nb) {
      const int nt = it >> 6, mt = it & 63;
      RowKB af{p.cat, NTOK, mt * 256, 0};
      RowKB bf{p.WoutT + (long)layer * 1024 * DM, 1024, nt * 256, 0};
      EpiResid ep{layer == 0 ? p.x_in : nullptr, p.hb, p.ssq, mt * 256, nt * 256};
      gemm_tile(smfull, 16, af, bf, ep);
    }
    GSYNCK(7 + layer * 12);
    REP(8) PH(8) for (int it = bid; it < 256; it += nb) {
      const int nt = it >> 6, mt = it & 63;
      RowKB af{p.hb, NTOK, mt * 256, 0};
      RowKB bf{p.WqT + (long)layer * 1024 * DM, 1024, nt * 256, 0};
      EpiBf16 ep{p.qx, DM, mt * 256, nt * 256, p.ssq};
      gemm_tile(smfull, 16, af, bf, ep);
    }
    GSYNCK(8 + layer * 12);
    REP(5) { for (int it = bid; it < 512; it += nb) { const int dh = it & 1, hd = (it >> 1) & 3, b = (it >> 3) & 3, qb = it >> 5; xattn_unit(p, layer, b, hd, qb, dh, smfull); } }
    GSYNCK(9 + layer * 12);
    PH(9) for (int it = bid; it < 256; it += nb) {
      const int nt = it >> 6, mt = it & 63;
      RowKB af{p.ox, NTOK, mt * 256, 0};
      RowKB bf{p.WoT + (long)layer * 1024 * DM, 1024, nt * 256, 0};
      EpiResid ep{nullptr, p.hb, p.ssq, mt * 256, nt * 256};
      gemm_tile(smfull, 16, af, bf, ep);
    }
    GSYNCK(10 + layer * 12);
    PH(10) for (int it = bid; it < 256; it += nb) {
      const int ks = it & 3, mt = it >> 2;
      RowKB af{p.hb, NTOK, mt * 256, ks * 8};
      RowKB bf{p.WrT + (long)layer * 256 * DM, 256, 0, ks * 8};
      EpiRouterPart ep{p.rpart + (long)ks * NTOK * 32, mt * 256};
      gemm_tile(smfull, 4, af, bf, ep);
    }
    GSYNC();
    PH(10) if (vb < 64) {
      const int tid = otid();
      const int tok = vb * 256 + tid;
      TSYNC();
      if (tid < 32) xs[tid] = 0;
      TSYNC();
      float lg[20];
#pragma unroll
      for (int q4 = 0; q4 < 5; ++q4) {
        f32x4 v = *(const f32x4*)(p.rpart + (long)tok * 32 + q4 * 4);
#pragma unroll
        for (int sI = 1; sI < 4; ++sI) v += *(const f32x4*)(p.rpart + ((long)sI * NTOK + tok) * 32 + q4 * 4);
        lg[q4 * 4] = v[0]; lg[q4 * 4 + 1] = v[1]; lg[q4 * 4 + 2] = v[2]; lg[q4 * 4 + 3] = v[3];
      }
      { const float rs = row_rstd(p.ssq, tok);
#pragma unroll
        for (int q = 0; q < 20; ++q) lg[q] *= rs; }
      float c[4], f[4];
#pragma unroll
      for (int i = 0; i < 4; ++i) c[i] = lg[i] + p.rc_b[layer * 4 + i];
      int grp = 0; float cm = c[0];
#pragma unroll
      for (int i = 1; i < 4; ++i) if (c[i] > cm) { cm = c[i]; grp = i; }
      float cs = 0.f;
#pragma unroll
      for (int i = 0; i < 4; ++i) cs += __expf(c[i] - cm);
      const float wgrp = 1.0f / cs;
#pragma unroll
      for (int i = 0; i < 4; ++i) { const float l0 = lg[4 + i], l1 = lg[8 + i], l2 = lg[12 + i], l3 = lg[16 + i];
        f[i] = (grp == 0 ? l0 : grp == 1 ? l1 : grp == 2 ? l2 : l3) + p.rf_b[layer * 16 + grp * 4 + i]; }
      int i1 = 0; float f1 = f[0];
#pragma unroll
      for (int i = 1; i < 4; ++i) if (f[i] > f1) { f1 = f[i]; i1 = i; }
      int i2 = -1; float f2 = -INFINITY;
#pragma unroll
      for (int i = 0; i < 4; ++i) if (i != i1 && f[i] > f2) { f2 = f[i]; i2 = i; }
      const float e2 = __expf(f2 - f1);
      const float w1 = wgrp / (1.0f + e2), w2 = wgrp * e2 / (1.0f + e2);
      const int a = i1 < i2 ? i1 : i2, bq = i1 < i2 ? i2 : i1;
      const float wa = i1 < i2 ? w1 : w2, wb = i1 < i2 ? w2 : w1;
      const int pairidx = (a == 0) ? (bq - 1) : (a == 1 ? bq + 1 : 5);
      const int cls = grp * 6 + pairidx;
      const int lpos = __hip_atomic_fetch_add(xs + cls, 1, __ATOMIC_RELAXED, __HIP_MEMORY_SCOPE_WORKGROUP);
      TSYNC();
      if (tid < 24) xs[32 + tid] = atomicAdd(&p.mcnt[layer * 32 + tid], xs[tid]);
      TSYNC();
      const int pos = xs[32 + cls] + lpos;
      p.mlist[((long)layer * 24 + cls) * NTOK + pos] = tok;
      p.tokw[tok * 2 + 0] = wa; p.tokw[tok * 2 + 1] = wb;
    }
    GSYNCK(11 + layer * 12);
    PH(11) {
      LAS int* tstart = xsg;
      LAS int* ccnt = xsg + 32;
      LAS int* toks = xsg + 64;
      LAS float* wts = (LAS float*)xsg + 320;
      LAS float* rsd = (LAS float*)xsg + 576;
      __syncthreads();
      if (tid5 == 0) { int a = 0; for (int c = 0; c < 24; ++c) { const int n = p.mcnt[layer * 32 + c]; ccnt[c] = n; tstart[c] = a; a += (n + 255) >> 8; } tstart[24] = a; }
      __syncthreads();
      const int nrt = tstart[24];
      for (int pass = 0; pass < 2; ++pass) {
        const int nct = pass == 0 ? 8 : 4;
        for (int it = bid; it < nrt * nct; it += nb) {
          const int rt = it / nct, ct = it % nct;
          int cls = 0;
          for (int c = 1; c < 24; ++c) if (rt >= tstart[c]) cls = c;
          const int rtl = rt - tstart[cls];
          const int grp = cls / 6, pi = cls % 6;
          const int ea = grp * 4 + (pi < 3 ? 0 : (pi < 5 ? 1 : 2)), eb = grp * 4 + (pi < 3 ? pi + 1 : (pi < 5 ? pi - 1 : 3));
          __syncthreads();
          const int tid5 = otid512();
          if (tid5 < 256) { const int idx = rtl * 256 + tid5; const bool ok = idx < ccnt[cls];
            const int tk = ok ? p.mlist[((long)layer * 24 + cls) * NTOK + idx] : -1; toks[tid5] = tk;
            wts[tid5] = ok ? p.tokw[tk * 2 + (ct < 4 ? 0 : 1)] : 0.f; rsd[tid5] = ok ? row_rstd(p.ssq, tk) : 0.f; }
          __syncthreads();
          if (pass == 0) {
            const int ex = ct < 4 ? ea : eb;
            RowGather af{p.hb, NTOK, toks};
            RowKB bf{p.WguT + ((long)layer * 16 + ex) * 1024 * DM, 1024, (ct & 3) * 256, 0};
            EpiMoeUp ep{p.he, (long)rt * 256, (ct < 4 ? 0 : 512) + (ct & 3) * 128, wts, rsd};
            gemm_tile(smfull, 16, af, bf, ep);
          } else {
            RowKB af{p.he, HE_ROWS, rt * 256, 0};
            const bf16_t* ba = p.WdT + ((long)layer * 16 + ea) * 1024 * 512;
            const bf16_t* bb = p.WdT + ((long)layer * 16 + eb) * 1024 * 512;
            RowSplitKB bf{ba, 1024, ct * 256, (long)(bb - ba)};
            EpiMoeDown ep{p.hb, p.ssq, ct * 256, toks};
            gemm_tile(smfull, 16, af, bf, ep);
          }
        }
        GSYNCK(12 + pass + layer * 12);
      }
    }
  }
  finalnorm(p.hb, p.ssq, p.final_g, p.xw, NTOK);
  if (SPINMASK != 0ull && bid == 0 && tid5 == 0) {
    unsigned long long tot = 0;
    for (int k = 0; k < 25; ++k) if ((SPINMASK >> k) & 1ull) tot += ((unsigned long long*)(xb.bar + 4096))[k + 1] - ((unsigned long long*)(xb.bar + 4096))[k];
    const unsigned long long t0 = __builtin_amdgcn_s_memrealtime();
    while (__builtin_amdgcn_s_memrealtime() - t0 < tot * SPINMUL) __builtin_amdgcn_s_sleep(8);
  }
}

static inline size_t al256(size_t x) { return (x + 255) & ~(size_t)255; }
extern "C" void kernel_launch(void* const* d_in, const int* in_sizes, int n_in, void* d_out, int out_size, void* d_ws, size_t ws_size, hipStream_t stream) {
  Params p; memset(&p, 0, sizeof(p));
  const float* const* in = (const float* const*)d_in;
  p.x_in = in[0]; p.mem = in[1]; p.mix_g = in[2]; p.fox_b = in[4]; p.pool_w = in[5]; p.pool_scale = in[6]; p.pe_k = in[7]; p.pe_v = in[8];
  p.w1k = in[9]; p.w1v = in[11]; p.w2k = in[10]; p.w2v = in[12]; p.gate_b = in[13]; p.xattn_g = in[15]; p.mem_g = in[16]; p.ffn_g = in[21]; p.rc_b = in[23]; p.rf_b = in[25]; p.final_g = in[29];
  p.xw = (float*)d_out;
  char* ws = (char*)d_ws; size_t off = 0;
  auto take = [&](size_t bytes) { char* r = ws + off; off = al256(off + bytes); return r; };
  p.bar = (unsigned*)take(4096 * 4 + 128 * 8);
  p.mcnt = (int*)take(64 * 4);
  p.wq = (int*)take(64 * 4);
  p.WinT = (bf16_t*)take(2UL * 2816 * 1024 * 2);
  p.WoutT = (bf16_t*)take(2UL * 1024 * 1024 * 2);
  p.WqT = (bf16_t*)take(2UL * 1024 * 1024 * 2);
  p.WkT = (bf16_t*)take(2UL * 1024 * 1024 * 2);
  p.WvT = (bf16_t*)take(2UL * 1024 * 1024 * 2);
  p.WoT = (bf16_t*)take(2UL * 1024 * 1024 * 2);
  p.WguT = (bf16_t*)take(2UL * 16 * 1024 * 1024 * 2);
  p.WdT = (bf16_t*)take(2UL * 16 * 1024 * 512 * 2);
  p.W1T = (bf16_t*)take(2UL * 2 * 256 * 2048 * 2);
  p.W2T = (bf16_t*)take(2UL * 2 * 64 * 256 * 2);
  p.WrT = (bf16_t*)take(2UL * 256 * 1024 * 2);
  p.bias1 = (float*)take(16 * 1024 * 4);
  p.hb = (bf16_t*)take((size_t)NTOK * 1024 * 2);
  p.onsa = (float*)d_out; p.hidp = (float*)d_out;
  p.P = (bf16_t*)take((size_t)NTOK * PW * 2);
  p.qx = p.P;
  p.ox = p.P + (size_t)NTOK * 1024;
  p.he = p.P;
  p.rpart = (float*)(p.P + (size_t)NTOK * 2048);
  p.cat = (bf16_t*)take((size_t)NTOK * 1024 * 2);
  p.memn = (bf16_t*)take(2UL * 1024 * 1024 * 2);
  p.Kmem = (bf16_t*)take(2UL * 1024 * 1024 * 2);
  p.Vmem = (bf16_t*)take(2UL * 1024 * 1024 * 2);
  p.hid = (bf16_t*)take(2UL * 2048 * 256 * 2);
  p.kvc = (bf16_t*)take(2UL * 2048 * 64 * 2);
  p.fgl = (float*)take((size_t)NTOK * 32 * 4);
  p.cum = (float*)take(24UL * SEQ * 4);
  p.tokw = (float*)take((size_t)NTOK * 2 * 4);
  p.ssq = (float*)take((size_t)NTOK * 16 * 4);
  p.mlist = (int*)take(2UL * 24 * NTOK * 4);
  p.selm = (unsigned*)take((size_t)NTOK * 2 * 2 * 4);
  int nj = 0, tile0 = 0;
  auto job = [&](const float* src, bf16_t* dst, long sbs, long dbs, int K, int N, int lds, int R, int map, int nbatch, const float* g = nullptr, int gdiv = 1) {
    TJob& j = p.jobs[nj++]; j.src = src; j.dst = dst; j.g = g; j.sbs = sbs; j.dbs = dbs; j.K = K; j.N = N; j.lds = lds; j.R = R; j.map = map;
    j.tpb = (K / 64) * ((N + 63) / 64); j.tile0 = tile0; j.gdiv = gdiv; tile0 += j.tpb * nbatch; };
  job(in[26], p.WguT, 1024L * 512, 1024L * 1024, 1024, 512, 512, 1024, 2, 32, in[21], 16);
  job(in[27], p.WguT, 1024L * 512, 1024L * 1024, 1024, 512, 512, 1024, 3, 32, in[21], 16);
  job(in[28], p.WdT, 512L * 1024, 1024L * 512, 512, 1024, 1024, 1024, 0, 32);
  job(in[3], p.WinT, 1024L * 2584, 2816L * 1024, 1024, 2584, 2584, 2816, 1, 2, in[2], 1);
  job(in[14], p.WoutT, 1024L * 1024, 1024L * 1024, 1024, 1024, 1024, 1024, 0, 2);
  job(in[17], p.WqT, 1024L * 1024, 1024L * 1024, 1024, 1024, 1024, 1024, 0, 2, in[15], 1);
  job(in[18], p.WkT, 1024L * 1024, 1024L * 1024, 1024, 1024, 1024, 1024, 0, 2);
  job(in[19], p.WvT, 1024L * 1024, 1024L * 1024, 1024, 1024, 1024, 1024, 0, 2);
  job(in[20], p.WoT, 1024L * 1024, 1024L * 1024, 1024, 1024, 1024, 1024, 0, 2);
  job(in[9], p.W1T, 2048L * 256, 2L * 256 * 2048, 2048, 256, 256, 256, 0, 2);
  job(in[11], p.W1T + 256L * 2048, 2048L * 256, 2L * 256 * 2048, 2048, 256, 256, 256, 0, 2);
  job(in[22], p.WrT, 1024L * 4, 256L * 1024, 1024, 4, 4, 256, 0, 2, in[21], 1);
  job(in[24], p.WrT + 4L * 32, 1024L * 16, 256L * 1024, 1024, 16, 16, 256, 0, 2, in[21], 1);
  p.ttiles = tile0; p.never = 0;
  static int grid_blocks = 0;
  if (!grid_blocks) {
    int dev = 0, cus = 0, per_cu = 0;
    (void)hipGetDevice(&dev);
    (void)hipDeviceGetAttribute(&cus, hipDeviceAttributeMultiprocessorCount, dev);
    if (hipFuncSetAttribute((const void*)fwd_kernel, hipFuncAttributeMaxDynamicSharedMemorySize, LDS_BYTES) != hipSuccess) fprintf(stderr, "hipFuncSetAttribute(dynamic LDS %d) failed\n", LDS_BYTES);
    (void)hipOccupancyMaxActiveBlocksPerMultiprocessor(&per_cu, fwd_kernel, 512, LDS_BYTES);
    (void)hipGetLastError();
    grid_blocks = cus;
  }
  (void)hipMemsetAsync(p.bar, 0, XCD_BAR_WORDS * 4, stream);
  void* args[] = {&p};
  hipError_t e = hipLaunchCooperativeKernel((void*)fwd_kernel, dim3(grid_blocks), dim3(512), args, LDS_BYTES, stream);
  if (e != hipSuccess) fprintf(stderr, "cooperative launch failed: %s (grid %d, ws needed %zu of %zu)\n", hipGetErrorString(e), grid_blocks, off, ws_size);
}
```

```cpp
#define DUPMASK 0
#define FLEXP 0
#define SPINMASK 0ull
#define SPINMUL 8
#define QEXP 0
#include <hip/hip_runtime.h>
#include <hip/hip_cooperative_groups.h>
#include <cstdint>
#include <cstdio>
#include <cstring>
namespace cg = cooperative_groups;

#define LAS __attribute__((address_space(3)))
typedef unsigned short bf16_t;
typedef short bf16x8 __attribute__((ext_vector_type(8)));
typedef short s16x4 __attribute__((ext_vector_type(4)));
typedef float f32x16 __attribute__((ext_vector_type(16)));
typedef float f32x4 __attribute__((ext_vector_type(4)));
typedef float f32x2 __attribute__((ext_vector_type(2)));
typedef unsigned u32x4 __attribute__((ext_vector_type(4)));
typedef unsigned u32x2 __attribute__((ext_vector_type(2)));
typedef __bf16 bf16x2_t __attribute__((ext_vector_type(2)));

#define NTOK 16384
#define SEQ 4096
#define DM 1024
#define PW 2560
#define LOG2E 1.4426950408889634f

__device__ __forceinline__ unsigned cvtpk(float lo, float hi) { f32x2 v = {lo, hi}; bf16x2_t b = __builtin_convertvector(v, bf16x2_t); return __builtin_bit_cast(unsigned, b); }
__device__ __forceinline__ bf16_t f2bf(float x) { return (bf16_t)(cvtpk(x, 0.f) & 0xffffu); }
__device__ __forceinline__ float bf2f(bf16_t b) { return __uint_as_float(((unsigned)b) << 16); }
__device__ __forceinline__ long kbo(long R, long r, int k) { return ((long)(k >> 5) * R + r) * 32 + (k & 31); }
#define HE_ROWS 22528
__device__ __forceinline__ int crow(int r, int hi) { return (r & 3) + 8 * (r >> 2) + 4 * hi; }
__device__ __forceinline__ float fexp2(float x) { return __builtin_amdgcn_exp2f(x); }
extern __shared__ __attribute__((aligned(16))) unsigned char lds_dyn[];
#define LDS_XS 131072
#define LDS_XB 135168
#define LDS_TB 135232
#define LDS_BYTES 135424
__device__ __forceinline__ int otid() { int t = threadIdx.x & 255; asm volatile("" : "+v"(t)); return t; }
__device__ __forceinline__ int otid512() { int t = threadIdx.x; asm volatile("" : "+v"(t)); return t; }
__device__ __forceinline__ int team_id() { return __builtin_amdgcn_readfirstlane((int)(threadIdx.x >> 8)); }
__device__ __forceinline__ int vbid() { return blockIdx.x * 2 + team_id(); }
__device__ __forceinline__ int nvb() { return gridDim.x * 2; }
__device__ __forceinline__ void team_sync() {
  asm volatile("s_waitcnt lgkmcnt(0)" ::: "memory");
  LAS unsigned* ctr = (LAS unsigned*)((LAS char*)lds_dyn + LDS_TB + team_id() * 64);
  unsigned old = 0u;
  if ((threadIdx.x & 63) == 0) old = __hip_atomic_fetch_add(ctr, 1u, __ATOMIC_RELAXED, __HIP_MEMORY_SCOPE_WORKGROUP);
  old = __builtin_amdgcn_readfirstlane(old);
  const unsigned tgt = (old & ~3u) + 4u;
  while ((int)(__hip_atomic_load(ctr, __ATOMIC_RELAXED, __HIP_MEMORY_SCOPE_WORKGROUP) - tgt) < 0) __builtin_amdgcn_s_sleep(0);
  asm volatile("" ::: "memory");
}
#define TSYNC() team_sync()
__device__ __forceinline__ float sigmoidf_(float x) { return 1.0f / (1.0f + __expf(-x)); }

struct TJob { const float* src; bf16_t* dst; const float* g; long sbs, dbs; int K, N, lds, R, map, tpb, tile0, gdiv; };
#define NJOBS 13
struct Params {
  const float *x_in, *mem, *mix_g, *fox_b, *pool_w, *pool_scale, *pe_k, *pe_v, *w1k, *w1v, *w2k, *w2v, *gate_b;
  const float *xattn_g, *mem_g, *ffn_g, *rc_b, *rf_b, *final_g;
  float* xw;
  bf16_t *WinT, *WoutT, *WqT, *WkT, *WvT, *WoT, *WguT, *WdT, *W1T, *W2T, *WrT;
  float* bias1;
  bf16_t *hb, *P, *cat, *memn, *Kmem, *Vmem, *hid, *kvc, *qx, *ox, *he;
  float *fgl, *cum, *onsa, *tokw, *hidp, *rpart, *ssq;
  int *mlist, *mcnt, *wq;
  unsigned* selm;
  unsigned* bar;
  TJob jobs[NJOBS];
  int ttiles; int never;
};

#define XB_TMO      128
#define XB_XCNT(j)  (256  + 64 * (j))
#define XB_XSUB(j)  (1280 + 64 * (j))
#define XB_XGEN(j)  (2304 + 64 * (j))
#define XB_TOP      3328
#define XB_TOPGEN   3392
#define XCD_BAR_WORDS 3456
#define XB_SPIN_CAP (1u << 22)
__device__ __forceinline__ unsigned xb_ld(unsigned* p)              { return __hip_atomic_load(p, __ATOMIC_RELAXED, __HIP_MEMORY_SCOPE_AGENT); }
__device__ __forceinline__ unsigned xb_add(unsigned* p, unsigned v) { return __hip_atomic_fetch_add(p, v, __ATOMIC_RELAXED, __HIP_MEMORY_SCOPE_AGENT); }
__device__ __forceinline__ unsigned xb_xcc_id() { return (unsigned)__builtin_amdgcn_s_getreg((3 << 11) | 20) & 0xFu; }
#define XB_SPIN(cond, bar) do { unsigned _sp = 0; while (cond) { __builtin_amdgcn_s_sleep(1); \
    if ((++_sp & 255u) == 0u) { if (xb_ld(&(bar)[XB_TMO])) break; if (_sp > XB_SPIN_CAP) { atomicAdd(&(bar)[XB_TMO], 1u); break; } } } } while (0)
struct XcdBarrier { unsigned* bar; unsigned x; volatile LAS unsigned* st; };
__device__ __forceinline__ XcdBarrier xcd_barrier_post(unsigned* bar, volatile LAS unsigned* st) {
    XcdBarrier b; b.bar = bar; b.x = xb_xcc_id(); b.st = st;
    if (threadIdx.x == 0) (void)xb_add(&bar[XB_XCNT(b.x)], 1u);
    return b;
}
__device__ __forceinline__ void xcd_barrier_complete(unsigned* bar, unsigned x, unsigned& nloc, unsigned& nx) {
    const unsigned G = gridDim.x * gridDim.y * gridDim.z;
    unsigned sum, cnt, mine, sp = 0u;
    for (;;) {
        sum = 0u; cnt = 0u; mine = 0u;
#pragma unroll
        for (unsigned j = 0; j < 16; ++j) { const unsigned c = xb_ld(&bar[XB_XCNT(j)]); sum += c; cnt += (c > 0u) ? 1u : 0u; mine = (j == x) ? c : mine; }
        if (sum == G) break;
        __builtin_amdgcn_s_sleep(1);
        if ((++sp & 255u) == 0u) { if (xb_ld(&bar[XB_TMO])) break; if (sp > XB_SPIN_CAP) { atomicAdd(&bar[XB_TMO], 1u); break; } }
    }
    nloc = mine > 0u ? mine : 1u; nx = cnt > 0u ? cnt : 1u;
}
__device__ __forceinline__ void xcd_barrier(const XcdBarrier& b) {
    asm volatile("s_waitcnt vmcnt(0)" ::: "memory");
    __syncthreads();
    if (threadIdx.x == 0) {
        unsigned* bar = b.bar;
        unsigned bx = __builtin_amdgcn_readfirstlane(b.x); asm volatile("" : "+s"(bx));
        __builtin_amdgcn_s_waitcnt(0);
        unsigned nloc = b.st[0], nx = b.st[1];
        if (nloc == 0u) { xcd_barrier_complete(bar, bx, nloc, nx); b.st[0] = nloc; b.st[1] = nx; }
        const unsigned old = xb_add(&bar[XB_XSUB(bx)], 1u);
        const unsigned gen = old / nloc;
        if (old + 1u == (gen + 1u) * nloc) {
            __builtin_amdgcn_fence(__ATOMIC_RELEASE, "agent");
            asm volatile("s_waitcnt vmcnt(0)" ::: "memory");
            const unsigned og = xb_add(&bar[XB_TOP], 1u);
            const unsigned tg = og / nx;
            if (og + 1u == (tg + 1u) * nx) xb_add(&bar[XB_TOPGEN], 1u);
            else XB_SPIN(xb_ld(&bar[XB_TOPGEN]) == tg, bar);
            __builtin_amdgcn_fence(__ATOMIC_ACQUIRE, "agent");
            xb_add(&bar[XB_XGEN(bx)], 1u);
            asm volatile("s_waitcnt vmcnt(0)" ::: "memory");
        } else {
            XB_SPIN(xb_ld(&bar[XB_XGEN(bx)]) == gen, bar);
            __builtin_amdgcn_fence(__ATOMIC_ACQUIRE, "agent");
            asm volatile("s_waitcnt vmcnt(0)" ::: "memory");
        }
    }
    __syncthreads();
}

__device__ __forceinline__ int nmap(int map, int n) {
  if (map == 1) { if (n < 1152) return n; if (n < 1158) return 2560 + (n - 1152); if (n < 2566) return n - 6; return n; }
  if (map == 2) return 64 * (n >> 5) + (n & 31);
  if (map == 3) return 64 * (n >> 5) + 32 + (n & 31);
  return n;
}
__device__ __forceinline__ void transpose_tile(const TJob& j, int t, LAS char* sm) {
  const int tid = otid();
  const int tb = t / j.tpb, tt = t - tb * j.tpb;
  const int nkt = j.K >> 6;
  const int kt = tt % nkt, nt = tt / nkt;
  const float* src = j.src + (long)tb * j.sbs + (long)(kt * 64) * j.lds + nt * 64;
  bf16_t* dst = j.dst + (long)tb * j.dbs;
  LAS float* tile = (LAS float*)sm;
  {
    const int tk = tid >> 4, tn4 = tid & 15;
    const bool ok = (nt * 64 + tn4 * 4) < j.N;
#pragma unroll
    for (int i = 0; i < 4; ++i) {
      const int k = tk + 16 * i;
      f32x4 v = {0.f, 0.f, 0.f, 0.f};
      if (ok) v = *(const f32x4*)(src + (long)k * j.lds + tn4 * 4);
      if (j.g) v *= j.g[(tb / j.gdiv) * DM + kt * 64 + k];
      tile[k * 65 + tn4 * 4 + 0] = v[0]; tile[k * 65 + tn4 * 4 + 1] = v[1]; tile[k * 65 + tn4 * 4 + 2] = v[2]; tile[k * 65 + tn4 * 4 + 3] = v[3];
    }
  }
  TSYNC();
  {
    const int n = tid >> 2, kq = tid & 3, ng = nt * 64 + n;
    if (ng < j.N) {
      const int row = nmap(j.map, ng);
      unsigned w[8];
#pragma unroll
      for (int c = 0; c < 8; ++c) w[c] = cvtpk(tile[(kq * 16 + 2 * c) * 65 + n], tile[(kq * 16 + 2 * c + 1) * 65 + n]);
      bf16_t* d = dst + kbo(j.R, row, kt * 64 + kq * 16);
      *(u32x4*)d = (u32x4){w[0], w[1], w[2], w[3]};
      *(u32x4*)(d + 8) = (u32x4){w[4], w[5], w[6], w[7]};
    }
  }
  TSYNC();
}

template <bool F32OUT>
__device__ __forceinline__ void rownorm(const float* x, const float* g, void* out, int nrows) {
  const int tid = otid(); const int lane = tid & 63;
  const int gw = vbid() * 4 + (tid >> 6), nw = nvb() * 4;
  for (int row = gw; row < nrows; row += nw) {
    const float* xr = x + (long)row * DM;
    f32x4 v[4]; float ss = 0.f;
#pragma unroll
    for (int i = 0; i < 4; ++i) { v[i] = *(const f32x4*)(xr + i * 256 + lane * 4); ss += v[i][0] * v[i][0] + v[i][1] * v[i][1] + v[i][2] * v[i][2] + v[i][3] * v[i][3]; }
#pragma unroll
    for (int o = 32; o >= 1; o >>= 1) ss += __shfl_xor(ss, o);
    const float rstd = 1.0f / sqrtf(ss * (1.0f / DM) + 1e-6f);
#pragma unroll
    for (int i = 0; i < 4; ++i) {
      const f32x4 gg = *(const f32x4*)(g + i * 256 + lane * 4);
      const f32x4 y = v[i] * rstd * gg;
      if (F32OUT) *(f32x4*)((float*)out + (long)row * DM + i * 256 + lane * 4) = y;
      else { u32x2 w; w.x = cvtpk(y[0], y[1]); w.y = cvtpk(y[2], y[3]); *(u32x2*)((bf16_t*)out + kbo(nrows, row, i * 256 + lane * 4)) = w; }
    }
  }
}

__device__ __forceinline__ float row_rstd(const float* ssq, long row) {
  const f32x4 a = *(const f32x4*)(ssq + row * 16), b = *(const f32x4*)(ssq + row * 16 + 4), c = *(const f32x4*)(ssq + row * 16 + 8), d = *(const f32x4*)(ssq + row * 16 + 12);
  const float t = ((a[0] + a[1]) + (a[2] + a[3])) + ((b[0] + b[1]) + (b[2] + b[3])) + ((c[0] + c[1]) + (c[2] + c[3])) + ((d[0] + d[1]) + (d[2] + d[3]));
  return 1.0f / sqrtf(t * (1.0f / DM) + 1e-6f);
}
__device__ __forceinline__ void rowprep(const float* x, bf16_t* xb, float* ssq, int nrows) {
  const int tid = otid(); const int lane = tid & 63;
  const int gw = vbid() * 4 + (tid >> 6), nw = nvb() * 4;
  for (int row = gw; row < nrows; row += nw) {
    const float* xr = x + (long)row * DM;
    f32x4 v[4]; float ss = 0.f;
#pragma unroll
    for (int i = 0; i < 4; ++i) { v[i] = *(const f32x4*)(xr + i * 256 + lane * 4); ss += v[i][0] * v[i][0] + v[i][1] * v[i][1] + v[i][2] * v[i][2] + v[i][3] * v[i][3]; }
#pragma unroll
    for (int o = 32; o >= 1; o >>= 1) ss += __shfl_xor(ss, o);
#pragma unroll
    for (int i = 0; i < 4; ++i) { u32x2 w; w.x = cvtpk(v[i][0], v[i][1]); w.y = cvtpk(v[i][2], v[i][3]); *(u32x2*)(xb + kbo(NTOK, row, i * 256 + lane * 4)) = w; }
    if (lane < 16) ssq[(long)row * 16 + lane] = lane == 0 ? ss : 0.f;
  }
}
struct RowKB { const bf16_t* base; long R; int r0; int s0;
  __device__ __forceinline__ const bf16_t* bptr() const { return base; }
  __device__ __forceinline__ unsigned rowoff(int r) const { return (unsigned)((r0 + r) * 32); }
  __device__ __forceinline__ long soff(int s) const { return (long)(s0 + s) * R * 32; } };
struct RowGather { const bf16_t* base; long R; LAS const int* toks;
  __device__ __forceinline__ const bf16_t* bptr() const { return base; }
  __device__ __forceinline__ unsigned rowoff(int r) const { int t = toks[r]; t = t < 0 ? 0 : t; return (unsigned)(t * 32); }
  __device__ __forceinline__ long soff(int s) const { return (long)s * R * 32; } };
struct RowCmp { const bf16_t* base; int r0; int kt0;
  __device__ __forceinline__ const bf16_t* bptr() const { return base; }
  __device__ __forceinline__ unsigned rowoff(int r) const { const int R = r0 + r; const int bg = R >> 8; int c = R & 255; c = c > 254 ? 254 : c;
    return (unsigned)(((bg >> 1) * SEQ + 16 * c) * PW + (bg & 1) * 64); }
  __device__ __forceinline__ long soff(int s) const { return (long)(kt0 + (s >> 1)) * PW + (s & 1) * 32; } };
struct RowSplitKB { const bf16_t* base; long R; int r0; long delta;
  __device__ __forceinline__ const bf16_t* bptr() const { return base; }
  __device__ __forceinline__ unsigned rowoff(int r) const { return (unsigned)((r0 + r) * 32); }
  __device__ __forceinline__ long soff(int s) const { return s < 16 ? (long)s * R * 32 : delta + (long)(s - 16) * R * 32; } };
__device__ __forceinline__ float gelu_tanh(float x) { const float u = 0.7978845608028654f * (x + 0.044715f * x * x * x); return 0.5f * x * (1.0f + tanhf(u)); }
__device__ __forceinline__ void finalnorm(const bf16_t* xb, const float* ssq, const float* g, float* out, int nrows) {
  const int tid = otid(); const int lane = tid & 63;
  const int gw = vbid() * 4 + (tid >> 6), nw = nvb() * 4;
  for (int row = gw; row < nrows; row += nw) {
    const float rs = row_rstd(ssq, row);
#pragma unroll
    for (int i = 0; i < 2; ++i) {
      const u32x4 w = *(const u32x4*)(xb + kbo(NTOK, row, i * 512 + lane * 8));
      const f32x4 g0 = *(const f32x4*)(g + i * 512 + lane * 8), g1 = *(const f32x4*)(g + i * 512 + lane * 8 + 4);
      float* op = out + (long)row * DM + i * 512 + lane * 8;
      *(f32x4*)op = (f32x4){__uint_as_float(w.x << 16) * rs * g0[0], __uint_as_float(w.x & 0xffff0000u) * rs * g0[1], __uint_as_float(w.y << 16) * rs * g0[2], __uint_as_float(w.y & 0xffff0000u) * rs * g0[3]};
      *(f32x4*)(op + 4) = (f32x4){__uint_as_float(w.z << 16) * rs * g1[0], __uint_as_float(w.z & 0xffff0000u) * rs * g1[1], __uint_as_float(w.w << 16) * rs * g1[2], __uint_as_float(w.w & 0xffff0000u) * rs * g1[3]};
    }
  }
}
#define GT_WAITBAR(N) asm volatile("s_waitcnt vmcnt(" #N ")\n\ts_barrier" ::: "memory")
template <class AF, class BF, class EPI, int EXPM = 0>
__device__ __forceinline__ void gemm_tile(LAS char* sm, int nkt, const AF& af, const BF& bfn, const EPI& epi) {
  const int tid = otid512(), lane = tid & 63, wid = __builtin_amdgcn_readfirstlane(tid >> 6), wm = wid >> 2, wn = wid & 3, l31 = lane & 31, hh = lane >> 5;
  const int lrow = tid >> 2;
  const int lkc = (tid & 3) ^ ((tid >> 4) & 3);
  unsigned ao[2], bo[2];
#pragma unroll
  for (int i = 0; i < 2; ++i) { ao[i] = (af.rowoff(lrow + 128 * i) + lkc * 8) * 2u; bo[i] = (bfn.rowoff(lrow + 128 * i) + lkc * 8) * 2u; }
  const char* abase = (const char*)af.bptr(); const char* bbase = (const char*)bfn.bptr();
  const int swz = (l31 >> 2) & 3;
  const int koff0 = ((hh ^ swz) << 4), koff1 = (((2 + hh) ^ swz) << 4);
  const int arow = (wm * 128 + l31) * 64, brow = 16384 + (wn * 64 + l31) * 64;
  f32x16 acc[4][2];
#pragma unroll
  for (int i = 0; i < 4; ++i)
#pragma unroll
    for (int j = 0; j < 2; ++j)
#pragma unroll
      for (int r = 0; r < 16; ++r) acc[i][j][r] = 0.f;
  LAS char* dst0 = sm + wid * 1024;
#define GT_ISSUE(st_) do { const int s__ = (st_); const long ka_ = af.soff(s__) * 2, kb_ = bfn.soff(s__) * 2; LAS char* d_ = dst0 + (s__ & 3) * 32768; \
    _Pragma("unroll") for (int i = 0; i < 2; ++i) { \
      __builtin_amdgcn_global_load_lds((const unsigned*)(abase + ka_ + ao[i]), (LAS unsigned*)(d_ + i * 8192), 16, 0, 0); \
      __builtin_amdgcn_global_load_lds((const unsigned*)(bbase + kb_ + bo[i]), (LAS unsigned*)(d_ + 16384 + i * 8192), 16, 0, 0); } } while (0)
  const int nst = 2 * nkt;
  __syncthreads();
  if (!(EXPM & 1)) { GT_ISSUE(0); GT_ISSUE(1); GT_ISSUE(2); }
  for (int st = 0; st < nst; ++st) {
    if (st + 2 < nst) GT_WAITBAR(8); else if (st + 1 < nst) GT_WAITBAR(4); else GT_WAITBAR(0);
    if (st + 3 < nst && !(EXPM & 1)) GT_ISSUE(st + 3);
    const int cur = (st & 3) * 32768;
#pragma unroll
    for (int s2 = 0; s2 < 2; ++s2) {
      const int ko = s2 ? koff1 : koff0;
      bf16x8 af4[4], bf2[2];
#pragma unroll
      for (int i = 0; i < 4; ++i) af4[i] = *(LAS const bf16x8*)(sm + cur + arow + i * 2048 + ko);
#pragma unroll
      for (int j = 0; j < 2; ++j) bf2[j] = *(LAS const bf16x8*)(sm + cur + brow + j * 2048 + ko);
#pragma unroll
      for (int i = 0; i < 4; ++i)
#pragma unroll
        for (int j = 0; j < 2; ++j) acc[i][j] = __builtin_amdgcn_mfma_f32_32x32x16_bf16(bf2[j], af4[i], acc[i][j], 0, 0, 0);
    }
  }
#undef GT_ISSUE
  if (!(EXPM & 2)) epi(acc, wm, wn, lane);
}

struct EpiInproj { bf16_t* P; float* fgl; const float* ssq; int mt, nt;
  __device__ __forceinline__ void operator()(f32x16 (&acc)[4][2], int wm, int wn, int lane) const {
    const int l31 = lane & 31, hh = lane >> 5;
#pragma unroll
    for (int i = 0; i < 4; ++i) {
      const long row = mt * 256 + wm * 128 + i * 32 + l31;
      const float rs = row_rstd(ssq, row);
#pragma unroll
      for (int j = 0; j < 2; ++j)
#pragma unroll
        for (int a = 0; a < 4; ++a) {
          const int col = nt * 256 + wn * 64 + j * 32 + 8 * a + 4 * hh;
          const f32x4 v = (f32x4){acc[i][j][4 * a] * rs, acc[i][j][4 * a + 1] * rs, acc[i][j][4 * a + 2] * rs, acc[i][j][4 * a + 3] * rs};
          if (nt < 10) { u32x2 w; w.x = cvtpk(v[0], v[1]); w.y = cvtpk(v[2], v[3]); *(u32x2*)(P + row * PW + col) = w; }
          else { const int c = col - 2560; if (c < 24) *(f32x4*)(fgl + row * 32 + c) = v; }
        }
    }
  } };
struct EpiBf16 { bf16_t* out; long ld; int row0, col0; const float* ssq;
  __device__ __forceinline__ void operator()(f32x16 (&acc)[4][2], int wm, int wn, int lane) const {
    const int l31 = lane & 31, hh = lane >> 5;
#pragma unroll
    for (int i = 0; i < 4; ++i) {
      const long row = row0 + wm * 128 + i * 32 + l31;
      const float rs = ssq ? row_rstd(ssq, row) : 1.0f;
      bf16_t* rp = out + row * ld + col0 + wn * 64 + 4 * hh;
#pragma unroll
      for (int j = 0; j < 2; ++j)
#pragma unroll
        for (int a = 0; a < 4; ++a) { u32x2 w; w.x = cvtpk(acc[i][j][4 * a] * rs, acc[i][j][4 * a + 1] * rs); w.y = cvtpk(acc[i][j][4 * a + 2] * rs, acc[i][j][4 * a + 3] * rs); *(u32x2*)(rp + j * 32 + 8 * a) = w; }
    }
  } };
struct EpiF32 { float* out; long ld; int row0, col0;
  __device__ __forceinline__ void operator()(f32x16 (&acc)[4][2], int wm, int wn, int lane) const {
    const int l31 = lane & 31, hh = lane >> 5;
#pragma unroll
    for (int i = 0; i < 4; ++i) {
      float* rp = out + (long)(row0 + wm * 128 + i * 32 + l31) * ld + col0 + wn * 64 + 4 * hh;
#pragma unroll
      for (int j = 0; j < 2; ++j)
#pragma unroll
        for (int a = 0; a < 4; ++a) *(f32x4*)(rp + j * 32 + 8 * a) = (f32x4){acc[i][j][4 * a], acc[i][j][4 * a + 1], acc[i][j][4 * a + 2], acc[i][j][4 * a + 3]};
    }
  } };
struct EpiResid { const float* basef; bf16_t* xb; float* ssq; int row0, col0;
  __device__ __forceinline__ void operator()(f32x16 (&acc)[4][2], int wm, int wn, int lane) const {
    const int l31 = lane & 31, hh = lane >> 5;
#pragma unroll
    for (int i = 0; i < 4; ++i) {
      const long row = row0 + wm * 128 + i * 32 + l31;
      const int c0 = col0 + wn * 64 + 4 * hh; const long o0 = row * DM + c0;
      float sq = 0.f;
#pragma unroll
      for (int j = 0; j < 2; ++j) {
        f32x4 bv[4];
        if (basef) {
#pragma unroll
          for (int a = 0; a < 4; ++a) bv[a] = *(const f32x4*)(basef + o0 + j * 32 + 8 * a);
        } else {
#pragma unroll
          for (int a = 0; a < 4; ++a) { const u32x2 w = *(const u32x2*)(xb + kbo(NTOK, row, c0 + j * 32 + 8 * a));
            bv[a] = (f32x4){__uint_as_float(w.x << 16), __uint_as_float(w.x & 0xffff0000u), __uint_as_float(w.y << 16), __uint_as_float(w.y & 0xffff0000u)}; }
        }
#pragma unroll
        for (int a = 0; a < 4; ++a) { u32x2 w; w.x = cvtpk(bv[a][0] + acc[i][j][4 * a], bv[a][1] + acc[i][j][4 * a + 1]); w.y = cvtpk(bv[a][2] + acc[i][j][4 * a + 2], bv[a][3] + acc[i][j][4 * a + 3]);
          *(u32x2*)(xb + kbo(NTOK, row, c0 + j * 32 + 8 * a)) = w;
          const float v0 = __uint_as_float(w.x << 16), v1 = __uint_as_float(w.x & 0xffff0000u), v2 = __uint_as_float(w.y << 16), v3 = __uint_as_float(w.y & 0xffff0000u);
          sq += (v0 * v0 + v1 * v1) + (v2 * v2 + v3 * v3); }
      }
      sq += __shfl_xor(sq, 32);
      if (hh == 0) ssq[row * 16 + (col0 >> 6) + wn] = sq;
      __builtin_amdgcn_sched_barrier(0);
    }
  } };
struct EpiMoeUp { bf16_t* he; long herow0; int hcol0; LAS const float* wts; LAS const float* rsd;
  __device__ __forceinline__ void operator()(f32x16 (&acc)[4][2], int wm, int wn, int lane) const {
    const int l31 = lane & 31, hh = lane >> 5;
#pragma unroll
    for (int i = 0; i < 4; ++i) {
      const int rl = wm * 128 + i * 32 + l31; const float wt = wts[rl]; const float rs = rsd[rl];
      const long hrow = herow0 + rl; const int hc0 = hcol0 + wn * 32 + 4 * hh;
#pragma unroll
      for (int a = 0; a < 4; ++a) {
        float v[4];
#pragma unroll
        for (int e = 0; e < 4; ++e) { const float gte = acc[i][0][4 * a + e] * rs, up = acc[i][1][4 * a + e] * rs; v[e] = gte * sigmoidf_(gte) * up * wt; }
        u32x2 w; w.x = cvtpk(v[0], v[1]); w.y = cvtpk(v[2], v[3]); *(u32x2*)(he + kbo(HE_ROWS, hrow, hc0 + 8 * a)) = w;
      }
      __builtin_amdgcn_sched_barrier(0);
    }
  } };
struct EpiMoeDown { bf16_t* xb; float* ssq; int col0; LAS const int* toks;
  __device__ __forceinline__ void operator()(f32x16 (&acc)[4][2], int wm, int wn, int lane) const {
    const int l31 = lane & 31, hh = lane >> 5;
#pragma unroll
    for (int i = 0; i < 4; ++i) {
      const int tok = toks[wm * 128 + i * 32 + l31];
      const long trow = tok < 0 ? 0 : tok; const int c0 = col0 + wn * 64 + 4 * hh;
      float sq = 0.f;
#pragma unroll
      for (int j = 0; j < 2; ++j) {
        u32x2 bw[4];
#pragma unroll
        for (int a = 0; a < 4; ++a) bw[a] = *(const u32x2*)(xb + kbo(NTOK, trow, c0 + j * 32 + 8 * a));
#pragma unroll
        for (int a = 0; a < 4; ++a) {
          u32x2 w; w.x = cvtpk(__uint_as_float(bw[a].x << 16) + acc[i][j][4 * a], __uint_as_float(bw[a].x & 0xffff0000u) + acc[i][j][4 * a + 1]);
          w.y = cvtpk(__uint_as_float(bw[a].y << 16) + acc[i][j][4 * a + 2], __uint_as_float(bw[a].y & 0xffff0000u) + acc[i][j][4 * a + 3]);
          if (tok >= 0) *(u32x2*)(xb + kbo(NTOK, trow, c0 + j * 32 + 8 * a)) = w;
          const float v0 = __uint_as_float(w.x << 16), v1 = __uint_as_float(w.x & 0xffff0000u), v2 = __uint_as_float(w.y << 16), v3 = __uint_as_float(w.y & 0xffff0000u);
          sq += (v0 * v0 + v1 * v1) + (v2 * v2 + v3 * v3); }
      }
      sq += __shfl_xor(sq, 32);
      if (hh == 0 && tok >= 0) ssq[(long)tok * 16 + (col0 >> 6) + wn] = sq;
      __builtin_amdgcn_sched_barrier(0);
    }
  } };
struct EpiRouterPart { float* part; int row0;
  __device__ __forceinline__ void operator()(f32x16 (&acc)[4][2], int wm, int wn, int lane) const {
    const int l31 = lane & 31, hh = lane >> 5;
    if (wn != 0) return;
#pragma unroll
    for (int i = 0; i < 4; ++i) {
      float* rp = part + (long)(row0 + wm * 128 + i * 32 + l31) * 32 + 4 * hh;
#pragma unroll
      for (int a = 0; a < 3; ++a) *(f32x4*)(rp + 8 * a) = (f32x4){acc[i][0][4 * a], acc[i][0][4 * a + 1], acc[i][0][4 * a + 2], acc[i][0][4 * a + 3]};
    }
  } };

template <int NKS> __device__ __forceinline__ int kswz(int kc, int row) {
  if (NKS == 4) return kc ^ ((row >> 1) & 7);
  return (kc & 16) | ((kc & 15) ^ (row & 15));
}
__device__ __forceinline__ void qk_tile64(f32x16& p0, f32x16& p1, const bf16x8* qf, LAS const char* Ks, int lane) {
  const int l31 = lane & 31, hh = lane >> 5;
#pragma unroll
  for (int r = 0; r < 16; ++r) { p0[r] = 0.f; p1[r] = 0.f; }
#pragma unroll
  for (int ds = 0; ds < 4; ++ds) {
    const int so = kswz<4>(2 * ds + hh, l31) << 4;
    const bf16x8 k0 = *(LAS const bf16x8*)(Ks + l31 * 128 + so);
    const bf16x8 k1 = *(LAS const bf16x8*)(Ks + (32 + l31) * 128 + so);
    p0 = __builtin_amdgcn_mfma_f32_32x32x16_bf16(k0, qf[ds], p0, 0, 0, 0);
    p1 = __builtin_amdgcn_mfma_f32_32x32x16_bf16(k1, qf[ds], p1, 0, 0, 0);
  }
}
__device__ __forceinline__ void qk_tile256(f32x16& p0, f32x16& p1, const bf16x8* qf, LAS const char* Ks, int lane) {
  const int l31 = lane & 31, hh = lane >> 5;
#pragma unroll
  for (int r = 0; r < 16; ++r) { p0[r] = 0.f; p1[r] = 0.f; }
#pragma unroll
  for (int ds = 0; ds < 16; ++ds) {
    const int so = kswz<16>(2 * ds + hh, l31) << 4;
    const bf16x8 k0 = *(LAS const bf16x8*)(Ks + l31 * 512 + so);
    const bf16x8 k1 = *(LAS const bf16x8*)(Ks + (32 + l31) * 512 + so);
    p0 = __builtin_amdgcn_mfma_f32_32x32x16_bf16(k0, qf[ds], p0, 0, 0, 0);
    p1 = __builtin_amdgcn_mfma_f32_32x32x16_bf16(k1, qf[ds], p1, 0, 0, 0);
  }
}
template <int NDT>
__device__ __forceinline__ void softmax_tile(f32x16& p0, f32x16& p1, float& m, float& l, f32x16* O, bf16x8* pb) {
  float mx = fmaxf(p0[0], p1[0]);
#pragma unroll
  for (int r = 1; r < 16; ++r) mx = fmaxf(mx, fmaxf(p0[r], p1[r]));
  mx = fmaxf(mx, __shfl_xor(mx, 32));
  if (__builtin_amdgcn_ballot_w64(mx > m) != 0ull) {
    const float mn = fmaxf(m, mx);
    const float mu = (mn == -INFINITY) ? 0.f : mn;
    const float alpha = fexp2(m - mu);
    l *= alpha; m = mn;
#pragma unroll
    for (int dt = 0; dt < NDT; ++dt)
#pragma unroll
      for (int r = 0; r < 16; ++r) O[dt][r] *= alpha;
  }
  const float mu = (m == -INFINITY) ? 0.f : m;
  float rs = 0.f;
#pragma unroll
  for (int r = 0; r < 16; ++r) { p0[r] = fexp2(p0[r] - mu); rs += p0[r]; }
#pragma unroll
  for (int r = 0; r < 16; ++r) { p1[r] = fexp2(p1[r] - mu); rs += p1[r]; }
  l += rs;
  u32x4 w;
  w = (u32x4){cvtpk(p0[0], p0[1]), cvtpk(p0[2], p0[3]), cvtpk(p0[4], p0[5]), cvtpk(p0[6], p0[7])}; pb[0] = __builtin_bit_cast(bf16x8, w);
  w = (u32x4){cvtpk(p0[8], p0[9]), cvtpk(p0[10], p0[11]), cvtpk(p0[12], p0[13]), cvtpk(p0[14], p0[15])}; pb[1] = __builtin_bit_cast(bf16x8, w);
  w = (u32x4){cvtpk(p1[0], p1[1]), cvtpk(p1[2], p1[3]), cvtpk(p1[4], p1[5]), cvtpk(p1[6], p1[7])}; pb[2] = __builtin_bit_cast(bf16x8, w);
  w = (u32x4){cvtpk(p1[8], p1[9]), cvtpk(p1[10], p1[11]), cvtpk(p1[12], p1[13]), cvtpk(p1[14], p1[15])}; pb[3] = __builtin_bit_cast(bf16x8, w);
}
template <int NDT>
__device__ __forceinline__ void pv_tile(f32x16* O, const bf16x8* pb, LAS const char* Vs, int lane) {
  const int hh = lane >> 5;
  const int vlane = (4 * hh + ((lane & 15) >> 2)) * 64 + (((lane >> 4) & 1) * 16 + (lane & 3) * 4) * 2;
#pragma unroll
  for (int dt = 0; dt < NDT; dt += 2) {
    s16x4 lo[2][4], hi[2][4];
#pragma unroll
    for (int d2 = 0; d2 < 2; ++d2)
#pragma unroll
      for (int ks = 0; ks < 4; ++ks) {
        LAS const char* vp = Vs + (dt + d2) * 4096 + ks * 16 * 64 + vlane;
        lo[d2][ks] = __builtin_amdgcn_ds_read_tr16_b64_v4i16((LAS s16x4*)vp);
        hi[d2][ks] = __builtin_amdgcn_ds_read_tr16_b64_v4i16((LAS s16x4*)(vp + 8 * 64));
      }
    __builtin_amdgcn_sched_barrier(0);
#pragma unroll
    for (int ks = 0; ks < 4; ++ks)
#pragma unroll
      for (int d2 = 0; d2 < 2; ++d2) {
        const bf16x8 vf = (bf16x8){lo[d2][ks][0], lo[d2][ks][1], lo[d2][ks][2], lo[d2][ks][3], hi[d2][ks][0], hi[d2][ks][1], hi[d2][ks][2], hi[d2][ks][3]};
        O[dt + d2] = __builtin_amdgcn_mfma_f32_32x32x16_bf16(vf, pb[ks], O[dt + d2], 0, 0, 0);
      }
  }
}
struct TLRange { int n, kv_last; __device__ __forceinline__ int count() const { return n; } __device__ __forceinline__ int kv0(int i) const { return kv_last - 64 * i; } };
struct TLList { int n; LAS const int* lst; __device__ __forceinline__ int count() const { return n; } __device__ __forceinline__ int kv0(int i) const { return lst[i]; } };

struct SMFox { float cq; const float* ck; int tq; int tqmax;
  static constexpr bool EXTRA = true;
  __device__ __forceinline__ bool active(int kv0) const { return kv0 <= tqmax; }
  __device__ __forceinline__ bool full(int kv0) const { return kv0 + 63 <= tqmax - 31; }
  __device__ __forceinline__ const float* xsrc(int kv0, int lane) const { return ck + kv0 + lane; }
  template <bool MASK> __device__ __forceinline__ void apply(f32x16& p0, f32x16& p1, int kv0, int lane, LAS const char* xs_) const {
    const int hh = lane >> 5; const float C = 0.125f * LOG2E;
    const int db = tq - kv0 - 4 * hh;
    LAS const float* cp = (LAS const float*)xs_ + 4 * hh;
#pragma unroll
    for (int a = 0; a < 4; ++a) {
      const f32x4 c0 = *(LAS const f32x4*)(cp + 8 * a);
      const f32x4 c1 = *(LAS const f32x4*)(cp + 32 + 8 * a);
#pragma unroll
      for (int e = 0; e < 4; ++e) {
        const int c = 8 * a + e;
        const float s0 = __builtin_fmaf(p0[4 * a + e], C, cq - c0[e]), s1 = __builtin_fmaf(p1[4 * a + e], C, cq - c1[e]);
        p0[4 * a + e] = (!MASK || db >= c) ? s0 : -INFINITY;
        p1[4 * a + e] = (!MASK || db >= c + 32) ? s1 : -INFINITY;
      }
    }
  } };
struct SMWin { int tq; float slope2; int tqmax;
  static constexpr bool EXTRA = false;
  __device__ __forceinline__ const float* xsrc(int, int) const { return nullptr; }
  __device__ __forceinline__ bool active(int kv0) const { return kv0 <= tqmax && kv0 + 63 + 512 > tqmax - 31; }
  __device__ __forceinline__ bool full(int kv0) const { return kv0 + 63 <= tqmax - 31 && tqmax - kv0 < 512; }
  template <bool MASK> __device__ __forceinline__ void apply(f32x16& p0, f32x16& p1, int kv0, int lane, LAS const char*) const {
    const int hh = lane >> 5; const float C = 0.125f * LOG2E;
    const int db = tq - kv0 - 4 * hh; const float sb = -slope2 * (float)db;
#pragma unroll
    for (int r = 0; r < 16; ++r) {
      const int c = (r & 3) + 8 * (r >> 2);
      const int d0 = db - c, d1 = db - c - 32;
      const float s0 = __builtin_fmaf(p0[r], C, __builtin_fmaf(slope2, (float)c, sb)), s1 = __builtin_fmaf(p1[r], C, __builtin_fmaf(slope2, (float)(c + 32), sb));
      p0[r] = (!MASK || (d0 >= 0 && d0 < 512)) ? s0 : -INFINITY;
      p1[r] = (!MASK || (d1 >= 0 && d1 < 512)) ? s1 : -INFINITY;
    }
  } };
struct SMSel { int tq; float slope2; unsigned mlo, mhi; int tqmax;
  static constexpr bool EXTRA = false;
  __device__ __forceinline__ const float* xsrc(int, int) const { return nullptr; }
  __device__ __forceinline__ bool selbit(int kv0) const { const int j = kv0 >> 6; return ((j < 32 ? (mlo >> j) : (mhi >> (j - 32))) & 1u) != 0u; }
  __device__ __forceinline__ bool active(int kv0) const { return kv0 <= tqmax && __builtin_amdgcn_ballot_w64(selbit(kv0)) != 0ull; }
  __device__ __forceinline__ bool full(int kv0) const { return kv0 + 63 <= tqmax - 31 && __builtin_amdgcn_ballot_w64(!selbit(kv0)) == 0ull; }
  template <bool MASK> __device__ __forceinline__ void apply(f32x16& p0, f32x16& p1, int kv0, int lane, LAS const char*) const {
    const int hh = lane >> 5; const float C = 0.125f * LOG2E;
    const int dbr = tq - kv0 - 4 * hh;
    const int db = (!MASK || selbit(kv0)) ? dbr : -1; const float sb = -slope2 * (float)dbr;
#pragma unroll
    for (int r = 0; r < 16; ++r) {
      const int c = (r & 3) + 8 * (r >> 2);
      const float s0 = __builtin_fmaf(p0[r], C, __builtin_fmaf(slope2, (float)c, sb)), s1 = __builtin_fmaf(p1[r], C, __builtin_fmaf(slope2, (float)(c + 32), sb));
      p0[r] = (!MASK || db >= c) ? s0 : -INFINITY;
      p1[r] = (!MASK || db >= c + 32) ? s1 : -INFINITY;
    }
  } };
struct SMCmp { int tq; float slope2; int tqmax;
  static constexpr bool EXTRA = false;
  __device__ __forceinline__ const float* xsrc(int, int) const { return nullptr; }
  __device__ __forceinline__ bool active(int kv0) const { return 16 * kv0 + 31 <= tqmax; }
  __device__ __forceinline__ bool full(int kv0) const { return 16 * (kv0 + 63) + 31 <= tqmax - 31; }
  template <bool MASK> __device__ __forceinline__ void apply(f32x16& p0, f32x16& p1, int kv0, int lane, LAS const char*) const {
    const int hh = lane >> 5; const float C = 0.125f * LOG2E;
    const int db = tq - 31 - 16 * kv0 - 64 * hh; const float sb = -slope2 * (float)db;
#pragma unroll
    for (int r = 0; r < 16; ++r) {
      const int c = 16 * ((r & 3) + 8 * (r >> 2));
      const float s0 = __builtin_fmaf(p0[r], C, __builtin_fmaf(slope2, (float)c, sb)), s1 = __builtin_fmaf(p1[r], C, __builtin_fmaf(slope2, (float)(c + 512), sb));
      p0[r] = (!MASK || db >= c) ? s0 : -INFINITY;
      p1[r] = (!MASK || db >= c + 512) ? s1 : -INFINITY;
    }
  } };

#define FL_STAGE 16896
#define g_flx (((LAS const int*)((LAS const char*)lds_dyn + LDS_XS))[500] != 0)
template <int N> __device__ __forceinline__ void fl_waitbar() {
  if (N == 0) asm volatile("s_waitcnt vmcnt(0)\n\ts_barrier" ::: "memory");
  else if (N == 2) asm volatile("s_waitcnt vmcnt(2)\n\ts_barrier" ::: "memory");
  else if (N == 3) asm volatile("s_waitcnt vmcnt(3)\n\ts_barrier" ::: "memory");
  else if (N == 4) asm volatile("s_waitcnt vmcnt(4)\n\ts_barrier" ::: "memory");
  else asm volatile("s_waitcnt vmcnt(6)\n\ts_barrier" ::: "memory");
}
template <int NSTG, class SM, class TL>
__device__ __forceinline__ void flash_run64(LAS char* sm, const bf16x8* qf, const bf16_t* Kb, long ldk, const bf16_t* Vb, long ldv,
                                            const TL& tl, const SM& smod, float& m, float& l, f32x16* O) {
  const int n = tl.count();
  if (n <= 0) return;
  constexpr int DPT = SM::EXTRA ? 3 : 2;
  const int tid = otid512(), lane = tid & 63, wid = __builtin_amdgcn_readfirstlane(tid >> 6);
  const int krow = tid >> 3;
  const bf16_t* ksrc = Kb + (long)krow * ldk + (((tid & 7) ^ ((krow >> 1) & 7)) * 8);
  const bf16_t* vsrc = Vb + (long)((tid & 255) >> 2) * ldv + (((tid >> 8) * 4 + (tid & 3)) * 8);
  LAS char* kd0 = sm + wid * 1024;
#define FL_ISSUE(i_) do { if ((FLEXP & 16) && g_flx) break; const int i__ = (i_); const int kv__ = tl.kv0(i__); LAS char* d__ = kd0 + (i__ % NSTG) * FL_STAGE; \
    __builtin_amdgcn_global_load_lds((const unsigned*)(ksrc + (long)kv__ * ldk), (LAS unsigned*)d__, 16, 0, 0); \
    __builtin_amdgcn_global_load_lds((const unsigned*)(vsrc + (long)kv__ * ldv), (LAS unsigned*)(d__ + 8192), 16, 0, 0); \
    if (SM::EXTRA) __builtin_amdgcn_global_load_lds((const unsigned*)(smod.xsrc(kv__, lane)), (LAS unsigned*)(sm + (i__ % NSTG) * FL_STAGE + 16384), 4, 0, 0); } while (0)
  __syncthreads();
#pragma unroll
  for (int i = 0; i < NSTG - 1; ++i) if (i < n) FL_ISSUE(i);
  { const int later = min(n - 1, NSTG - 2);
    if (later >= 2) fl_waitbar<2 * DPT>(); else if (later == 1) fl_waitbar<DPT>(); else fl_waitbar<0>(); }
  if (NSTG - 1 < n) FL_ISSUE(NSTG - 1);
  f32x16 pc0, pc1, pn0, pn1;
  int kv_cur = tl.kv0(0);
  bool act_cur = smod.active(kv_cur), act_next = false;
  if (act_cur) qk_tile64(pc0, pc1, qf, sm, lane);
  int st_cur = 0;
  for (int it = 0; it < n; ++it) {
    const int st_next = st_cur == NSTG - 1 ? 0 : st_cur + 1;
    int kv_next = 0;
    if (it + 1 < n) {
      kv_next = tl.kv0(it + 1);
      const int later = min(n - 1, it + NSTG - 2) - (it + 1);
      if (!((FLEXP & 32) && g_flx)) { if (NSTG >= 4 && later >= 1) fl_waitbar<DPT>(); else fl_waitbar<0>(); }
      if (it + NSTG - 1 < n && it > 0) FL_ISSUE(it + NSTG - 1);
    }
    act_next = false;
    if (it + 1 < n) { act_next = smod.active(kv_next); if (act_next) { if ((FLEXP & 8) && g_flx) { pn0 = pc0; pn1 = pc1; } else qk_tile64(pn0, pn1, qf, sm + st_next * FL_STAGE, lane); } }
    if (act_cur) {
      LAS const char* sb_ = sm + st_cur * FL_STAGE;
      if (!((FLEXP & 4) && g_flx)) { if (smod.full(kv_cur)) smod.template apply<false>(pc0, pc1, kv_cur, lane, sb_ + 16384); else smod.template apply<true>(pc0, pc1, kv_cur, lane, sb_ + 16384); }
      bf16x8 pb[4];
      if ((FLEXP & 1) && g_flx) { u32x4 w_ = {cvtpk(pc0[0], pc0[1]), cvtpk(pc0[2], pc0[3]), cvtpk(pc1[0], pc1[1]), cvtpk(pc1[2], pc1[3])}; pb[0] = pb[1] = pb[2] = pb[3] = __builtin_bit_cast(bf16x8, w_); }
      else softmax_tile<2>(pc0, pc1, m, l, O, pb);
      if ((FLEXP & 2) && g_flx) { const u32x4 w0 = __builtin_bit_cast(u32x4, pb[0]), w1 = __builtin_bit_cast(u32x4, pb[3]); O[0][0] += __uint_as_float((w0.x ^ w1.y) & 0x3fffffffu); }
      else pv_tile<2>(O, pb, sb_ + 8192, lane);
    }
    pc0 = pn0; pc1 = pn1; act_cur = act_next; kv_cur = kv_next; st_cur = st_next;
  }
#undef FL_ISSUE
}

__device__ __forceinline__ void fox_unit(const Params& p, int b, int h, int qb, LAS char* sm) {
  const int tid = otid512(), lane = tid & 63, w = tid >> 6, l31 = lane & 31, hh = lane >> 5;
  const int tq = qb * 256 + w * 32 + l31; const long tok = (long)b * SEQ + tq;
  const bf16_t* Pb = p.P + (long)b * SEQ * PW;
  bf16x8 qf[4];
#pragma unroll
  for (int ds = 0; ds < 4; ++ds) qf[ds] = *(const bf16x8*)(p.P + tok * PW + h * 64 + ds * 16 + hh * 8);
  const float* ck = p.cum + (long)(b * 6 + h) * SEQ;
  SMFox smod; smod.cq = ck[tq]; smod.ck = ck; smod.tq = tq; smod.tqmax = qb * 256 + w * 32 + 31;
  float m = -INFINITY, l = 0.f; f32x16 O[2];
#pragma unroll
  for (int r = 0; r < 16; ++r) { O[0][r] = 0.f; O[1][r] = 0.f; }
  TLRange tl; tl.n = 4 * qb + 4; tl.kv_last = qb * 256 + 192;
  flash_run64<4>(sm, qf, Pb + 384 + h * 64, PW, Pb + 768 + h * 64, PW, tl, smod, m, l, O);
  const float lt = l + __shfl_xor(l, 32); const float inv = lt > 0.f ? 1.0f / lt : 0.f;
#pragma unroll
  for (int dt = 0; dt < 2; ++dt)
#pragma unroll
    for (int a = 0; a < 4; ++a) { u32x2 wv; wv.x = cvtpk(O[dt][4 * a] * inv, O[dt][4 * a + 1] * inv); wv.y = cvtpk(O[dt][4 * a + 2] * inv, O[dt][4 * a + 3] * inv);
      *(u32x2*)(p.cat + kbo(NTOK, tok, h * 64 + dt * 32 + 8 * a + 4 * hh)) = wv; }
}

__device__ __forceinline__ void xattn_unit(const Params& p, int layer, int b, int hd, int qb, int dh, LAS char* sm) {
  const int tid = otid512(), lane = tid & 63, w = tid >> 6, l31 = lane & 31, hh = lane >> 5;
  const int tq = qb * 256 + w * 32 + l31; const long tok = (long)b * SEQ + tq;
  bf16x8 qf[16];
#pragma unroll
  for (int ds = 0; ds < 16; ++ds) qf[ds] = *(const bf16x8*)(p.qx + tok * DM + hd * 256 + ds * 16 + hh * 8);
  const float C = 0.0625f * LOG2E;
  float m = -INFINITY, l = 0.f; f32x16 O[4];
#pragma unroll
  for (int dt = 0; dt < 4; ++dt)
#pragma unroll
    for (int r = 0; r < 16; ++r) O[dt][r] = 0.f;
  const bf16_t* Kb = p.Kmem + ((long)layer * 1024 + b * 256) * DM + hd * 256;
  const bf16_t* Vb = p.Vmem + ((long)layer * 1024 + b * 256) * DM + hd * 256 + dh * 128;
  const int wid = __builtin_amdgcn_readfirstlane(tid >> 6);
  const bf16_t* ksrc[4]; const bf16_t* vsrc[2];
#pragma unroll
  for (int i = 0; i < 4; ++i) { const int pp = tid + 512 * i; const int row = pp >> 5, sl = pp & 31; const int kc = (sl & 16) | ((sl & 15) ^ (row & 15)); ksrc[i] = Kb + (long)row * DM + kc * 8; }
#pragma unroll
  for (int i = 0; i < 2; ++i) { const int pp = tid + 512 * i; vsrc[i] = Vb + (long)((pp & 255) >> 2) * DM + ((pp >> 8) * 4 + (pp & 3)) * 8; }
#define XA_ISSUE(t_) do { const int t__ = (t_); LAS char* d__ = sm + (t__ & 1) * 49152 + wid * 1024; \
    _Pragma("unroll") for (int i = 0; i < 4; ++i) __builtin_amdgcn_global_load_lds((const unsigned*)(ksrc[i] + (long)t__ * 64 * DM), (LAS unsigned*)(d__ + i * 8192), 16, 0, 0); \
    _Pragma("unroll") for (int i = 0; i < 2; ++i) __builtin_amdgcn_global_load_lds((const unsigned*)(vsrc[i] + (long)t__ * 64 * DM), (LAS unsigned*)(d__ + 32768 + i * 8192), 16, 0, 0); } while (0)
  __syncthreads();
  XA_ISSUE(0);
  fl_waitbar<0>();
#pragma unroll 1
  for (int it = 0; it < 4; ++it) {
    if (it + 1 < 4) XA_ISSUE(it + 1);
    LAS const char* sb_ = sm + (it & 1) * 49152;
    f32x16 p0, p1;
    qk_tile256(p0, p1, qf, sb_, lane);
#pragma unroll
    for (int r = 0; r < 16; ++r) { p0[r] *= C; p1[r] *= C; }
    bf16x8 pb[4];
    softmax_tile<4>(p0, p1, m, l, O, pb);
    pv_tile<4>(O, pb, sb_ + 32768, lane);
    fl_waitbar<0>();
  }
#undef XA_ISSUE
  const float lt = l + __shfl_xor(l, 32); const float inv = 1.0f / lt;
#pragma unroll
  for (int dt = 0; dt < 4; ++dt)
#pragma unroll
    for (int a = 0; a < 4; ++a) { u32x2 wv; wv.x = cvtpk(O[dt][4 * a] * inv, O[dt][4 * a + 1] * inv); wv.y = cvtpk(O[dt][4 * a + 2] * inv, O[dt][4 * a + 3] * inv);
      *(u32x2*)(p.ox + kbo(NTOK, tok, hd * 256 + dh * 128 + dt * 32 + 8 * a + 4 * hh)) = wv; }
}

#define NSA_SC 51200
#define NSA_UNI 122880
#define NSA_TL 122896
__device__ __forceinline__ void nsa_stageA(const Params& p, int layer, int b, int g, int qb, LAS char* sm) {
  const int tid = otid512(), lane = tid & 63, w = tid >> 6, l31 = lane & 31, hh = lane >> 5;
  const int tq = qb * 256 + w * 32 + l31; const long tok = (long)b * SEQ + tq;
  LAS float* sc = (LAS float*)(sm + NSA_SC);
  const bf16_t* kcb = p.kvc + (long)(0 * 8 + b * 2 + g) * 256 * 64;
  const bf16_t* vcb = p.kvc + (long)(1 * 8 + b * 2 + g) * 256 * 64;
  const int ntc = min(4, (16 * qb + 14) / 64 + 1);
  LAS float* myrow = sc + (w * 32 + l31) * 68;
  __syncthreads();
#pragma unroll
  for (int i = 0; i < 32; ++i) myrow[2 * i + hh] = 0.f;
  const float* glp = p.fgl + tok * 32 + 6;
  const float* gbp = p.gate_b + layer * 18;
#pragma unroll 1
  for (int r3 = 0; r3 < 3; ++r3) {
    const int head = 3 * g + r3;
    const float slope2 = exp2f(-8.0f * (float)(head + 1) / 6.0f) * LOG2E;
    bf16x8 qf[4];
#pragma unroll
    for (int ds = 0; ds < 4; ++ds) qf[ds] = *(const bf16x8*)(p.P + tok * PW + 1408 + head * 64 + ds * 16 + hh * 8);
    SMCmp smod; smod.tq = tq; smod.slope2 = slope2; smod.tqmax = qb * 256 + w * 32 + 31;
    float m = -INFINITY, l = 0.f; f32x16 O[2];
#pragma unroll
    for (int r = 0; r < 16; ++r) { O[0][r] = 0.f; O[1][r] = 0.f; }
    TLRange tl; tl.n = ntc; tl.kv_last = 64 * (ntc - 1);
    flash_run64<3>(sm, qf, kcb, 64, vcb, 64, tl, smod, m, l, O);
    const float lt = l + __shfl_xor(l, 32); const float inv = lt > 0.f ? 1.0f / lt : 0.f;
    const float gc = sigmoidf_(glp[head * 3 + 0] + gbp[head * 3 + 0]) * inv;
    float* ob = p.onsa + tok * 384 + head * 64;
#pragma unroll
    for (int dt = 0; dt < 2; ++dt)
#pragma unroll
      for (int a = 0; a < 4; ++a) *(f32x4*)(ob + dt * 32 + 8 * a + 4 * hh) = (f32x4){O[dt][4 * a] * gc, O[dt][4 * a + 1] * gc, O[dt][4 * a + 2] * gc, O[dt][4 * a + 3] * gc};
    const float mu = (m == -INFINITY) ? 0.f : m;
    float e_prev = 0.f;
    u32x4 kq[4];
    { const int row = tid >> 3, kc = tid & 7;
#pragma unroll
      for (int it = 0; it < 4; ++it) if (it < ntc) kq[it] = *(const u32x4*)(kcb + (long)(64 * it + row) * 64 + kc * 8); }
    const int kdst2 = (tid >> 3) * 128 + (kswz<4>(tid & 7, tid >> 3) << 4);
    __syncthreads();
    *(LAS u32x4*)(sm + kdst2) = kq[0];
    __syncthreads();
#pragma unroll
    for (int it = 0; it < 4; ++it) {
      if (it < ntc) {
        LAS char* kb_ = sm + (it & 1) * 8192;
        if (it + 1 < ntc) *(LAS u32x4*)(sm + ((it + 1) & 1) * 8192 + kdst2) = kq[(it + 1) & 3];
        f32x16 p0, p1;
        qk_tile64(p0, p1, qf, kb_, lane);
        smod.template apply<true>(p0, p1, 64 * it, lane, sm);
#pragma unroll
        for (int r = 0; r < 16; ++r) { p0[r] = fexp2(p0[r] - mu) * inv; p1[r] = fexp2(p1[r] - mu) * inv; }
#pragma unroll
        for (int pi = 0; pi < 2; ++pi)
#pragma unroll
          for (int a = 0; a < 4; ++a) {
            const float q0 = pi ? p1[4 * a] : p0[4 * a], q1 = pi ? p1[4 * a + 1] : p0[4 * a + 1], q2 = pi ? p1[4 * a + 2] : p0[4 * a + 2], q3 = pi ? p1[4 * a + 3] : p0[4 * a + 3];
            const float ex = __shfl_xor(q3, 32);
            myrow[2 * (8 * it + 4 * pi + a) + hh] += (q0 + q1) + (q2 + q3) + (hh ? ex : e_prev);
            e_prev = ex;
          }
        __syncthreads();
      }
    }
  }
  __syncthreads();
  {
    const int cur = tq >> 6;
#pragma unroll
    for (int mi = 0; mi < 32; ++mi) {
      const int j = 2 * mi + hh;
      const bool forced = (j == 0) || (j == cur) || (j == cur - 1);
      const float iv = myrow[j];
      myrow[j] = forced ? 1.0e4f : (j <= cur ? iv : -1.0f);
    }
  }
  __syncthreads();
  {
    float v[32];
#pragma unroll
    for (int i = 0; i < 8; ++i) { const f32x4 t = *(LAS const f32x4*)(myrow + 32 * hh + 4 * i); v[4 * i] = t[0]; v[4 * i + 1] = t[1]; v[4 * i + 2] = t[2]; v[4 * i + 3] = t[3]; }
    unsigned mym = 0u;
#pragma unroll 1
    for (int itk = 0; itk < 16; ++itk) {
      float best = v[0]; int bi = 0;
#pragma unroll
      for (int i = 1; i < 32; ++i) { const bool gt = v[i] > best; best = gt ? v[i] : best; bi = gt ? i : bi; }
      const float ob = __shfl_xor(best, 32);
      const bool mine = hh == 0 ? (best >= ob) : (best > ob);
      if (mine) {
        mym |= 1u << bi;
#pragma unroll
        for (int i = 0; i < 32; ++i) v[i] = (i == bi) ? -INFINITY : v[i];
      }
    }
    const unsigned oth = __shfl_xor(mym, 32);
    if (hh == 0) *(u32x2*)(p.selm + (tok * 2 + g) * 2) = (u32x2){mym, oth};
  }
  __syncthreads();
}

__device__ __forceinline__ void nsa_stageB(const Params& p, int layer, int b, int head, int qb, LAS char* sm) {
  const int tid = otid512(), lane = tid & 63, w = tid >> 6, l31 = lane & 31, hh = lane >> 5;
  const int g = head / 3;
  const int tq = qb * 256 + w * 32 + l31; const long tok = (long)b * SEQ + tq;
  const bf16_t* Pb = p.P + (long)b * SEQ * PW;
  LAS unsigned* uni = (LAS unsigned*)(sm + NSA_UNI);
  LAS int* tll = (LAS int*)(sm + NSA_TL);
  const float* glp = p.fgl + tok * 32 + 6;
  const float* gbp = p.gate_b + layer * 18;
  const u32x2 mk = *(const u32x2*)(p.selm + (tok * 2 + g) * 2);
  const unsigned mlo = mk.x, mhi = mk.y;
  __syncthreads();
  if (tid < 2) uni[tid] = 0u;
  __syncthreads();
  if (hh == 0) { __hip_atomic_fetch_or(uni, mlo, __ATOMIC_RELAXED, __HIP_MEMORY_SCOPE_WORKGROUP); __hip_atomic_fetch_or(uni + 1, mhi, __ATOMIC_RELAXED, __HIP_MEMORY_SCOPE_WORKGROUP); }
  __syncthreads();
  if (tid == 0) {
    unsigned long long u = ((unsigned long long)uni[1] << 32) | (unsigned long long)uni[0];
    const int jmax = (qb * 256 + 255) >> 6;
    int n = 0;
    for (int j = jmax; j >= 0; --j) if ((u >> j) & 1ull) tll[1 + n++] = 64 * j;
    tll[0] = n;
  }
  __syncthreads();
  const int nsel = tll[0];
  const int tqmax = qb * 256 + w * 32 + 31;
  const float slope2 = exp2f(-8.0f * (float)(head + 1) / 6.0f) * LOG2E;
  bf16x8 qf[4];
#pragma unroll
  for (int ds = 0; ds < 4; ++ds) qf[ds] = *(const bf16x8*)(p.P + tok * PW + 1408 + head * 64 + ds * 16 + hh * 8);
  f32x16 acc[2];
  {
    SMSel smod; smod.tq = tq; smod.slope2 = slope2; smod.mlo = mlo; smod.mhi = mhi; smod.tqmax = tqmax;
    float m = -INFINITY, l = 0.f; f32x16 O[2];
#pragma unroll
    for (int r = 0; r < 16; ++r) { O[0][r] = 0.f; O[1][r] = 0.f; }
    TLList tl; tl.n = nsel; tl.lst = tll + 1;
    flash_run64<4>(sm, qf, Pb + 2048 + g * 64, PW, Pb + 2176 + g * 64, PW, tl, smod, m, l, O);
    const float lt = l + __shfl_xor(l, 32); const float inv = lt > 0.f ? 1.0f / lt : 0.f;
    const float gs = sigmoidf_(glp[head * 3 + 1] + gbp[head * 3 + 1]) * inv;
#pragma unroll
    for (int r = 0; r < 16; ++r) { acc[0][r] = O[0][r] * gs; acc[1][r] = O[1][r] * gs; }
  }
  {
    SMWin smod; smod.tq = tq; smod.slope2 = slope2; smod.tqmax = tqmax;
    float m = -INFINITY, l = 0.f; f32x16 O[2];
#pragma unroll
    for (int r = 0; r < 16; ++r) { O[0][r] = 0.f; O[1][r] = 0.f; }
    const int kvf = max(0, qb * 256 - 512);
    TLRange tl; tl.kv_last = qb * 256 + 192; tl.n = (qb * 256 + 256 - kvf) >> 6;
    flash_run64<4>(sm, qf, Pb + 2304 + g * 64, PW, Pb + 2432 + g * 64, PW, tl, smod, m, l, O);
    const float lt = l + __shfl_xor(l, 32); const float inv = lt > 0.f ? 1.0f / lt : 0.f;
    const float gw = sigmoidf_(glp[head * 3 + 2] + gbp[head * 3 + 2]) * inv;
    const float* ob = p.onsa + tok * 384 + head * 64;
#pragma unroll
    for (int dt = 0; dt < 2; ++dt)
#pragma unroll
      for (int a = 0; a < 4; ++a) {
        const f32x4 oc = *(const f32x4*)(ob + dt * 32 + 8 * a + 4 * hh);
        u32x2 wv; wv.x = cvtpk(O[dt][4 * a] * gw + acc[dt][4 * a] + oc[0], O[dt][4 * a + 1] * gw + acc[dt][4 * a + 1] + oc[1]);
        wv.y = cvtpk(O[dt][4 * a + 2] * gw + acc[dt][4 * a + 2] + oc[2], O[dt][4 * a + 3] * gw + acc[dt][4 * a + 3] + oc[3]);
        *(u32x2*)(p.cat + kbo(NTOK, tok, 640 + head * 64 + dt * 32 + 8 * a + 4 * hh)) = wv;
      }
  }
  __syncthreads();
}

__device__ __forceinline__ void pool_unit(const Params& p, int layer, int b, int tb, int g, LAS char* sm) {
  const int tid = otid();
  LAS float* u = (LAS float*)sm;
  LAS float* W = (LAS float*)(sm + 20480);
  LAS float* pl = (LAS float*)(sm + 36864);
  const int t0 = tb * 64;
  const int wsz = 2 << g;
  TSYNC();
#pragma unroll
  for (int i3 = 0; i3 < 3; ++i3) { const int pi = tid + 256 * i3; if (pi < 79 * 8) { const int rr = pi >> 3, c8 = (pi & 7) * 8; const int t = t0 - 15 + rr;
      u32x4 v = {0u, 0u, 0u, 0u}; if (t >= 0) v = *(const u32x4*)(p.P + ((long)b * SEQ + t) * PW + 1152 + g * 64 + c8);
      *(LAS f32x4*)(u + rr * 64 + c8) = (f32x4){__uint_as_float(v.x << 16), __uint_as_float(v.x & 0xffff0000u), __uint_as_float(v.y << 16), __uint_as_float(v.y & 0xffff0000u)};
      *(LAS f32x4*)(u + rr * 64 + c8 + 4) = (f32x4){__uint_as_float(v.z << 16), __uint_as_float(v.z & 0xffff0000u), __uint_as_float(v.w << 16), __uint_as_float(v.w & 0xffff0000u)}; } }
#pragma unroll
  for (int i4 = 0; i4 < 4; ++i4) { const int i = (tid + 256 * i4) * 4; *(LAS f32x4*)(W + i) = *(const f32x4*)(p.pool_w + ((long)layer * 4 + g) * 4096 + i); }
  TSYNC();
  for (int i = tid; i < 4096; i += 256) { const int tl = i >> 6, c = i & 63; const int t = t0 + tl;
    float s = 0.f; for (int k = 0; k < wsz; ++k) s += u[(tl + 15 - k) * 64 + c];
    const float cnt = (float)min(t + 1, wsz);
    pl[i] = s / cnt - u[(tl + 15) * 64 + c]; }
  TSYNC();
  { const int d = tid & 63, tg = tid >> 6;
    const float scl = p.pool_scale[layer * 256 + g * 64 + d];
    float o[16];
#pragma unroll
    for (int i = 0; i < 16; ++i) o[i] = 0.f;
    for (int c = 0; c < 64; ++c) { const float wv = W[c * 64 + d];
#pragma unroll
      for (int i = 0; i < 16; ++i) o[i] += pl[(tg * 16 + i) * 64 + c] * wv; }
#pragma unroll
    for (int i = 0; i < 16; ++i) p.cat[kbo(NTOK, (long)b * SEQ + t0 + tg * 16 + i, 384 + g * 64 + d)] = f2bf(o[i] * scl); }
}

__device__ __forceinline__ void cum_unit(const Params& p, int layer, int b, int h, LAS char* sm) {
  const int tid = otid();
  LAS float* part = (LAS float*)sm;
  const float bf = p.fox_b[layer * 6 + h];
  float v[16]; float s = 0.f;
#pragma unroll
  for (int i = 0; i < 16; ++i) { const int t = tid * 16 + i; const float z = p.fgl[((long)b * SEQ + t) * 32 + h] + bf;
    const float ls = fminf(z, 0.f) - log1pf(__expf(-fabsf(z))); s += ls; v[i] = s; }
  TSYNC();
  part[tid] = s;
  TSYNC();
  if (tid < 64) {
    const f32x4 q = *(LAS const f32x4*)(part + 4 * tid);
    const float s0 = q[0], s1 = s0 + q[1], s2 = s1 + q[2], s3 = s2 + q[3];
    float inc = s3;
#pragma unroll
    for (int o = 1; o < 64; o <<= 1) { const float t = __shfl_up(inc, o); if (tid >= o) inc += t; }
    const float ex = inc - s3;
    *(LAS f32x4*)(part + 4 * tid) = (f32x4){ex, ex + s0, ex + s1, ex + s2};
  }
  TSYNC();
  const float base = part[tid];
#pragma unroll
  for (int i = 0; i < 16; ++i) p.cum[(long)(b * 6 + h) * SEQ + tid * 16 + i] = (base + v[i]) * LOG2E;
  TSYNC();
}

__device__ __forceinline__ void cmp2_unit(const Params& p, int layer, int kv, int rb, LAS char* sm) {
  const int tid = otid();
  LAS float* hs = (LAS float*)sm;
  const float* bias = p.bias1 + (layer * 2 + kv) * 256;
  const float* part = p.hidp + (long)kv * 2048 * 256;
  TSYNC();
#pragma unroll
  for (int i4 = 0; i4 < 4; ++i4) { const int i = (tid + 256 * i4) * 4; const int r = i >> 8, k = i & 255; const long o = (long)(rb * 16 + r) * 256 + k;
    f32x4 v = *(const f32x4*)(bias + k);
#pragma unroll
    for (int sI = 1; sI < 16; ++sI) v += *(const f32x4*)(bias + sI * 1024 + k);
#pragma unroll
    for (int sI = 0; sI < 8; ++sI) v += *(const f32x4*)(part + o + (long)sI * 4096 * 256);
    *(LAS f32x4*)(hs + i) = (f32x4){gelu_tanh(v[0]), gelu_tanh(v[1]), gelu_tanh(v[2]), gelu_tanh(v[3])}; }
  TSYNC();
  const int n = tid & 63, rg = tid >> 6;
  const float* w2 = (kv ? p.w2v : p.w2k) + (long)layer * 256 * 64 + n;
  float acc[4] = {0.f, 0.f, 0.f, 0.f};
#pragma unroll 1
  for (int k0 = 0; k0 < 256; k0 += 16) {
    float wv[16];
#pragma unroll
    for (int q = 0; q < 16; ++q) wv[q] = w2[(k0 + q) * 64];
#pragma unroll
    for (int q = 0; q < 16; q += 4)
#pragma unroll
      for (int j = 0; j < 4; ++j) { const f32x4 h4 = *(LAS const f32x4*)(hs + (rg * 4 + j) * 256 + k0 + q);
        acc[j] += h4[0] * wv[q] + h4[1] * wv[q + 1] + h4[2] * wv[q + 2] + h4[3] * wv[q + 3]; }
  }
#pragma unroll
  for (int j = 0; j < 4; ++j) { const int row = rb * 16 + rg * 4 + j; p.kvc[((long)kv * 2048 + row) * 64 + n] = ((row & 255) == 255) ? (bf16_t)0 : f2bf(acc[j]); }
}

#define GSYNC() xcd_barrier(xb)
#define GSYNCK(k) do { xcd_barrier(xb); if (SPINMASK != 0ull && bid == 0 && tid5 == 0) { ((unsigned long long*)(xb.bar + 4096))[(k)] = __builtin_amdgcn_s_memrealtime(); } } while (0)
#ifndef SKIPMASK
#define SKIPMASK 0
#endif
#define PH(n) if (!((SKIPMASK >> (n)) & 1))
#define REP(n) for (int rep_ = 0; rep_ < ((((DUPMASK) >> (n)) & 1) ? 2 : 1); ++rep_)
__global__ void __launch_bounds__(512, 2) fwd_kernel(Params p) {
  LAS char* smfull = (LAS char*)lds_dyn;
  const int tid5 = otid512();
  const int tid = otid();
  const int team = team_id();
  LAS char* sm = smfull + team * 65536;
  LAS int* xs = (LAS int*)(smfull + LDS_XS + team * 2048);
  LAS int* xsg = (LAS int*)(smfull + LDS_XS);
  const int bid = blockIdx.x, nb = gridDim.x;
  const int vb = vbid(), nv = nvb();
  if (p.never) cg::this_grid().sync();
  if (tid5 < 64) ((LAS unsigned*)(smfull + LDS_XB))[tid5] = 0u;
  __syncthreads();
  XcdBarrier xb = xcd_barrier_post(p.bar, (volatile LAS unsigned*)(smfull + LDS_XB));
  if (SPINMASK != 0ull && bid == 0 && tid5 == 0) ((unsigned long long*)(xb.bar + 4096))[0] = __builtin_amdgcn_s_memrealtime();

  REP(0) PH(0) for (int t = vb; t < p.ttiles; t += nv) {
    int ji = 0;
#pragma unroll
    for (int q = 1; q < NJOBS; ++q) if (t >= p.jobs[q].tile0) ji = q;
    transpose_tile(p.jobs[ji], t - p.jobs[ji].tile0, sm);
  }
  PH(1) {
    const long gt = (long)vb * 256 + tid, gs = (long)nv * 256;
    for (long i = gt; i < 2L * 32 * 232 * 4; i += gs) { const long l = i / (32 * 232 * 4); long rem = i % (32 * 232 * 4); const long kb = rem / (232 * 4); rem %= (232 * 4);
      *(u32x4*)(p.WinT + l * 2816 * 1024 + (kb * 2816 + 2584) * 32 + rem * 8) = (u32x4){0u, 0u, 0u, 0u}; }
    for (long i = gt; i < 2L * 32 * 236 * 4; i += gs) { const long l = i / (32 * 236 * 4); long rem = i % (32 * 236 * 4); const long kb = rem / (236 * 4); rem %= (236 * 4);
      *(u32x4*)(p.WrT + l * 256 * 1024 + (kb * 256 + 20) * 32 + rem * 8) = (u32x4){0u, 0u, 0u, 0u}; }
    if (gt < 64) { p.mcnt[gt] = 0; p.wq[gt] = 0; }
    if (gt < 16384) { const int kc = (int)(gt >> 10), l = (int)((gt >> 9) & 1), kv = (int)((gt >> 8) & 1), n = (int)(gt & 255);
      const float* pe = (kv ? p.pe_v : p.pe_k) + l * 2048 + kc * 128; const float* w1 = (kv ? p.w1v : p.w1k) + (long)l * 2048 * 256 + (long)kc * 128 * 256 + n;
      float s = 0.f;
#pragma unroll 16
      for (int k = 0; k < 128; ++k) s += pe[k] * w1[(long)k * 256];
      p.bias1[gt] = s; }
  }
  PH(2) rownorm<false>(p.mem, p.mem_g, p.memn, 1024);
  rownorm<false>(p.mem, p.mem_g + DM, p.memn + 1024 * DM, 1024);
  rowprep(p.x_in, p.hb, p.ssq, NTOK);
  GSYNCK(1);

  for (int layer = 0; layer < 2; ++layer) {
    REP(3) PH(3) {
      const int nmain = 64 * 11, nextra = layer == 0 ? 64 : 0;
      for (int it = bid; it < nmain + nextra; it += nb) {
        if (it < nmain) {
          const int nt = it / 64, mt = it % 64;
          RowKB af{p.hb, NTOK, mt * 256, 0};
          RowKB bf{p.WinT + (long)layer * 2816 * DM, 2816, nt * 256, 0};
          EpiInproj ep{p.P, p.fgl, p.ssq, mt, nt};
          gemm_tile(smfull, 16, af, bf, ep);
        } else {
          const int e = it - nmain; const int l2 = e >> 5, kv = (e >> 4) & 1, mt = (e >> 2) & 3, nt = e & 3;
          RowKB af{p.memn + (long)l2 * 1024 * DM, 1024, mt * 256, 0};
          RowKB bf{(kv ? p.WvT : p.WkT) + (long)l2 * 1024 * DM, 1024, nt * 256, 0};
          EpiBf16 ep{(kv ? p.Vmem : p.Kmem) + (long)l2 * 1024 * DM, DM, mt * 256, nt * 256, nullptr};
          gemm_tile(smfull, 16, af, bf, ep);
        }
      }
    }
    GSYNCK(2 + layer * 12);
    REP(4) PH(4) {
      for (int it = bid; it < 128; it += nb) {
        const int ks = it & 7, mt = (it >> 3) & 7, kv = it >> 6;
        RowCmp af{p.P + (kv ? 1920 : 1792), mt * 256, ks * 4};
        RowKB bf{p.W1T + ((long)layer * 2 + kv) * 256 * 2048, 256, 0, ks * 8};
        EpiF32 ep{p.hidp + ((long)ks * 4096 + kv * 2048) * 256, 256, mt * 256, 0};
        gemm_tile(smfull, 4, af, bf, ep);
      }
      __syncthreads();
      for (int e = vb; e < 1024; e += nv) pool_unit(p, layer, e >> 8, (e >> 2) & 63, e & 3, sm);
      if (vb >= nv - 24) { const int e = nv - 1 - vb; cum_unit(p, layer, e / 6, e % 6, sm); }
    }
    GSYNCK(3 + layer * 12);
    PH(5) for (int it = vb; it < 256; it += nv) cmp2_unit(p, layer, it >> 7, it & 127, sm);
    GSYNCK(4 + layer * 12);
    REP(6) {
      if (FLEXP) { __syncthreads(); if (tid5 == 0) xsg[500] = (rep_ == 0 && ((DUPMASK >> 6) & 1)) ? 1 : 0; __syncthreads(); }
      int* ctr = p.wq + layer * 8 + rep_ * 2;
      for (;;) {
        __syncthreads();
        if (tid5 == 0) xsg[0] = atomicAdd(ctr, 1);
        __syncthreads();
        const int it = xsg[0];
        if (it >= 416) break;
        if (it < 216) { const int qb = 15 - it / 24, bh = it % 24; fox_unit(p, bh / 6, bh % 6, qb, smfull); }
        else if (it < 344) { const int e = it - 216; const int qb = 15 - (e >> 3), bg = e & 7; nsa_stageA(p, layer, bg >> 1, bg & 1, qb, smfull); }
        else { const int e = it - 344; const int qb = 6 - e / 24, bh = e % 24; fox_unit(p, bh / 6, bh % 6, qb, smfull); }
      }
    }
    GSYNCK(5 + layer * 12);
    REP(6) {
      if (FLEXP) { __syncthreads(); if (tid5 == 0) xsg[500] = (rep_ == 0 && ((DUPMASK >> 6) & 1)) ? 1 : 0; __syncthreads(); }
      int* ctr = p.wq + layer * 8 + 4 + rep_ * 2;
      for (;;) {
        __syncthreads();
        if (tid5 == 0) xsg[0] = atomicAdd(ctr, 1);
        __syncthreads();
        const int it = xsg[0];
        if (it >= 480) break;
        if (it < 192) { const int qb = 15 - it / 12, e = it % 12; nsa_stageB(p, layer, e / 3, 3 + e % 3, qb, smfull); }
        else if (it < 384) { const int e2 = it - 192; const int qb = 15 - e2 / 12, e = e2 % 12; nsa_stageB(p, layer, e / 3, e % 3, qb, smfull); }
        else { const int e = it - 384; const int qb = 3 - e / 24, bh = e % 24; fox_unit(p, bh / 6, bh % 6, qb, smfull); }
      }
    }
    GSYNCK(6 + layer * 12);
    PH(7) for (int it = bid; it < 256; it += nb) {
      const int nt = it >> 6, mt = it & 63;
      RowKB af{p.cat, NTOK, mt * 256, 0};
      RowKB bf{p.WoutT + (long)layer * 1024 * DM, 1024, nt * 256, 0};
      EpiResid ep{layer == 0 ? p.x_in : nullptr, p.hb, p.ssq, mt * 256, nt * 256};
      gemm_tile(smfull, 16, af, bf, ep);
    }
    GSYNCK(7 + layer * 12);
    REP(8) PH(8) for (int it = bid; it < 256; it += nb) {
      const int nt = it >> 6, mt = it & 63;
      RowKB af{p.hb, NTOK, mt * 256, 0};
      RowKB bf{p.WqT + (long)layer * 1024 * DM, 1024, nt * 256, 0};
      EpiBf16 ep{p.qx, DM, mt * 256, nt * 256, p.ssq};
      gemm_tile(smfull, 16, af, bf, ep);
    }
    GSYNCK(8 + layer * 12);
    REP(5) { for (int it = bid; it < 512; it += nb) { const int dh = it & 1, hd = (it >> 1) & 3, b = (it >> 3) & 3, qb = it >> 5; xattn_unit(p, layer, b, hd, qb, dh, smfull); } }
    GSYNCK(9 + layer * 12);
    PH(9) for (int it = bid; it < 256; it += nb) {
      const int nt = it >> 6, mt = it & 63;
      RowKB af{p.ox, NTOK, mt * 256, 0};
      RowKB bf{p.WoT + (long)layer * 1024 * DM, 1024, nt * 256, 0};
      EpiResid ep{nullptr, p.hb, p.ssq, mt * 256, nt * 256};
      gemm_tile(smfull, 16, af, bf, ep);
    }
    GSYNCK(10 + layer * 12);
    PH(10) for (int it = bid; it < 256; it += nb) {
      const int ks = it & 3, mt = it >> 2;
      RowKB af{p.hb, NTOK, mt * 256, ks * 8};
      RowKB bf{p.WrT + (long)layer * 256 * DM, 256, 0, ks * 8};
      EpiRouterPart ep{p.rpart + (long)ks * NTOK * 32, mt * 256};
      gemm_tile(smfull, 4, af, bf, ep);
    }
    GSYNC();
    PH(10) if (vb < 64) {
      const int tid = otid();
      const int tok = vb * 256 + tid;
      TSYNC();
      if (tid < 32) xs[tid] = 0;
      TSYNC();
      float lg[20];
#pragma unroll
      for (int q4 = 0; q4 < 5; ++q4) {
        f32x4 v = *(const f32x4*)(p.rpart + (long)tok * 32 + q4 * 4);
#pragma unroll
        for (int sI = 1; sI < 4; ++sI) v += *(const f32x4*)(p.rpart + ((long)sI * NTOK + tok) * 32 + q4 * 4);
        lg[q4 * 4] = v[0]; lg[q4 * 4 + 1] = v[1]; lg[q4 * 4 + 2] = v[2]; lg[q4 * 4 + 3] = v[3];
      }
      { const float rs = row_rstd(p.ssq, tok);
#pragma unroll
        for (int q = 0; q < 20; ++q) lg[q] *= rs; }
      float c[4], f[4];
#pragma unroll
      for (int i = 0; i < 4; ++i) c[i] = lg[i] + p.rc_b[layer * 4 + i];
      int grp = 0; float cm = c[0];
#pragma unroll
      for (int i = 1; i < 4; ++i) if (c[i] > cm) { cm = c[i]; grp = i; }
      float cs = 0.f;
#pragma unroll
      for (int i = 0; i < 4; ++i) cs += __expf(c[i] - cm);
      const float wgrp = 1.0f / cs;
#pragma unroll
      for (int i = 0; i < 4; ++i) { const float l0 = lg[4 + i], l1 = lg[8 + i], l2 = lg[12 + i], l3 = lg[16 + i];
        f[i] = (grp == 0 ? l0 : grp == 1 ? l1 : grp == 2 ? l2 : l3) + p.rf_b[layer * 16 + grp * 4 + i]; }
      int i1 = 0; float f1 = f[0];
#pragma unroll
      for (int i = 1; i < 4; ++i) if (f[i] > f1) { f1 = f[i]; i1 = i; }
      int i2 = -1; float f2 = -INFINITY;
#pragma unroll
      for (int i = 0; i < 4; ++i) if (i != i1 && f[i] > f2) { f2 = f[i]; i2 = i; }
      const float e2 = __expf(f2 - f1);
      const float w1 = wgrp / (1.0f + e2), w2 = wgrp * e2 / (1.0f + e2);
      const int a = i1 < i2 ? i1 : i2, bq = i1 < i2 ? i2 : i1;
      const float wa = i1 < i2 ? w1 : w2, wb = i1 < i2 ? w2 : w1;
      const int pairidx = (a == 0) ? (bq - 1) : (a == 1 ? bq + 1 : 5);
      const int cls = grp * 6 + pairidx;
      const int lpos = __hip_atomic_fetch_add(xs + cls, 1, __ATOMIC_RELAXED, __HIP_MEMORY_SCOPE_WORKGROUP);
      TSYNC();
      if (tid < 24) xs[32 + tid] = atomicAdd(&p.mcnt[layer * 32 + tid], xs[tid]);
      TSYNC();
      const int pos = xs[32 + cls] + lpos;
      p.mlist[((long)layer * 24 + cls) * NTOK + pos] = tok;
      p.tokw[tok * 2 + 0] = wa; p.tokw[tok * 2 + 1] = wb;
    }
    GSYNCK(11 + layer * 12);
    PH(11) {
      LAS int* tstart = xsg;
      LAS int* ccnt = xsg + 32;
      LAS int* toks = xsg + 64;
      LAS float* wts = (LAS float*)xsg + 320;
      LAS float* rsd = (LAS float*)xsg + 576;
      __syncthreads();
      if (tid5 == 0) { int a = 0; for (int c = 0; c < 24; ++c) { const int n = p.mcnt[layer * 32 + c]; ccnt[c] = n; tstart[c] = a; a += (n + 255) >> 8; } tstart[24] = a; }
      __syncthreads();
      const int nrt = tstart[24];
      for (int pass = 0; pass < 2; ++pass) {
        const int nct = pass == 0 ? 8 : 4;
        for (int it = bid; it < nrt * nct; it += nb) {
          const int rt = it / nct, ct = it % nct;
          int cls = 0;
          for (int c = 1; c < 24; ++c) if (rt >= tstart[c]) cls = c;
          const int rtl = rt - tstart[cls];
          const int grp = cls / 6, pi = cls % 6;
          const int ea = grp * 4 + (pi < 3 ? 0 : (pi < 5 ? 1 : 2)), eb = grp * 4 + (pi < 3 ? pi + 1 : (pi < 5 ? pi - 1 : 3));
          __syncthreads();
          const int tid5 = otid512();
          if (tid5 < 256) { const int idx = rtl * 256 + tid5; const bool ok = idx < ccnt[cls];
            const int tk = ok ? p.mlist[((long)layer * 24 + cls) * NTOK + idx] : -1; toks[tid5] = tk;
            wts[tid5] = ok ? p.tokw[tk * 2 + (ct < 4 ? 0 : 1)] : 0.f; rsd[tid5] = ok ? row_rstd(p.ssq, tk) : 0.f; }
          __syncthreads();
          if (pass == 0) {
            const int ex = ct < 4 ? ea : eb;
            RowGather af{p.hb, NTOK, toks};
            RowKB bf{p.WguT + ((long)layer * 16 + ex) * 1024 * DM, 1024, (ct & 3) * 256, 0};
            EpiMoeUp ep{p.he, (long)rt * 256, (ct < 4 ? 0 : 512) + (ct & 3) * 128, wts, rsd};
            gemm_tile(smfull, 16, af, bf, ep);
          } else {
            RowKB af{p.he, HE_ROWS, rt * 256, 0};
            const bf16_t* ba = p.WdT + ((long)layer * 16 + ea) * 1024 * 512;
            const bf16_t* bb = p.WdT + ((long)layer * 16 + eb) * 1024 * 512;
            RowSplitKB bf{ba, 1024, ct * 256, (long)(bb - ba)};
            EpiMoeDown ep{p.hb, p.ssq, ct * 256, toks};
            gemm_tile(smfull, 16, af, bf, ep);
          }
        }
        GSYNCK(12 + pass + layer * 12);
      }
    }
  }
  finalnorm(p.hb, p.ssq, p.final_g, p.xw, NTOK);
  if (SPINMASK != 0ull && bid == 0 && tid5 == 0) {
    unsigned long long tot = 0;
    for (int k = 0; k < 25; ++k) if ((SPINMASK >> k) & 1ull) tot += ((unsigned long long*)(xb.bar + 4096))[k + 1] - ((unsigned long long*)(xb.bar + 4096))[k];
    const unsigned long long t0 = __builtin_amdgcn_s_memrealtime();
    while (__builtin_amdgcn_s_memrealtime() - t0 < tot * SPINMUL) __builtin_amdgcn_s_sleep(8);
  }
}

static inline size_t al256(size_t x) { return (x + 255) & ~(size_t)255; }
extern "C" void kernel_launch(void* const* d_in, const int* in_sizes, int n_in, void* d_out, int out_size, void* d_ws, size_t ws_size, hipStream_t stream) {
  Params p; memset(&p, 0, sizeof(p));
  const float* const* in = (const float* const*)d_in;
  p.x_in = in[0]; p.mem = in[1]; p.mix_g = in[2]; p.fox_b = in[4]; p.pool_w = in[5]; p.pool_scale = in[6]; p.pe_k = in[7]; p.pe_v = in[8];
  p.w1k = in[9]; p.w1v = in[11]; p.w2k = in[10]; p.w2v = in[12]; p.gate_b = in[13]; p.xattn_g = in[15]; p.mem_g = in[16]; p.ffn_g = in[21]; p.rc_b = in[23]; p.rf_b = in[25]; p.final_g = in[29];
  p.xw = (float*)d_out;
  char* ws = (char*)d_ws; size_t off = 0;
  auto take = [&](size_t bytes) { char* r = ws + off; off = al256(off + bytes); return r; };
  p.bar = (unsigned*)take(4096 * 4 + 128 * 8);
  p.mcnt = (int*)take(64 * 4);
  p.wq = (int*)take(64 * 4);
  p.WinT = (bf16_t*)take(2UL * 2816 * 1024 * 2);
  p.WoutT = (bf16_t*)take(2UL * 1024 * 1024 * 2);
  p.WqT = (bf16_t*)take(2UL * 1024 * 1024 * 2);
  p.WkT = (bf16_t*)take(2UL * 1024 * 1024 * 2);
  p.WvT = (bf16_t*)take(2UL * 1024 * 1024 * 2);
  p.WoT = (bf16_t*)take(2UL * 1024 * 1024 * 2);
  p.WguT = (bf16_t*)take(2UL * 16 * 1024 * 1024 * 2);
  p.WdT = (bf16_t*)take(2UL * 16 * 1024 * 512 * 2);
  p.W1T = (bf16_t*)take(2UL * 2 * 256 * 2048 * 2);
  p.W2T = (bf16_t*)take(2UL * 2 * 64 * 256 * 2);
  p.WrT = (bf16_t*)take(2UL * 256 * 1024 * 2);
  p.bias1 = (float*)take(16 * 1024 * 4);
  p.hb = (bf16_t*)take((size_t)NTOK * 1024 * 2);
  p.onsa = (float*)d_out; p.hidp = (float*)d_out;
  p.P = (bf16_t*)take((size_t)NTOK * PW * 2);
  p.qx = p.P;
  p.ox = p.P + (size_t)NTOK * 1024;
  p.he = p.P;
  p.rpart = (float*)(p.P + (size_t)NTOK * 2048);
  p.cat = (bf16_t*)take((size_t)NTOK * 1024 * 2);
  p.memn = (bf16_t*)take(2UL * 1024 * 1024 * 2);
  p.Kmem = (bf16_t*)take(2UL * 1024 * 1024 * 2);
  p.Vmem = (bf16_t*)take(2UL * 1024 * 1024 * 2);
  p.hid = (bf16_t*)take(2UL * 2048 * 256 * 2);
  p.kvc = (bf16_t*)take(2UL * 2048 * 64 * 2);
  p.fgl = (float*)take((size_t)NTOK * 32 * 4);
  p.cum = (float*)take(24UL * SEQ * 4);
  p.tokw = (float*)take((size_t)NTOK * 2 * 4);
  p.ssq = (float*)take((size_t)NTOK * 16 * 4);
  p.mlist = (int*)take(2UL * 24 * NTOK * 4);
  p.selm = (unsigned*)take((size_t)NTOK * 2 * 2 * 4);
  int nj = 0, tile0 = 0;
  auto job = [&](const float* src, bf16_t* dst, long sbs, long dbs, int K, int N, int lds, int R, int map, int nbatch, const float* g = nullptr, int gdiv = 1) {
    TJob& j = p.jobs[nj++]; j.src = src; j.dst = dst; j.g = g; j.sbs = sbs; j.dbs = dbs; j.K = K; j.N = N; j.lds = lds; j.R = R; j.map = map;
    j.tpb = (K / 64) * ((N + 63) / 64); j.tile0 = tile0; j.gdiv = gdiv; tile0 += j.tpb * nbatch; };
  job(in[26], p.WguT, 1024L * 512, 1024L * 1024, 1024, 512, 512, 1024, 2, 32, in[21], 16);
  job(in[27], p.WguT, 1024L * 512, 1024L * 1024, 1024, 512, 512, 1024, 3, 32, in[21], 16);
  job(in[28], p.WdT, 512L * 1024, 1024L * 512, 512, 1024, 1024, 1024, 0, 32);
  job(in[3], p.WinT, 1024L * 2584, 2816L * 1024, 1024, 2584, 2584, 2816, 1, 2, in[2], 1);
  job(in[14], p.WoutT, 1024L * 1024, 1024L * 1024, 1024, 1024, 1024, 1024, 0, 2);
  job(in[17], p.WqT, 1024L * 1024, 1024L * 1024, 1024, 1024, 1024, 1024, 0, 2, in[15], 1);
  job(in[18], p.WkT, 1024L * 1024, 1024L * 1024, 1024, 1024, 1024, 1024, 0, 2);
  job(in[19], p.WvT, 1024L * 1024, 1024L * 1024, 1024, 1024, 1024, 1024, 0, 2);
  job(in[20], p.WoT, 1024L * 1024, 1024L * 1024, 1024, 1024, 1024, 1024, 0, 2);
  job(in[9], p.W1T, 2048L * 256, 2L * 256 * 2048, 2048, 256, 256, 256, 0, 2);
  job(in[11], p.W1T + 256L * 2048, 2048L * 256, 2L * 256 * 2048, 2048, 256, 256, 256, 0, 2);
  job(in[22], p.WrT, 1024L * 4, 256L * 1024, 1024, 4, 4, 256, 0, 2, in[21], 1);
  job(in[24], p.WrT + 4L * 32, 1024L * 16, 256L * 1024, 1024, 16, 16, 256, 0, 2, in[21], 1);
  p.ttiles = tile0; p.never = 0;
  static int grid_blocks = 0;
  if (!grid_blocks) {
    int dev = 0, cus = 0, per_cu = 0;
    (void)hipGetDevice(&dev);
    (void)hipDeviceGetAttribute(&cus, hipDeviceAttributeMultiprocessorCount, dev);
    if (hipFuncSetAttribute((const void*)fwd_kernel, hipFuncAttributeMaxDynamicSharedMemorySize, LDS_BYTES) != hipSuccess) fprintf(stderr, "hipFuncSetAttribute(dynamic LDS %d) failed\n", LDS_BYTES);
    (void)hipOccupancyMaxActiveBlocksPerMultiprocessor(&per_cu, fwd_kernel, 512, LDS_BYTES);
    (void)hipGetLastError();
    grid_blocks = cus;
  }
  (void)hipMemsetAsync(p.bar, 0, XCD_BAR_WORDS * 4, stream);
  void* args[] = {&p};
  hipError_t e = hipLaunchCooperativeKernel((void*)fwd_kernel, dim3(grid_blocks), dim3(512), args, LDS_BYTES, stream);
  if (e != hipSuccess) fprintf(stderr, "cooperative launch failed: %s (grid %d, ws needed %zu of %zu)\n", hipGetErrorString(e), grid_blocks, off, ws_size);
}
```

```cpp
#define DUPMASK 0
#define FLEXP 0
#define SPINMASK 0ull
#define SPINMUL 8
#define QEXP 0
#include <hip/hip_runtime.h>
#include <hip/hip_cooperative_groups.h>
#include <cstdint>
#include <cstdio>
#include <cstring>
namespace cg = cooperative_groups;

#define LAS __attribute__((address_space(3)))
typedef unsigned short bf16_t;
typedef short bf16x8 __attribute__((ext_vector_type(8)));
typedef short s16x4 __attribute__((ext_vector_type(4)));
typedef float f32x16 __attribute__((ext_vector_type(16)));
typedef float f32x4 __attribute__((ext_vector_type(4)));
typedef float f32x2 __attribute__((ext_vector_type(2)));
typedef unsigned u32x4 __attribute__((ext_vector_type(4)));
typedef unsigned u32x2 __attribute__((ext_vector_type(2)));
typedef __bf16 bf16x2_t __attribute__((ext_vector_type(2)));

#define NTOK 16384
#define SEQ 4096
#define DM 1024
#define PW 2560
#define LOG2E 1.4426950408889634f

__device__ __forceinline__ unsigned cvtpk(float lo, float hi) { f32x2 v = {lo, hi}; bf16x2_t b = __builtin_convertvector(v, bf16x2_t); return __builtin_bit_cast(unsigned, b); }
__device__ __forceinline__ bf16_t f2bf(float x) { return (bf16_t)(cvtpk(x, 0.f) & 0xffffu); }
__device__ __forceinline__ float bf2f(bf16_t b) { return __uint_as_float(((unsigned)b) << 16); }
__device__ __forceinline__ long kbo(long R, long r, int k) { return ((long)(k >> 5) * R + r) * 32 + (k & 31); }
#define HE_ROWS 22528
__device__ __forceinline__ int crow(int r, int hi) { return (r & 3) + 8 * (r >> 2) + 4 * hi; }
__device__ __forceinline__ float fexp2(float x) { return __builtin_amdgcn_exp2f(x); }
extern __shared__ __attribute__((aligned(16))) unsigned char lds_dyn[];
#define LDS_XS 131072
#define LDS_XB 135168
#define LDS_TB 135232
#define LDS_BYTES 135424
__device__ __forceinline__ int otid() { int t = threadIdx.x & 255; asm volatile("" : "+v"(t)); return t; }
__device__ __forceinline__ int otid512() { int t = threadIdx.x; asm volatile("" : "+v"(t)); return t; }
__device__ __forceinline__ int team_id() { return __builtin_amdgcn_readfirstlane((int)(threadIdx.x >> 8)); }
__device__ __forceinline__ int vbid() { return blockIdx.x * 2 + team_id(); }
__device__ __forceinline__ int nvb() { return gridDim.x * 2; }
__device__ __forceinline__ void team_sync() {
  asm volatile("s_waitcnt lgkmcnt(0)" ::: "memory");
  LAS unsigned* ctr = (LAS unsigned*)((LAS char*)lds_dyn + LDS_TB + team_id() * 64);
  unsigned old = 0u;
  if ((threadIdx.x & 63) == 0) old = __hip_atomic_fetch_add(ctr, 1u, __ATOMIC_RELAXED, __HIP_MEMORY_SCOPE_WORKGROUP);
  old = __builtin_amdgcn_readfirstlane(old);
  const unsigned tgt = (old & ~3u) + 4u;
  while ((int)(__hip_atomic_load(ctr, __ATOMIC_RELAXED, __HIP_MEMORY_SCOPE_WORKGROUP) - tgt) < 0) __builtin_amdgcn_s_sleep(0);
  asm volatile("" ::: "memory");
}
#define TSYNC() team_sync()
__device__ __forceinline__ float sigmoidf_(float x) { return 1.0f / (1.0f + __expf(-x)); }

struct TJob { const float* src; bf16_t* dst; const float* g; long sbs, dbs; int K, N, lds, R, map, tpb, tile0, gdiv; };
#define NJOBS 13
struct Params {
  const float *x_in, *mem, *mix_g, *fox_b, *pool_w, *pool_scale, *pe_k, *pe_v, *w1k, *w1v, *w2k, *w2v, *gate_b;
  const float *xattn_g, *mem_g, *ffn_g, *rc_b, *rf_b, *final_g;
  float* xw;
  bf16_t *WinT, *WoutT, *WqT, *WkT, *WvT, *WoT, *WguT, *WdT, *W1T, *W2T, *WrT;
  float* bias1;
  bf16_t *hb, *P, *cat, *memn, *Kmem, *Vmem, *hid, *kvc, *qx, *ox, *he;
  float *fgl, *cum, *onsa, *tokw, *hidp, *rpart, *ssq;
  int *mlist, *mcnt, *wq;
  unsigned* selm;
  unsigned* bar;
  TJob jobs[NJOBS];
  int ttiles; int never;
};

#define XB_TMO      128
#define XB_XCNT(j)  (256  + 64 * (j))
#define XB_XSUB(j)  (1280 + 64 * (j))
#define XB_XGEN(j)  (2304 + 64 * (j))
#define XB_TOP      3328
#define XB_TOPGEN   3392
#define XCD_BAR_WORDS 3456
#define XB_SPIN_CAP (1u << 22)
__device__ __forceinline__ unsigned xb_ld(unsigned* p)              { return __hip_atomic_load(p, __ATOMIC_RELAXED, __HIP_MEMORY_SCOPE_AGENT); }
__device__ __forceinline__ unsigned xb_add(unsigned* p, unsigned v) { return __hip_atomic_fetch_add(p, v, __ATOMIC_RELAXED, __HIP_MEMORY_SCOPE_AGENT); }
__device__ __forceinline__ unsigned xb_xcc_id() { return (unsigned)__builtin_amdgcn_s_getreg((3 << 11) | 20) & 0xFu; }
#define XB_SPIN(cond, bar) do { unsigned _sp = 0; while (cond) { __builtin_amdgcn_s_sleep(1); \
    if ((++_sp & 255u) == 0u) { if (xb_ld(&(bar)[XB_TMO])) break; if (_sp > XB_SPIN_CAP) { atomicAdd(&(bar)[XB_TMO], 1u); break; } } } } while (0)
struct XcdBarrier { unsigned* bar; unsigned x; volatile LAS unsigned* st; };
__device__ __forceinline__ XcdBarrier xcd_barrier_post(unsigned* bar, volatile LAS unsigned* st) {
    XcdBarrier b; b.bar = bar; b.x = xb_xcc_id(); b.st = st;
    if (threadIdx.x == 0) (void)xb_add(&bar[XB_XCNT(b.x)], 1u);
    return b;
}
__device__ __forceinline__ void xcd_barrier_complete(unsigned* bar, unsigned x, unsigned& nloc, unsigned& nx) {
    const unsigned G = gridDim.x * gridDim.y * gridDim.z;
    unsigned sum, cnt, mine, sp = 0u;
    for (;;) {
        sum = 0u; cnt = 0u; mine = 0u;
#pragma unroll
        for (unsigned j = 0; j < 16; ++j) { const unsigned c = xb_ld(&bar[XB_XCNT(j)]); sum += c; cnt += (c > 0u) ? 1u : 0u; mine = (j == x) ? c : mine; }
        if (sum == G) break;
        __builtin_amdgcn_s_sleep(1);
        if ((++sp & 255u) == 0u) { if (xb_ld(&bar[XB_TMO])) break; if (sp > XB_SPIN_CAP) { atomicAdd(&bar[XB_TMO], 1u); break; } }
    }
    nloc = mine > 0u ? mine : 1u; nx = cnt > 0u ? cnt : 1u;
}
__device__ __forceinline__ void xcd_barrier(const XcdBarrier& b) {
    asm volatile("s_waitcnt vmcnt(0)" ::: "memory");
    __syncthreads();
    if (threadIdx.x == 0) {
        unsigned* bar = b.bar;
        unsigned bx = __builtin_amdgcn_readfirstlane(b.x); asm volatile("" : "+s"(bx));
        __builtin_amdgcn_s_waitcnt(0);
        unsigned nloc = b.st[0], nx = b.st[1];
        if (nloc == 0u) { xcd_barrier_complete(bar, bx, nloc, nx); b.st[0] = nloc; b.st[1] = nx; }
        const unsigned old = xb_add(&bar[XB_XSUB(bx)], 1u);
        const unsigned gen = old / nloc;
        if (old + 1u == (gen + 1u) * nloc) {
            __builtin_amdgcn_fence(__ATOMIC_RELEASE, "agent");
            asm volatile("s_waitcnt vmcnt(0)" ::: "memory");
            const unsigned og = xb_add(&bar[XB_TOP], 1u);
            const unsigned tg = og / nx;
            if (og + 1u == (tg + 1u) * nx) xb_add(&bar[XB_TOPGEN], 1u);
            else XB_SPIN(xb_ld(&bar[XB_TOPGEN]) == tg, bar);
            __builtin_amdgcn_fence(__ATOMIC_ACQUIRE, "agent");
            xb_add(&bar[XB_XGEN(bx)], 1u);
            asm volatile("s_waitcnt vmcnt(0)" ::: "memory");
        } else {
            XB_SPIN(xb_ld(&bar[XB_XGEN(bx)]) == gen, bar);
            __builtin_amdgcn_fence(__ATOMIC_ACQUIRE, "agent");
            asm volatile("s_waitcnt vmcnt(0)" ::: "memory");
        }
    }
    __syncthreads();
}

__device__ __forceinline__ int nmap(int map, int n) {
  if (map == 1) { if (n < 1152) return n; if (n < 1158) return 2560 + (n - 1152); if (n < 2566) return n - 6; return n; }
  if (map == 2) return 64 * (n >> 5) + (n & 31);
  if (map == 3) return 64 * (n >> 5) + 32 + (n & 31);
  return n;
}
__device__ __forceinline__ void tt_load(const TJob& j, int t, f32x4 (&v)[4]) {
  const int tid = otid();
  const int tb = t / j.tpb, tt = t - tb * j.tpb;
  const int nkt = j.K >> 6;
  const int kt = tt % nkt, nt = tt / nkt;
  const float* src = j.src + (long)tb * j.sbs + (long)(kt * 64) * j.lds + nt * 64;
  const int tk = tid >> 4, tn4 = tid & 15;
  const bool ok = (nt * 64 + tn4 * 4) < j.N;
#pragma unroll
  for (int i = 0; i < 4; ++i) { v[i] = (f32x4){0.f, 0.f, 0.f, 0.f}; if (ok) v[i] = *(const f32x4*)(src + (long)(tk + 16 * i) * j.lds + tn4 * 4); }
  if (j.g) {
#pragma unroll
    for (int i = 0; i < 4; ++i) v[i] *= j.g[(tb / j.gdiv) * DM + kt * 64 + tk + 16 * i];
  }
}
__device__ __forceinline__ void tt_finish(const TJob& j, int t, const f32x4 (&v)[4], LAS char* sm) {
  const int tid = otid();
  const int tb = t / j.tpb, tt = t - tb * j.tpb;
  const int nkt = j.K >> 6;
  const int kt = tt % nkt, nt = tt / nkt;
  bf16_t* dst = j.dst + (long)tb * j.dbs;
  LAS float* tile = (LAS float*)sm;
  {
    const int tk = tid >> 4, tn4 = tid & 15;
#pragma unroll
    for (int i = 0; i < 4; ++i) { const int k = tk + 16 * i;
      tile[k * 65 + tn4 * 4 + 0] = v[i][0]; tile[k * 65 + tn4 * 4 + 1] = v[i][1]; tile[k * 65 + tn4 * 4 + 2] = v[i][2]; tile[k * 65 + tn4 * 4 + 3] = v[i][3]; }
  }
  TSYNC();
  {
    const int n = tid >> 2, kq = tid & 3, ng = nt * 64 + n;
    if (ng < j.N) {
      const int row = nmap(j.map, ng);
      unsigned w[8];
#pragma unroll
      for (int c = 0; c < 8; ++c) w[c] = cvtpk(tile[(kq * 16 + 2 * c) * 65 + n], tile[(kq * 16 + 2 * c + 1) * 65 + n]);
      bf16_t* d = dst + kbo(j.R, row, kt * 64 + kq * 16);
      *(u32x4*)d = (u32x4){w[0], w[1], w[2], w[3]};
      *(u32x4*)(d + 8) = (u32x4){w[4], w[5], w[6], w[7]};
    }
  }
  TSYNC();
}

template <bool F32OUT>
__device__ __forceinline__ void rownorm(const float* x, const float* g, void* out, int nrows) {
  const int tid = otid(); const int lane = tid & 63;
  const int gw = vbid() * 4 + (tid >> 6), nw = nvb() * 4;
  for (int row = gw; row < nrows; row += nw) {
    const float* xr = x + (long)row * DM;
    f32x4 v[4]; float ss = 0.f;
#pragma unroll
    for (int i = 0; i < 4; ++i) { v[i] = *(const f32x4*)(xr + i * 256 + lane * 4); ss += v[i][0] * v[i][0] + v[i][1] * v[i][1] + v[i][2] * v[i][2] + v[i][3] * v[i][3]; }
#pragma unroll
    for (int o = 32; o >= 1; o >>= 1) ss += __shfl_xor(ss, o);
    const float rstd = 1.0f / sqrtf(ss * (1.0f / DM) + 1e-6f);
#pragma unroll
    for (int i = 0; i < 4; ++i) {
      const f32x4 gg = *(const f32x4*)(g + i * 256 + lane * 4);
      const f32x4 y = v[i] * rstd * gg;
      if (F32OUT) *(f32x4*)((float*)out + (long)row * DM + i * 256 + lane * 4) = y;
      else { u32x2 w; w.x = cvtpk(y[0], y[1]); w.y = cvtpk(y[2], y[3]); *(u32x2*)((bf16_t*)out + kbo(nrows, row, i * 256 + lane * 4)) = w; }
    }
  }
}

__device__ __forceinline__ float row_rstd(const float* ssq, long row) {
  const f32x4 a = *(const f32x4*)(ssq + row * 16), b = *(const f32x4*)(ssq + row * 16 + 4), c = *(const f32x4*)(ssq + row * 16 + 8), d = *(const f32x4*)(ssq + row * 16 + 12);
  const float t = ((a[0] + a[1]) + (a[2] + a[3])) + ((b[0] + b[1]) + (b[2] + b[3])) + ((c[0] + c[1]) + (c[2] + c[3])) + ((d[0] + d[1]) + (d[2] + d[3]));
  return 1.0f / sqrtf(t * (1.0f / DM) + 1e-6f);
}
__device__ __forceinline__ void rowprep(const float* x, bf16_t* xb, float* ssq, int nrows) {
  const int tid = otid(); const int lane = tid & 63;
  const int gw = vbid() * 4 + (tid >> 6), nw = nvb() * 4;
  for (int row = gw; row < nrows; row += nw) {
    const float* xr = x + (long)row * DM;
    f32x4 v[4]; float ss = 0.f;
#pragma unroll
    for (int i = 0; i < 4; ++i) { v[i] = *(const f32x4*)(xr + i * 256 + lane * 4); ss += v[i][0] * v[i][0] + v[i][1] * v[i][1] + v[i][2] * v[i][2] + v[i][3] * v[i][3]; }
#pragma unroll
    for (int o = 32; o >= 1; o >>= 1) ss += __shfl_xor(ss, o);
#pragma unroll
    for (int i = 0; i < 4; ++i) { u32x2 w; w.x = cvtpk(v[i][0], v[i][1]); w.y = cvtpk(v[i][2], v[i][3]); *(u32x2*)(xb + kbo(NTOK, row, i * 256 + lane * 4)) = w; }
    if (lane < 16) ssq[(long)row * 16 + lane] = lane == 0 ? ss : 0.f;
  }
}
struct RowKB { const bf16_t* base; long R; int r0; int s0;
  __device__ __forceinline__ const bf16_t* bptr() const { return base; }
  __device__ __forceinline__ unsigned rowoff(int r) const { return (unsigned)((r0 + r) * 32); }
  __device__ __forceinline__ long soff(int s) const { return (long)(s0 + s) * R * 32; } };
struct RowGather { const bf16_t* base; long R; LAS const int* toks;
  __device__ __forceinline__ const bf16_t* bptr() const { return base; }
  __device__ __forceinline__ unsigned rowoff(int r) const { int t = toks[r]; t = t < 0 ? 0 : t; return (unsigned)(t * 32); }
  __device__ __forceinline__ long soff(int s) const { return (long)s * R * 32; } };
struct RowCmp { const bf16_t* base; int r0; int kt0;
  __device__ __forceinline__ const bf16_t* bptr() const { return base; }
  __device__ __forceinline__ unsigned rowoff(int r) const { const int R = r0 + r; const int bg = R >> 8; int c = R & 255; c = c > 254 ? 254 : c;
    return (unsigned)(((bg >> 1) * SEQ + 16 * c) * PW + (bg & 1) * 64); }
  __device__ __forceinline__ long soff(int s) const { return (long)(kt0 + (s >> 1)) * PW + (s & 1) * 32; } };
struct RowSplitKB { const bf16_t* base; long R; int r0; long delta;
  __device__ __forceinline__ const bf16_t* bptr() const { return base; }
  __device__ __forceinline__ unsigned rowoff(int r) const { return (unsigned)((r0 + r) * 32); }
  __device__ __forceinline__ long soff(int s) const { return s < 16 ? (long)s * R * 32 : delta + (long)(s - 16) * R * 32; } };
__device__ __forceinline__ float gelu_tanh(float x) { const float u = 0.7978845608028654f * (x + 0.044715f * x * x * x); return 0.5f * x * (1.0f + tanhf(u)); }
__device__ __forceinline__ void finalnorm(const bf16_t* xb, const float* ssq, const float* g, float* out, int nrows) {
  const int tid = otid(); const int lane = tid & 63;
  const int gw = vbid() * 4 + (tid >> 6), nw = nvb() * 4;
  for (int row = gw; row < nrows; row += nw) {
    const float rs = row_rstd(ssq, row);
#pragma unroll
    for (int i = 0; i < 2; ++i) {
      const u32x4 w = *(const u32x4*)(xb + kbo(NTOK, row, i * 512 + lane * 8));
      const f32x4 g0 = *(const f32x4*)(g + i * 512 + lane * 8), g1 = *(const f32x4*)(g + i * 512 + lane * 8 + 4);
      float* op = out + (long)row * DM + i * 512 + lane * 8;
      *(f32x4*)op = (f32x4){__uint_as_float(w.x << 16) * rs * g0[0], __uint_as_float(w.x & 0xffff0000u) * rs * g0[1], __uint_as_float(w.y << 16) * rs * g0[2], __uint_as_float(w.y & 0xffff0000u) * rs * g0[3]};
      *(f32x4*)(op + 4) = (f32x4){__uint_as_float(w.z << 16) * rs * g1[0], __uint_as_float(w.z & 0xffff0000u) * rs * g1[1], __uint_as_float(w.w << 16) * rs * g1[2], __uint_as_float(w.w & 0xffff0000u) * rs * g1[3]};
    }
  }
}
#define GT_WAITBAR(N) asm volatile("s_waitcnt vmcnt(" #N ")\n\ts_barrier" ::: "memory")
template <class AF, class BF, class EPI, int EXPM = 0>
__device__ __forceinline__ void gemm_tile(LAS char* sm, int nkt, const AF& af, const BF& bfn, const EPI& epi) {
  const int tid = otid512(), lane = tid & 63, wid = __builtin_amdgcn_readfirstlane(tid >> 6), wm = wid >> 2, wn = wid & 3, l31 = lane & 31, hh = lane >> 5;
  const int lrow = tid >> 2;
  const int lkc = (tid & 3) ^ ((tid >> 4) & 3);
  unsigned ao[2], bo[2];
#pragma unroll
  for (int i = 0; i < 2; ++i) { ao[i] = (af.rowoff(lrow + 128 * i) + lkc * 8) * 2u; bo[i] = (bfn.rowoff(lrow + 128 * i) + lkc * 8) * 2u; }
  const char* abase = (const char*)af.bptr(); const char* bbase = (const char*)bfn.bptr();
  const int swz = (l31 >> 2) & 3;
  const int koff0 = ((hh ^ swz) << 4), koff1 = (((2 + hh) ^ swz) << 4);
  const int arow = (wm * 128 + l31) * 64, brow = 16384 + (wn * 64 + l31) * 64;
  f32x16 acc[4][2];
#pragma unroll
  for (int i = 0; i < 4; ++i)
#pragma unroll
    for (int j = 0; j < 2; ++j)
#pragma unroll
      for (int r = 0; r < 16; ++r) acc[i][j][r] = 0.f;
  LAS char* dst0 = sm + wid * 1024;
#define GT_ISSUE(st_) do { const int s__ = (st_); const long ka_ = af.soff(s__) * 2, kb_ = bfn.soff(s__) * 2; LAS char* d_ = dst0 + (s__ & 3) * 32768; \
    _Pragma("unroll") for (int i = 0; i < 2; ++i) { \
      __builtin_amdgcn_global_load_lds((const unsigned*)(abase + ka_ + ao[i]), (LAS unsigned*)(d_ + i * 8192), 16, 0, 0); \
      __builtin_amdgcn_global_load_lds((const unsigned*)(bbase + kb_ + bo[i]), (LAS unsigned*)(d_ + 16384 + i * 8192), 16, 0, 0); } } while (0)
  const int nst = 2 * nkt;
  __syncthreads();
  if (!(EXPM & 1)) { GT_ISSUE(0); GT_ISSUE(1); GT_ISSUE(2); }
  for (int st = 0; st < nst; ++st) {
    if (st + 2 < nst) GT_WAITBAR(8); else if (st + 1 < nst) GT_WAITBAR(4); else GT_WAITBAR(0);
    if (st + 3 < nst && !(EXPM & 1)) GT_ISSUE(st + 3);
    const int cur = (st & 3) * 32768;
#pragma unroll
    for (int s2 = 0; s2 < 2; ++s2) {
      const int ko = s2 ? koff1 : koff0;
      bf16x8 af4[4], bf2[2];
#pragma unroll
      for (int i = 0; i < 4; ++i) af4[i] = *(LAS const bf16x8*)(sm + cur + arow + i * 2048 + ko);
#pragma unroll
      for (int j = 0; j < 2; ++j) bf2[j] = *(LAS const bf16x8*)(sm + cur + brow + j * 2048 + ko);
#pragma unroll
      for (int i = 0; i < 4; ++i)
#pragma unroll
        for (int j = 0; j < 2; ++j) acc[i][j] = __builtin_amdgcn_mfma_f32_32x32x16_bf16(bf2[j], af4[i], acc[i][j], 0, 0, 0);
    }
  }
#undef GT_ISSUE
  if (!(EXPM & 2)) epi(acc, wm, wn, lane);
}

struct EpiInproj { bf16_t* P; float* fgl; const float* ssq; int mt, nt;
  __device__ __forceinline__ void operator()(f32x16 (&acc)[4][2], int wm, int wn, int lane) const {
    const int l31 = lane & 31, hh = lane >> 5;
#pragma unroll
    for (int i = 0; i < 4; ++i) {
      const long row = mt * 256 + wm * 128 + i * 32 + l31;
      const float rs = row_rstd(ssq, row);
#pragma unroll
      for (int j = 0; j < 2; ++j)
#pragma unroll
        for (int a = 0; a < 4; ++a) {
          const int col = nt * 256 + wn * 64 + j * 32 + 8 * a + 4 * hh;
          const f32x4 v = (f32x4){acc[i][j][4 * a] * rs, acc[i][j][4 * a + 1] * rs, acc[i][j][4 * a + 2] * rs, acc[i][j][4 * a + 3] * rs};
          if (nt < 10) { u32x2 w; w.x = cvtpk(v[0], v[1]); w.y = cvtpk(v[2], v[3]); *(u32x2*)(P + row * PW + col) = w; }
          else { const int c = col - 2560; if (c < 24) *(f32x4*)(fgl + row * 32 + c) = v; }
        }
    }
  } };
struct EpiBf16 { bf16_t* out; long ld; int row0, col0; const float* ssq;
  __device__ __forceinline__ void operator()(f32x16 (&acc)[4][2], int wm, int wn, int lane) const {
    const int l31 = lane & 31, hh = lane >> 5;
#pragma unroll
    for (int i = 0; i < 4; ++i) {
      const long row = row0 + wm * 128 + i * 32 + l31;
      const float rs = ssq ? row_rstd(ssq, row) : 1.0f;
      bf16_t* rp = out + row * ld + col0 + wn * 64 + 4 * hh;
#pragma unroll
      for (int j = 0; j < 2; ++j)
#pragma unroll
        for (int a = 0; a < 4; ++a) { u32x2 w; w.x = cvtpk(acc[i][j][4 * a] * rs, acc[i][j][4 * a + 1] * rs); w.y = cvtpk(acc[i][j][4 * a + 2] * rs, acc[i][j][4 * a + 3] * rs); *(u32x2*)(rp + j * 32 + 8 * a) = w; }
    }
  } };
struct EpiF32 { float* out; long ld; int row0, col0;
  __device__ __forceinline__ void operator()(f32x16 (&acc)[4][2], int wm, int wn, int lane) const {
    const int l31 = lane & 31, hh = lane >> 5;
#pragma unroll
    for (int i = 0; i < 4; ++i) {
      float* rp = out + (long)(row0 + wm * 128 + i * 32 + l31) * ld + col0 + wn * 64 + 4 * hh;
#pragma unroll
      for (int j = 0; j < 2; ++j)
#pragma unroll
        for (int a = 0; a < 4; ++a) *(f32x4*)(rp + j * 32 + 8 * a) = (f32x4){acc[i][j][4 * a], acc[i][j][4 * a + 1], acc[i][j][4 * a + 2], acc[i][j][4 * a + 3]};
    }
  } };
struct EpiResid { const float* basef; bf16_t* xb; float* ssq; int row0, col0;
  __device__ __forceinline__ void operator()(f32x16 (&acc)[4][2], int wm, int wn, int lane) const {
    const int l31 = lane & 31, hh = lane >> 5;
#pragma unroll
    for (int i = 0; i < 4; ++i) {
      const long row = row0 + wm * 128 + i * 32 + l31;
      const int c0 = col0 + wn * 64 + 4 * hh; const long o0 = row * DM + c0;
      float sq = 0.f;
#pragma unroll
      for (int j = 0; j < 2; ++j) {
        f32x4 bv[4];
        if (basef) {
#pragma unroll
          for (int a = 0; a < 4; ++a) bv[a] = *(const f32x4*)(basef + o0 + j * 32 + 8 * a);
        } else {
#pragma unroll
          for (int a = 0; a < 4; ++a) { const u32x2 w = *(const u32x2*)(xb + kbo(NTOK, row, c0 + j * 32 + 8 * a));
            bv[a] = (f32x4){__uint_as_float(w.x << 16), __uint_as_float(w.x & 0xffff0000u), __uint_as_float(w.y << 16), __uint_as_float(w.y & 0xffff0000u)}; }
        }
#pragma unroll
        for (int a = 0; a < 4; ++a) { u32x2 w; w.x = cvtpk(bv[a][0] + acc[i][j][4 * a], bv[a][1] + acc[i][j][4 * a + 1]); w.y = cvtpk(bv[a][2] + acc[i][j][4 * a + 2], bv[a][3] + acc[i][j][4 * a + 3]);
          *(u32x2*)(xb + kbo(NTOK, row, c0 + j * 32 + 8 * a)) = w;
          const float v0 = __uint_as_float(w.x << 16), v1 = __uint_as_float(w.x & 0xffff0000u), v2 = __uint_as_float(w.y << 16), v3 = __uint_as_float(w.y & 0xffff0000u);
          sq += (v0 * v0 + v1 * v1) + (v2 * v2 + v3 * v3); }
      }
      sq += __shfl_xor(sq, 32);
      if (hh == 0) ssq[row * 16 + (col0 >> 6) + wn] = sq;
      __builtin_amdgcn_sched_barrier(0);
    }
  } };
struct EpiMoeUp { bf16_t* he; long herow0; int hcol0; LAS const float* wts; LAS const float* rsd;
  __device__ __forceinline__ void operator()(f32x16 (&acc)[4][2], int wm, int wn, int lane) const {
    const int l31 = lane & 31, hh = lane >> 5;
#pragma unroll
    for (int i = 0; i < 4; ++i) {
      const int rl = wm * 128 + i * 32 + l31; const float wt = wts[rl]; const float rs = rsd[rl];
      const long hrow = herow0 + rl; const int hc0 = hcol0 + wn * 32 + 4 * hh;
#pragma unroll
      for (int a = 0; a < 4; ++a) {
        float v[4];
#pragma unroll
        for (int e = 0; e < 4; ++e) { const float gte = acc[i][0][4 * a + e] * rs, up = acc[i][1][4 * a + e] * rs; v[e] = gte * sigmoidf_(gte) * up * wt; }
        u32x2 w; w.x = cvtpk(v[0], v[1]); w.y = cvtpk(v[2], v[3]); *(u32x2*)(he + kbo(HE_ROWS, hrow, hc0 + 8 * a)) = w;
      }
      __builtin_amdgcn_sched_barrier(0);
    }
  } };
struct EpiMoeDown { bf16_t* xb; float* ssq; int col0; LAS const int* toks;
  __device__ __forceinline__ void operator()(f32x16 (&acc)[4][2], int wm, int wn, int lane) const {
    const int l31 = lane & 31, hh = lane >> 5;
#pragma unroll
    for (int i = 0; i < 4; ++i) {
      const int tok = toks[wm * 128 + i * 32 + l31];
      const long trow = tok < 0 ? 0 : tok; const int c0 = col0 + wn * 64 + 4 * hh;
      float sq = 0.f;
#pragma unroll
      for (int j = 0; j < 2; ++j) {
        u32x2 bw[4];
#pragma unroll
        for (int a = 0; a < 4; ++a) bw[a] = *(const u32x2*)(xb + kbo(NTOK, trow, c0 + j * 32 + 8 * a));
#pragma unroll
        for (int a = 0; a < 4; ++a) {
          u32x2 w; w.x = cvtpk(__uint_as_float(bw[a].x << 16) + acc[i][j][4 * a], __uint_as_float(bw[a].x & 0xffff0000u) + acc[i][j][4 * a + 1]);
          w.y = cvtpk(__uint_as_float(bw[a].y << 16) + acc[i][j][4 * a + 2], __uint_as_float(bw[a].y & 0xffff0000u) + acc[i][j][4 * a + 3]);
          if (tok >= 0) *(u32x2*)(xb + kbo(NTOK, trow, c0 + j * 32 + 8 * a)) = w;
          const float v0 = __uint_as_float(w.x << 16), v1 = __uint_as_float(w.x & 0xffff0000u), v2 = __uint_as_float(w.y << 16), v3 = __uint_as_float(w.y & 0xffff0000u);
          sq += (v0 * v0 + v1 * v1) + (v2 * v2 + v3 * v3); }
      }
      sq += __shfl_xor(sq, 32);
      if (hh == 0 && tok >= 0) ssq[(long)tok * 16 + (col0 >> 6) + wn] = sq;
      __builtin_amdgcn_sched_barrier(0);
    }
  } };
struct EpiRouterPart { float* part; int row0;
  __device__ __forceinline__ void operator()(f32x16 (&acc)[4][2], int wm, int wn, int lane) const {
    const int l31 = lane & 31, hh = lane >> 5;
    if (wn != 0) return;
#pragma unroll
    for (int i = 0; i < 4; ++i) {
      float* rp = part + (long)(row0 + wm * 128 + i * 32 + l31) * 32 + 4 * hh;
#pragma unroll
      for (int a = 0; a < 3; ++a) *(f32x4*)(rp + 8 * a) = (f32x4){acc[i][0][4 * a], acc[i][0][4 * a + 1], acc[i][0][4 * a + 2], acc[i][0][4 * a + 3]};
    }
  } };

template <int NKS> __device__ __forceinline__ int kswz(int kc, int row) {
  if (NKS == 4) return kc ^ ((row >> 1) & 7);
  return (kc & 16) | ((kc & 15) ^ (row & 15));
}
__device__ __forceinline__ void qk_tile64(f32x16& p0, f32x16& p1, const bf16x8* qf, LAS const char* Ks, int lane) {
  const int l31 = lane & 31, hh = lane >> 5;
#pragma unroll
  for (int r = 0; r < 16; ++r) { p0[r] = 0.f; p1[r] = 0.f; }
#pragma unroll
  for (int ds = 0; ds < 4; ++ds) {
    const int so = kswz<4>(2 * ds + hh, l31) << 4;
    const bf16x8 k0 = *(LAS const bf16x8*)(Ks + l31 * 128 + so);
    const bf16x8 k1 = *(LAS const bf16x8*)(Ks + (32 + l31) * 128 + so);
    p0 = __builtin_amdgcn_mfma_f32_32x32x16_bf16(k0, qf[ds], p0, 0, 0, 0);
    p1 = __builtin_amdgcn_mfma_f32_32x32x16_bf16(k1, qf[ds], p1, 0, 0, 0);
  }
}
__device__ __forceinline__ void qk_tile256(f32x16& p0, f32x16& p1, const bf16x8* qf, LAS const char* Ks, int lane) {
  const int l31 = lane & 31, hh = lane >> 5;
#pragma unroll
  for (int r = 0; r < 16; ++r) { p0[r] = 0.f; p1[r] = 0.f; }
#pragma unroll
  for (int ds = 0; ds < 16; ++ds) {
    const int so = kswz<16>(2 * ds + hh, l31) << 4;
    const bf16x8 k0 = *(LAS const bf16x8*)(Ks + l31 * 512 + so);
    const bf16x8 k1 = *(LAS const bf16x8*)(Ks + (32 + l31) * 512 + so);
    p0 = __builtin_amdgcn_mfma_f32_32x32x16_bf16(k0, qf[ds], p0, 0, 0, 0);
    p1 = __builtin_amdgcn_mfma_f32_32x32x16_bf16(k1, qf[ds], p1, 0, 0, 0);
  }
}
template <int NDT>
__device__ __forceinline__ void softmax_tile(f32x16& p0, f32x16& p1, float& m, float& l, f32x16* O, bf16x8* pb) {
  float mx = fmaxf(p0[0], p1[0]);
#pragma unroll
  for (int r = 1; r < 16; ++r) mx = fmaxf(mx, fmaxf(p0[r], p1[r]));
  mx = fmaxf(mx, __shfl_xor(mx, 32));
  if (__builtin_amdgcn_ballot_w64(mx > m) != 0ull) {
    const float mn = fmaxf(m, mx);
    const float mu = (mn == -INFINITY) ? 0.f : mn;
    const float alpha = fexp2(m - mu);
    l *= alpha; m = mn;
#pragma unroll
    for (int dt = 0; dt < NDT; ++dt)
#pragma unroll
      for (int r = 0; r < 16; ++r) O[dt][r] *= alpha;
  }
  const float mu = (m == -INFINITY) ? 0.f : m;
  float rs = 0.f;
#pragma unroll
  for (int r = 0; r < 16; ++r) { p0[r] = fexp2(p0[r] - mu); rs += p0[r]; }
#pragma unroll
  for (int r = 0; r < 16; ++r) { p1[r] = fexp2(p1[r] - mu); rs += p1[r]; }
  l += rs;
  u32x4 w;
  w = (u32x4){cvtpk(p0[0], p0[1]), cvtpk(p0[2], p0[3]), cvtpk(p0[4], p0[5]), cvtpk(p0[6], p0[7])}; pb[0] = __builtin_bit_cast(bf16x8, w);
  w = (u32x4){cvtpk(p0[8], p0[9]), cvtpk(p0[10], p0[11]), cvtpk(p0[12], p0[13]), cvtpk(p0[14], p0[15])}; pb[1] = __builtin_bit_cast(bf16x8, w);
  w = (u32x4){cvtpk(p1[0], p1[1]), cvtpk(p1[2], p1[3]), cvtpk(p1[4], p1[5]), cvtpk(p1[6], p1[7])}; pb[2] = __builtin_bit_cast(bf16x8, w);
  w = (u32x4){cvtpk(p1[8], p1[9]), cvtpk(p1[10], p1[11]), cvtpk(p1[12], p1[13]), cvtpk(p1[14], p1[15])}; pb[3] = __builtin_bit_cast(bf16x8, w);
}
template <int NDT>
__device__ __forceinline__ void pv_tile(f32x16* O, const bf16x8* pb, LAS const char* Vs, int lane) {
  const int hh = lane >> 5;
  const int vlane = (4 * hh + ((lane & 15) >> 2)) * 64 + (((lane >> 4) & 1) * 16 + (lane & 3) * 4) * 2;
#pragma unroll
  for (int dt = 0; dt < NDT; dt += 2) {
    s16x4 lo[2][4], hi[2][4];
#pragma unroll
    for (int d2 = 0; d2 < 2; ++d2)
#pragma unroll
      for (int ks = 0; ks < 4; ++ks) {
        LAS const char* vp = Vs + (dt + d2) * 4096 + ks * 16 * 64 + vlane;
        lo[d2][ks] = __builtin_amdgcn_ds_read_tr16_b64_v4i16((LAS s16x4*)vp);
        hi[d2][ks] = __builtin_amdgcn_ds_read_tr16_b64_v4i16((LAS s16x4*)(vp + 8 * 64));
      }
    __builtin_amdgcn_sched_barrier(0);
#pragma unroll
    for (int ks = 0; ks < 4; ++ks)
#pragma unroll
      for (int d2 = 0; d2 < 2; ++d2) {
        const bf16x8 vf = (bf16x8){lo[d2][ks][0], lo[d2][ks][1], lo[d2][ks][2], lo[d2][ks][3], hi[d2][ks][0], hi[d2][ks][1], hi[d2][ks][2], hi[d2][ks][3]};
        O[dt + d2] = __builtin_amdgcn_mfma_f32_32x32x16_bf16(vf, pb[ks], O[dt + d2], 0, 0, 0);
      }
  }
}
struct TLRange { int n, kv_last; __device__ __forceinline__ int count() const { return n; } __device__ __forceinline__ int kv0(int i) const { return kv_last - 64 * i; } };
struct TLList { int n; LAS const int* lst; __device__ __forceinline__ int count() const { return n; } __device__ __forceinline__ int kv0(int i) const { return lst[i]; } };

struct SMFox { float cq; const float* ck; int tq; int tqmax;
  static constexpr bool EXTRA = true;
  __device__ __forceinline__ bool active(int kv0) const { return kv0 <= tqmax; }
  __device__ __forceinline__ bool full(int kv0) const { return kv0 + 63 <= tqmax - 31; }
  __device__ __forceinline__ const float* xsrc(int kv0, int lane) const { return ck + kv0 + lane; }
  template <bool MASK> __device__ __forceinline__ void apply(f32x16& p0, f32x16& p1, int kv0, int lane, LAS const char* xs_) const {
    const int hh = lane >> 5; const float C = 0.125f * LOG2E;
    const int db = tq - kv0 - 4 * hh;
    LAS const float* cp = (LAS const float*)xs_ + 4 * hh;
#pragma unroll
    for (int a = 0; a < 4; ++a) {
      const f32x4 c0 = *(LAS const f32x4*)(cp + 8 * a);
      const f32x4 c1 = *(LAS const f32x4*)(cp + 32 + 8 * a);
#pragma unroll
      for (int e = 0; e < 4; ++e) {
        const int c = 8 * a + e;
        const float s0 = __builtin_fmaf(p0[4 * a + e], C, cq - c0[e]), s1 = __builtin_fmaf(p1[4 * a + e], C, cq - c1[e]);
        p0[4 * a + e] = (!MASK || db >= c) ? s0 : -INFINITY;
        p1[4 * a + e] = (!MASK || db >= c + 32) ? s1 : -INFINITY;
      }
    }
  } };
struct SMWin { int tq; float slope2; int tqmax;
  static constexpr bool EXTRA = false;
  __device__ __forceinline__ const float* xsrc(int, int) const { return nullptr; }
  __device__ __forceinline__ bool active(int kv0) const { return kv0 <= tqmax && kv0 + 63 + 512 > tqmax - 31; }
  __device__ __forceinline__ bool full(int kv0) const { return kv0 + 63 <= tqmax - 31 && tqmax - kv0 < 512; }
  template <bool MASK> __device__ __forceinline__ void apply(f32x16& p0, f32x16& p1, int kv0, int lane, LAS const char*) const {
    const int hh = lane >> 5; const float C = 0.125f * LOG2E;
    const int db = tq - kv0 - 4 * hh; const float sb = -slope2 * (float)db;
#pragma unroll
    for (int r = 0; r < 16; ++r) {
      const int c = (r & 3) + 8 * (r >> 2);
      const int d0 = db - c, d1 = db - c - 32;
      const float s0 = __builtin_fmaf(p0[r], C, __builtin_fmaf(slope2, (float)c, sb)), s1 = __builtin_fmaf(p1[r], C, __builtin_fmaf(slope2, (float)(c + 32), sb));
      p0[r] = (!MASK || (d0 >= 0 && d0 < 512)) ? s0 : -INFINITY;
      p1[r] = (!MASK || (d1 >= 0 && d1 < 512)) ? s1 : -INFINITY;
    }
  } };
struct SMSel { int tq; float slope2; unsigned mlo, mhi; int tqmax;
  static constexpr bool EXTRA = false;
  __device__ __forceinline__ const float* xsrc(int, int) const { return nullptr; }
  __device__ __forceinline__ bool selbit(int kv0) const { const int j = kv0 >> 6; return ((j < 32 ? (mlo >> j) : (mhi >> (j - 32))) & 1u) != 0u; }
  __device__ __forceinline__ bool active(int kv0) const { return kv0 <= tqmax && __builtin_amdgcn_ballot_w64(selbit(kv0)) != 0ull; }
  __device__ __forceinline__ bool full(int kv0) const { return kv0 + 63 <= tqmax - 31 && __builtin_amdgcn_ballot_w64(!selbit(kv0)) == 0ull; }
  template <bool MASK> __device__ __forceinline__ void apply(f32x16& p0, f32x16& p1, int kv0, int lane, LAS const char*) const {
    const int hh = lane >> 5; const float C = 0.125f * LOG2E;
    const int dbr = tq - kv0 - 4 * hh;
    const int db = (!MASK || selbit(kv0)) ? dbr : -1; const float sb = -slope2 * (float)dbr;
#pragma unroll
    for (int r = 0; r < 16; ++r) {
      const int c = (r & 3) + 8 * (r >> 2);
      const float s0 = __builtin_fmaf(p0[r], C, __builtin_fmaf(slope2, (float)c, sb)), s1 = __builtin_fmaf(p1[r], C, __builtin_fmaf(slope2, (float)(c + 32), sb));
      p0[r] = (!MASK || db >= c) ? s0 : -INFINITY;
      p1[r] = (!MASK || db >= c + 32) ? s1 : -INFINITY;
    }
  } };
struct SMCmp { int tq; float slope2; int tqmax;
  static constexpr bool EXTRA = false;
  __device__ __forceinline__ const float* xsrc(int, int) const { return nullptr; }
  __device__ __forceinline__ bool active(int kv0) const { return 16 * kv0 + 31 <= tqmax; }
  __device__ __forceinline__ bool full(int kv0) const { return 16 * (kv0 + 63) + 31 <= tqmax - 31; }
  template <bool MASK> __device__ __forceinline__ void apply(f32x16& p0, f32x16& p1, int kv0, int lane, LAS const char*) const {
    const int hh = lane >> 5; const float C = 0.125f * LOG2E;
    const int db = tq - 31 - 16 * kv0 - 64 * hh; const float sb = -slope2 * (float)db;
#pragma unroll
    for (int r = 0; r < 16; ++r) {
      const int c = 16 * ((r & 3) + 8 * (r >> 2));
      const float s0 = __builtin_fmaf(p0[r], C, __builtin_fmaf(slope2, (float)c, sb)), s1 = __builtin_fmaf(p1[r], C, __builtin_fmaf(slope2, (float)(c + 512), sb));
      p0[r] = (!MASK || db >= c) ? s0 : -INFINITY;
      p1[r] = (!MASK || db >= c + 512) ? s1 : -INFINITY;
    }
  } };

#define FL_STAGE 16896
#define g_flx (((LAS const int*)((LAS const char*)lds_dyn + LDS_XS))[500] != 0)
template <int N> __device__ __forceinline__ void fl_waitbar() {
  if (N == 0) asm volatile("s_waitcnt vmcnt(0)\n\ts_barrier" ::: "memory");
  else if (N == 2) asm volatile("s_waitcnt vmcnt(2)\n\ts_barrier" ::: "memory");
  else if (N == 3) asm volatile("s_waitcnt vmcnt(3)\n\ts_barrier" ::: "memory");
  else if (N == 4) asm volatile("s_waitcnt vmcnt(4)\n\ts_barrier" ::: "memory");
  else asm volatile("s_waitcnt vmcnt(6)\n\ts_barrier" ::: "memory");
}
template <int NSTG, class SM, class TL>
__device__ __forceinline__ void flash_run64(LAS char* sm, const bf16x8* qf, const bf16_t* Kb, long ldk, const bf16_t* Vb, long ldv,
                                            const TL& tl, const SM& smod, float& m, float& l, f32x16* O) {
  const int n = tl.count();
  if (n <= 0) return;
  constexpr int DPT = SM::EXTRA ? 3 : 2;
  const int tid = otid512(), lane = tid & 63, wid = __builtin_amdgcn_readfirstlane(tid >> 6);
  const int krow = tid >> 3;
  const bf16_t* ksrc = Kb + (long)krow * ldk + (((tid & 7) ^ ((krow >> 1) & 7)) * 8);
  const bf16_t* vsrc = Vb + (long)((tid & 255) >> 2) * ldv + (((tid >> 8) * 4 + (tid & 3)) * 8);
  LAS char* kd0 = sm + wid * 1024;
#define FL_ISSUE(i_) do { if ((FLEXP & 16) && g_flx) break; const int i__ = (i_); const int kv__ = tl.kv0(i__); LAS char* d__ = kd0 + (i__ % NSTG) * FL_STAGE; \
    __builtin_amdgcn_global_load_lds((const unsigned*)(ksrc + (long)kv__ * ldk), (LAS unsigned*)d__, 16, 0, 0); \
    __builtin_amdgcn_global_load_lds((const unsigned*)(vsrc + (long)kv__ * ldv), (LAS unsigned*)(d__ + 8192), 16, 0, 0); \
    if (SM::EXTRA) __builtin_amdgcn_global_load_lds((const unsigned*)(smod.xsrc(kv__, lane)), (LAS unsigned*)(sm + (i__ % NSTG) * FL_STAGE + 16384), 4, 0, 0); } while (0)
  __syncthreads();
#pragma unroll
  for (int i = 0; i < NSTG - 1; ++i) if (i < n) FL_ISSUE(i);
  { const int later = min(n - 1, NSTG - 2);
    if (later >= 2) fl_waitbar<2 * DPT>(); else if (later == 1) fl_waitbar<DPT>(); else fl_waitbar<0>(); }
  if (NSTG - 1 < n) FL_ISSUE(NSTG - 1);
  f32x16 pc0, pc1, pn0, pn1;
  int kv_cur = tl.kv0(0);
  bool act_cur = smod.active(kv_cur), act_next = false;
  if (act_cur) qk_tile64(pc0, pc1, qf, sm, lane);
  int st_cur = 0;
  for (int it = 0; it < n; ++it) {
    const int st_next = st_cur == NSTG - 1 ? 0 : st_cur + 1;
    int kv_next = 0;
    if (it + 1 < n) {
      kv_next = tl.kv0(it + 1);
      const int later = min(n - 1, it + NSTG - 2) - (it + 1);
      if (!((FLEXP & 32) && g_flx)) { if (NSTG >= 4 && later >= 1) fl_waitbar<DPT>(); else fl_waitbar<0>(); }
      if (it + NSTG - 1 < n && it > 0) FL_ISSUE(it + NSTG - 1);
    }
    act_next = false;
    if (it + 1 < n) { act_next = smod.active(kv_next); if (act_next) { if ((FLEXP & 8) && g_flx) { pn0 = pc0; pn1 = pc1; } else qk_tile64(pn0, pn1, qf, sm + st_next * FL_STAGE, lane); } }
    if (act_cur) {
      LAS const char* sb_ = sm + st_cur * FL_STAGE;
      if (!((FLEXP & 4) && g_flx)) { if (smod.full(kv_cur)) smod.template apply<false>(pc0, pc1, kv_cur, lane, sb_ + 16384); else smod.template apply<true>(pc0, pc1, kv_cur, lane, sb_ + 16384); }
      bf16x8 pb[4];
      if ((FLEXP & 1) && g_flx) { u32x4 w_ = {cvtpk(pc0[0], pc0[1]), cvtpk(pc0[2], pc0[3]), cvtpk(pc1[0], pc1[1]), cvtpk(pc1[2], pc1[3])}; pb[0] = pb[1] = pb[2] = pb[3] = __builtin_bit_cast(bf16x8, w_); }
      else softmax_tile<2>(pc0, pc1, m, l, O, pb);
      if ((FLEXP & 2) && g_flx) { const u32x4 w0 = __builtin_bit_cast(u32x4, pb[0]), w1 = __builtin_bit_cast(u32x4, pb[3]); O[0][0] += __uint_as_float((w0.x ^ w1.y) & 0x3fffffffu); }
      else pv_tile<2>(O, pb, sb_ + 8192, lane);
    }
    pc0 = pn0; pc1 = pn1; act_cur = act_next; kv_cur = kv_next; st_cur = st_next;
  }
#undef FL_ISSUE
}

__device__ __forceinline__ void fox_unit(const Params& p, int b, int h, int qb, LAS char* sm) {
  const int tid = otid512(), lane = tid & 63, w = tid >> 6, l31 = lane & 31, hh = lane >> 5;
  const int tq = qb * 256 + w * 32 + l31; const long tok = (long)b * SEQ + tq;
  const bf16_t* Pb = p.P + (long)b * SEQ * PW;
  bf16x8 qf[4];
#pragma unroll
  for (int ds = 0; ds < 4; ++ds) qf[ds] = *(const bf16x8*)(p.P + tok * PW + h * 64 + ds * 16 + hh * 8);
  const float* ck = p.cum + (long)(b * 6 + h) * SEQ;
  SMFox smod; smod.cq = ck[tq]; smod.ck = ck; smod.tq = tq; smod.tqmax = qb * 256 + w * 32 + 31;
  float m = -INFINITY, l = 0.f; f32x16 O[2];
#pragma unroll
  for (int r = 0; r < 16; ++r) { O[0][r] = 0.f; O[1][r] = 0.f; }
  TLRange tl; tl.n = 4 * qb + 4; tl.kv_last = qb * 256 + 192;
  flash_run64<4>(sm, qf, Pb + 384 + h * 64, PW, Pb + 768 + h * 64, PW, tl, smod, m, l, O);
  const float lt = l + __shfl_xor(l, 32); const float inv = lt > 0.f ? 1.0f / lt : 0.f;
#pragma unroll
  for (int dt = 0; dt < 2; ++dt)
#pragma unroll
    for (int a = 0; a < 4; ++a) { u32x2 wv; wv.x = cvtpk(O[dt][4 * a] * inv, O[dt][4 * a + 1] * inv); wv.y = cvtpk(O[dt][4 * a + 2] * inv, O[dt][4 * a + 3] * inv);
      *(u32x2*)(p.cat + kbo(NTOK, tok, h * 64 + dt * 32 + 8 * a + 4 * hh)) = wv; }
}

__device__ __forceinline__ void xattn_unit(const Params& p, int layer, int b, int hd, int qb, int dh, LAS char* sm) {
  const int tid = otid512(), lane = tid & 63, w = tid >> 6, l31 = lane & 31, hh = lane >> 5;
  const int tq = qb * 256 + w * 32 + l31; const long tok = (long)b * SEQ + tq;
  bf16x8 qf[16];
#pragma unroll
  for (int ds = 0; ds < 16; ++ds) qf[ds] = *(const bf16x8*)(p.qx + tok * DM + hd * 256 + ds * 16 + hh * 8);
  const float C = 0.0625f * LOG2E;
  float m = -INFINITY, l = 0.f; f32x16 O[4];
#pragma unroll
  for (int dt = 0; dt < 4; ++dt)
#pragma unroll
    for (int r = 0; r < 16; ++r) O[dt][r] = 0.f;
  const bf16_t* Kb = p.Kmem + ((long)layer * 1024 + b * 256) * DM + hd * 256;
  const bf16_t* Vb = p.Vmem + ((long)layer * 1024 + b * 256) * DM + hd * 256 + dh * 128;
  const int wid = __builtin_amdgcn_readfirstlane(tid >> 6);
  const bf16_t* ksrc[4]; const bf16_t* vsrc[2];
#pragma unroll
  for (int i = 0; i < 4; ++i) { const int pp = tid + 512 * i; const int row = pp >> 5, sl = pp & 31; const int kc = (sl & 16) | ((sl & 15) ^ (row & 15)); ksrc[i] = Kb + (long)row * DM + kc * 8; }
#pragma unroll
  for (int i = 0; i < 2; ++i) { const int pp = tid + 512 * i; vsrc[i] = Vb + (long)((pp & 255) >> 2) * DM + ((pp >> 8) * 4 + (pp & 3)) * 8; }
#define XA_ISSUE(t_) do { const int t__ = (t_); LAS char* d__ = sm + (t__ & 1) * 49152 + wid * 1024; \
    _Pragma("unroll") for (int i = 0; i < 4; ++i) __builtin_amdgcn_global_load_lds((const unsigned*)(ksrc[i] + (long)t__ * 64 * DM), (LAS unsigned*)(d__ + i * 8192), 16, 0, 0); \
    _Pragma("unroll") for (int i = 0; i < 2; ++i) __builtin_amdgcn_global_load_lds((const unsigned*)(vsrc[i] + (long)t__ * 64 * DM), (LAS unsigned*)(d__ + 32768 + i * 8192), 16, 0, 0); } while (0)
  __syncthreads();
  XA_ISSUE(0);
  fl_waitbar<0>();
#pragma unroll 1
  for (int it = 0; it < 4; ++it) {
    if (it + 1 < 4) XA_ISSUE(it + 1);
    LAS const char* sb_ = sm + (it & 1) * 49152;
    f32x16 p0, p1;
    qk_tile256(p0, p1, qf, sb_, lane);
#pragma unroll
    for (int r = 0; r < 16; ++r) { p0[r] *= C; p1[r] *= C; }
    bf16x8 pb[4];
    softmax_tile<4>(p0, p1, m, l, O, pb);
    pv_tile<4>(O, pb, sb_ + 32768, lane);
    fl_waitbar<0>();
  }
#undef XA_ISSUE
  const float lt = l + __shfl_xor(l, 32); const float inv = 1.0f / lt;
#pragma unroll
  for (int dt = 0; dt < 4; ++dt)
#pragma unroll
    for (int a = 0; a < 4; ++a) { u32x2 wv; wv.x = cvtpk(O[dt][4 * a] * inv, O[dt][4 * a + 1] * inv); wv.y = cvtpk(O[dt][4 * a + 2] * inv, O[dt][4 * a + 3] * inv);
      *(u32x2*)(p.ox + kbo(NTOK, tok, hd * 256 + dh * 128 + dt * 32 + 8 * a + 4 * hh)) = wv; }
}

#define NSA_SC 51200
#define NSA_UNI 122880
#define NSA_TL 122896
__device__ __forceinline__ void nsa_stageA(const Params& p, int layer, int b, int g, int qb, LAS char* sm) {
  const int tid = otid512(), lane = tid & 63, w = tid >> 6, l31 = lane & 31, hh = lane >> 5;
  const int tq = qb * 256 + w * 32 + l31; const long tok = (long)b * SEQ + tq;
  LAS float* sc = (LAS float*)(sm + NSA_SC);
  const bf16_t* kcb = p.kvc + (long)(0 * 8 + b * 2 + g) * 256 * 64;
  const bf16_t* vcb = p.kvc + (long)(1 * 8 + b * 2 + g) * 256 * 64;
  const int ntc = min(4, (16 * qb + 14) / 64 + 1);
  LAS float* myrow = sc + (w * 32 + l31) * 68;
  __syncthreads();
#pragma unroll
  for (int i = 0; i < 32; ++i) myrow[2 * i + hh] = 0.f;
  const float* glp = p.fgl + tok * 32 + 6;
  const float* gbp = p.gate_b + layer * 18;
#pragma unroll 1
  for (int r3 = 0; r3 < 3; ++r3) {
    const int head = 3 * g + r3;
    const float slope2 = exp2f(-8.0f * (float)(head + 1) / 6.0f) * LOG2E;
    bf16x8 qf[4];
#pragma unroll
    for (int ds = 0; ds < 4; ++ds) qf[ds] = *(const bf16x8*)(p.P + tok * PW + 1408 + head * 64 + ds * 16 + hh * 8);
    SMCmp smod; smod.tq = tq; smod.slope2 = slope2; smod.tqmax = qb * 256 + w * 32 + 31;
    float m = -INFINITY, l = 0.f; f32x16 O[2];
#pragma unroll
    for (int r = 0; r < 16; ++r) { O[0][r] = 0.f; O[1][r] = 0.f; }
    TLRange tl; tl.n = ntc; tl.kv_last = 64 * (ntc - 1);
    flash_run64<3>(sm, qf, kcb, 64, vcb, 64, tl, smod, m, l, O);
    const float lt = l + __shfl_xor(l, 32); const float inv = lt > 0.f ? 1.0f / lt : 0.f;
    const float gc = sigmoidf_(glp[head * 3 + 0] + gbp[head * 3 + 0]) * inv;
    float* ob = p.onsa + tok * 384 + head * 64;
#pragma unroll
    for (int dt = 0; dt < 2; ++dt)
#pragma unroll
      for (int a = 0; a < 4; ++a) *(f32x4*)(ob + dt * 32 + 8 * a + 4 * hh) = (f32x4){O[dt][4 * a] * gc, O[dt][4 * a + 1] * gc, O[dt][4 * a + 2] * gc, O[dt][4 * a + 3] * gc};
    const float mu = (m == -INFINITY) ? 0.f : m;
    float e_prev = 0.f;
    u32x4 kq[4];
    { const int row = tid >> 3, kc = tid & 7;
#pragma unroll
      for (int it = 0; it < 4; ++it) if (it < ntc) kq[it] = *(const u32x4*)(kcb + (long)(64 * it + row) * 64 + kc * 8); }
    const int kdst2 = (tid >> 3) * 128 + (kswz<4>(tid & 7, tid >> 3) << 4);
    __syncthreads();
    *(LAS u32x4*)(sm + kdst2) = kq[0];
    __syncthreads();
#pragma unroll
    for (int it = 0; it < 4; ++it) {
      if (it < ntc) {
        LAS char* kb_ = sm + (it & 1) * 8192;
        if (it + 1 < ntc) *(LAS u32x4*)(sm + ((it + 1) & 1) * 8192 + kdst2) = kq[(it + 1) & 3];
        f32x16 p0, p1;
        qk_tile64(p0, p1, qf, kb_, lane);
        smod.template apply<true>(p0, p1, 64 * it, lane, sm);
#pragma unroll
        for (int r = 0; r < 16; ++r) { p0[r] = fexp2(p0[r] - mu) * inv; p1[r] = fexp2(p1[r] - mu) * inv; }
#pragma unroll
        for (int pi = 0; pi < 2; ++pi)
#pragma unroll
          for (int a = 0; a < 4; ++a) {
            const float q0 = pi ? p1[4 * a] : p0[4 * a], q1 = pi ? p1[4 * a + 1] : p0[4 * a + 1], q2 = pi ? p1[4 * a + 2] : p0[4 * a + 2], q3 = pi ? p1[4 * a + 3] : p0[4 * a + 3];
            const float ex = __shfl_xor(q3, 32);
            myrow[2 * (8 * it + 4 * pi + a) + hh] += (q0 + q1) + (q2 + q3) + (hh ? ex : e_prev);
            e_prev = ex;
          }
        __syncthreads();
      }
    }
  }
  __syncthreads();
  {
    const int cur = tq >> 6;
#pragma unroll
    for (int mi = 0; mi < 32; ++mi) {
      const int j = 2 * mi + hh;
      const bool forced = (j == 0) || (j == cur) || (j == cur - 1);
      const float iv = myrow[j];
      myrow[j] = forced ? 1.0e4f : (j <= cur ? iv : -1.0f);
    }
  }
  __syncthreads();
  {
    float v[32];
#pragma unroll
    for (int i = 0; i < 8; ++i) { const f32x4 t = *(LAS const f32x4*)(myrow + 32 * hh + 4 * i); v[4 * i] = t[0]; v[4 * i + 1] = t[1]; v[4 * i + 2] = t[2]; v[4 * i + 3] = t[3]; }
    unsigned mym = 0u;
#pragma unroll 1
    for (int itk = 0; itk < 16; ++itk) {
      float best = v[0]; int bi = 0;
#pragma unroll
      for (int i = 1; i < 32; ++i) { const bool gt = v[i] > best; best = gt ? v[i] : best; bi = gt ? i : bi; }
      const float ob = __shfl_xor(best, 32);
      const bool mine = hh == 0 ? (best >= ob) : (best > ob);
      if (mine) {
        mym |= 1u << bi;
#pragma unroll
        for (int i = 0; i < 32; ++i) v[i] = (i == bi) ? -INFINITY : v[i];
      }
    }
    const unsigned oth = __shfl_xor(mym, 32);
    if (hh == 0) *(u32x2*)(p.selm + (tok * 2 + g) * 2) = (u32x2){mym, oth};
  }
  __syncthreads();
}

__device__ __forceinline__ void nsa_stageB(const Params& p, int layer, int b, int head, int qb, LAS char* sm) {
  const int tid = otid512(), lane = tid & 63, w = tid >> 6, l31 = lane & 31, hh = lane >> 5;
  const int g = head / 3;
  const int tq = qb * 256 + w * 32 + l31; const long tok = (long)b * SEQ + tq;
  const bf16_t* Pb = p.P + (long)b * SEQ * PW;
  LAS unsigned* uni = (LAS unsigned*)(sm + NSA_UNI);
  LAS int* tll = (LAS int*)(sm + NSA_TL);
  const float* glp = p.fgl + tok * 32 + 6;
  const float* gbp = p.gate_b + layer * 18;
  const u32x2 mk = *(const u32x2*)(p.selm + (tok * 2 + g) * 2);
  const unsigned mlo = mk.x, mhi = mk.y;
  __syncthreads();
  if (tid < 2) uni[tid] = 0u;
  __syncthreads();
  if (hh == 0) { __hip_atomic_fetch_or(uni, mlo, __ATOMIC_RELAXED, __HIP_MEMORY_SCOPE_WORKGROUP); __hip_atomic_fetch_or(uni + 1, mhi, __ATOMIC_RELAXED, __HIP_MEMORY_SCOPE_WORKGROUP); }
  __syncthreads();
  if (tid == 0) {
    unsigned long long u = ((unsigned long long)uni[1] << 32) | (unsigned long long)uni[0];
    const int jmax = (qb * 256 + 255) >> 6;
    int n = 0;
    for (int j = jmax; j >= 0; --j) if ((u >> j) & 1ull) tll[1 + n++] = 64 * j;
    tll[0] = n;
  }
  __syncthreads();
  const int nsel = tll[0];
  const int tqmax = qb * 256 + w * 32 + 31;
  const float slope2 = exp2f(-8.0f * (float)(head + 1) / 6.0f) * LOG2E;
  bf16x8 qf[4];
#pragma unroll
  for (int ds = 0; ds < 4; ++ds) qf[ds] = *(const bf16x8*)(p.P + tok * PW + 1408 + head * 64 + ds * 16 + hh * 8);
  f32x16 acc[2];
  {
    SMSel smod; smod.tq = tq; smod.slope2 = slope2; smod.mlo = mlo; smod.mhi = mhi; smod.tqmax = tqmax;
    float m = -INFINITY, l = 0.f; f32x16 O[2];
#pragma unroll
    for (int r = 0; r < 16; ++r) { O[0][r] = 0.f; O[1][r] = 0.f; }
    TLList tl; tl.n = nsel; tl.lst = tll + 1;
    flash_run64<4>(sm, qf, Pb + 2048 + g * 64, PW, Pb + 2176 + g * 64, PW, tl, smod, m, l, O);
    const float lt = l + __shfl_xor(l, 32); const float inv = lt > 0.f ? 1.0f / lt : 0.f;
    const float gs = sigmoidf_(glp[head * 3 + 1] + gbp[head * 3 + 1]) * inv;
#pragma unroll
    for (int r = 0; r < 16; ++r) { acc[0][r] = O[0][r] * gs; acc[1][r] = O[1][r] * gs; }
  }
  {
    SMWin smod; smod.tq = tq; smod.slope2 = slope2; smod.tqmax = tqmax;
    float m = -INFINITY, l = 0.f; f32x16 O[2];
#pragma unroll
    for (int r = 0; r < 16; ++r) { O[0][r] = 0.f; O[1][r] = 0.f; }
    const int kvf = max(0, qb * 256 - 512);
    TLRange tl; tl.kv_last = qb * 256 + 192; tl.n = (qb * 256 + 256 - kvf) >> 6;
    flash_run64<4>(sm, qf, Pb + 2304 + g * 64, PW, Pb + 2432 + g * 64, PW, tl, smod, m, l, O);
    const float lt = l + __shfl_xor(l, 32); const float inv = lt > 0.f ? 1.0f / lt : 0.f;
    const float gw = sigmoidf_(glp[head * 3 + 2] + gbp[head * 3 + 2]) * inv;
    const float* ob = p.onsa + tok * 384 + head * 64;
#pragma unroll
    for (int dt = 0; dt < 2; ++dt)
#pragma unroll
      for (int a = 0; a < 4; ++a) {
        const f32x4 oc = *(const f32x4*)(ob + dt * 32 + 8 * a + 4 * hh);
        u32x2 wv; wv.x = cvtpk(O[dt][4 * a] * gw + acc[dt][4 * a] + oc[0], O[dt][4 * a + 1] * gw + acc[dt][4 * a + 1] + oc[1]);
        wv.y = cvtpk(O[dt][4 * a + 2] * gw + acc[dt][4 * a + 2] + oc[2], O[dt][4 * a + 3] * gw + acc[dt][4 * a + 3] + oc[3]);
        *(u32x2*)(p.cat + kbo(NTOK, tok, 640 + head * 64 + dt * 32 + 8 * a + 4 * hh)) = wv;
      }
  }
  __syncthreads();
}

__device__ __forceinline__ void pool_unit(const Params& p, int layer, int b, int tb, int g, LAS char* sm) {
  const int tid = otid();
  LAS float* u = (LAS float*)sm;
  LAS float* W = (LAS float*)(sm + 20480);
  LAS float* pl = (LAS float*)(sm + 36864);
  const int t0 = tb * 64;
  const int wsz = 2 << g;
  TSYNC();
#pragma unroll
  for (int i3 = 0; i3 < 3; ++i3) { const int pi = tid + 256 * i3; if (pi < 79 * 8) { const int rr = pi >> 3, c8 = (pi & 7) * 8; const int t = t0 - 15 + rr;
      u32x4 v = {0u, 0u, 0u, 0u}; if (t >= 0) v = *(const u32x4*)(p.P + ((long)b * SEQ + t) * PW + 1152 + g * 64 + c8);
      *(LAS f32x4*)(u + rr * 64 + c8) = (f32x4){__uint_as_float(v.x << 16), __uint_as_float(v.x & 0xffff0000u), __uint_as_float(v.y << 16), __uint_as_float(v.y & 0xffff0000u)};
      *(LAS f32x4*)(u + rr * 64 + c8 + 4) = (f32x4){__uint_as_float(v.z << 16), __uint_as_float(v.z & 0xffff0000u), __uint_as_float(v.w << 16), __uint_as_float(v.w & 0xffff0000u)}; } }
#pragma unroll
  for (int i4 = 0; i4 < 4; ++i4) { const int i = (tid + 256 * i4) * 4; *(LAS f32x4*)(W + i) = *(const f32x4*)(p.pool_w + ((long)layer * 4 + g) * 4096 + i); }
  TSYNC();
  for (int i = tid; i < 4096; i += 256) { const int tl = i >> 6, c = i & 63; const int t = t0 + tl;
    float s = 0.f; for (int k = 0; k < wsz; ++k) s += u[(tl + 15 - k) * 64 + c];
    const float cnt = (float)min(t + 1, wsz);
    pl[i] = s / cnt - u[(tl + 15) * 64 + c]; }
  TSYNC();
  { const int d = tid & 63, tg = tid >> 6;
    const float scl = p.pool_scale[layer * 256 + g * 64 + d];
    float o[16];
#pragma unroll
    for (int i = 0; i < 16; ++i) o[i] = 0.f;
    for (int c = 0; c < 64; ++c) { const float wv = W[c * 64 + d];
#pragma unroll
      for (int i = 0; i < 16; ++i) o[i] += pl[(tg * 16 + i) * 64 + c] * wv; }
#pragma unroll
    for (int i = 0; i < 16; ++i) p.cat[kbo(NTOK, (long)b * SEQ + t0 + tg * 16 + i, 384 + g * 64 + d)] = f2bf(o[i] * scl); }
}

__device__ __forceinline__ void cum_unit(const Params& p, int layer, int b, int h, LAS char* sm) {
  const int tid = otid();
  LAS float* part = (LAS float*)sm;
  const float bf = p.fox_b[layer * 6 + h];
  float v[16]; float s = 0.f;
#pragma unroll
  for (int i = 0; i < 16; ++i) { const int t = tid * 16 + i; const float z = p.fgl[((long)b * SEQ + t) * 32 + h] + bf;
    const float ls = fminf(z, 0.f) - log1pf(__expf(-fabsf(z))); s += ls; v[i] = s; }
  TSYNC();
  part[tid] = s;
  TSYNC();
  if (tid < 64) {
    const f32x4 q = *(LAS const f32x4*)(part + 4 * tid);
    const float s0 = q[0], s1 = s0 + q[1], s2 = s1 + q[2], s3 = s2 + q[3];
    float inc = s3;
#pragma unroll
    for (int o = 1; o < 64; o <<= 1) { const float t = __shfl_up(inc, o); if (tid >= o) inc += t; }
    const float ex = inc - s3;
    *(LAS f32x4*)(part + 4 * tid) = (f32x4){ex, ex + s0, ex + s1, ex + s2};
  }
  TSYNC();
  const float base = part[tid];
#pragma unroll
  for (int i = 0; i < 16; ++i) p.cum[(long)(b * 6 + h) * SEQ + tid * 16 + i] = (base + v[i]) * LOG2E;
  TSYNC();
}

__device__ __forceinline__ void cmp2_unit(const Params& p, int layer, int kv, int rb, LAS char* sm) {
  const int tid = otid();
  LAS float* hs = (LAS float*)sm;
  const float* bias = p.bias1 + (layer * 2 + kv) * 256;
  const float* part = p.hidp + (long)kv * 2048 * 256;
  TSYNC();
#pragma unroll
  for (int i4 = 0; i4 < 4; ++i4) { const int i = (tid + 256 * i4) * 4; const int r = i >> 8, k = i & 255; const long o = (long)(rb * 16 + r) * 256 + k;
    f32x4 v = *(const f32x4*)(bias + k);
#pragma unroll
    for (int sI = 1; sI < 16; ++sI) v += *(const f32x4*)(bias + sI * 1024 + k);
#pragma unroll
    for (int sI = 0; sI < 8; ++sI) v += *(const f32x4*)(part + o + (long)sI * 4096 * 256);
    *(LAS f32x4*)(hs + i) = (f32x4){gelu_tanh(v[0]), gelu_tanh(v[1]), gelu_tanh(v[2]), gelu_tanh(v[3])}; }
  TSYNC();
  const int n = tid & 63, rg = tid >> 6;
  const float* w2 = (kv ? p.w2v : p.w2k) + (long)layer * 256 * 64 + n;
  float acc[4] = {0.f, 0.f, 0.f, 0.f};
#pragma unroll 1
  for (int k0 = 0; k0 < 256; k0 += 16) {
    float wv[16];
#pragma unroll
    for (int q = 0; q < 16; ++q) wv[q] = w2[(k0 + q) * 64];
#pragma unroll
    for (int q = 0; q < 16; q += 4)
#pragma unroll
      for (int j = 0; j < 4; ++j) { const f32x4 h4 = *(LAS const f32x4*)(hs + (rg * 4 + j) * 256 + k0 + q);
        acc[j] += h4[0] * wv[q] + h4[1] * wv[q + 1] + h4[2] * wv[q + 2] + h4[3] * wv[q + 3]; }
  }
#pragma unroll
  for (int j = 0; j < 4; ++j) { const int row = rb * 16 + rg * 4 + j; p.kvc[((long)kv * 2048 + row) * 64 + n] = ((row & 255) == 255) ? (bf16_t)0 : f2bf(acc[j]); }
}

#define GSYNC() xcd_barrier(xb)
#define GSYNCK(k) do { xcd_barrier(xb); if (SPINMASK != 0ull && bid == 0 && tid5 == 0) { ((unsigned long long*)(xb.bar + 4096))[(k)] = __builtin_amdgcn_s_memrealtime(); } } while (0)
#ifndef SKIPMASK
#define SKIPMASK 0
#endif
#define PH(n) if (!((SKIPMASK >> (n)) & 1))
#define REP(n) for (int rep_ = 0; rep_ < ((((DUPMASK) >> (n)) & 1) ? 2 : 1); ++rep_)
__global__ void __launch_bounds__(512, 2) fwd_kernel(Params p) {
  LAS char* smfull = (LAS char*)lds_dyn;
  const int tid5 = otid512();
  const int tid = otid();
  const int team = team_id();
  LAS char* sm = smfull + team * 65536;
  LAS int* xs = (LAS int*)(smfull + LDS_XS + team * 2048);
  LAS int* xsg = (LAS int*)(smfull + LDS_XS);
  const int bid = blockIdx.x, nb = gridDim.x;
  const int vb = vbid(), nv = nvb();
  if (p.never) cg::this_grid().sync();
  if (tid5 < 64) ((LAS unsigned*)(smfull + LDS_XB))[tid5] = 0u;
  __syncthreads();
  XcdBarrier xb = xcd_barrier_post(p.bar, (volatile LAS unsigned*)(smfull + LDS_XB));
  if (SPINMASK != 0ull && bid == 0 && tid5 == 0) ((unsigned long long*)(xb.bar + 4096))[0] = __builtin_amdgcn_s_memrealtime();

  REP(0) PH(0) {
    f32x4 vcur[4], vnxt[4];
    int t = vb, ji = 0;
    if (t < p.ttiles) {
#pragma unroll
      for (int q = 1; q < NJOBS; ++q) if (t >= p.jobs[q].tile0) ji = q;
      tt_load(p.jobs[ji], t - p.jobs[ji].tile0, vnxt);
    }
    for (; t < p.ttiles; t += nv) {
#pragma unroll
      for (int i = 0; i < 4; ++i) vcur[i] = vnxt[i];
      const int tn = t + nv; int jn = 0;
      if (tn < p.ttiles) {
#pragma unroll
        for (int q = 1; q < NJOBS; ++q) if (tn >= p.jobs[q].tile0) jn = q;
        tt_load(p.jobs[jn], tn - p.jobs[jn].tile0, vnxt);
      }
      tt_finish(p.jobs[ji], t - p.jobs[ji].tile0, vcur, sm);
      ji = jn;
    }
  }
  PH(1) {
    const long gt = (long)vb * 256 + tid, gs = (long)nv * 256;
    for (long i = gt; i < 2L * 32 * 232 * 4; i += gs) { const long l = i / (32 * 232 * 4); long rem = i % (32 * 232 * 4); const long kb = rem / (232 * 4); rem %= (232 * 4);
      *(u32x4*)(p.WinT + l * 2816 * 1024 + (kb * 2816 + 2584) * 32 + rem * 8) = (u32x4){0u, 0u, 0u, 0u}; }
    for (long i = gt; i < 2L * 32 * 236 * 4; i += gs) { const long l = i / (32 * 236 * 4); long rem = i % (32 * 236 * 4); const long kb = rem / (236 * 4); rem %= (236 * 4);
      *(u32x4*)(p.WrT + l * 256 * 1024 + (kb * 256 + 20) * 32 + rem * 8) = (u32x4){0u, 0u, 0u, 0u}; }
    if (gt < 64) { p.mcnt[gt] = 0; p.wq[gt] = 0; }
    if (gt < 16384) { const int kc = (int)(gt >> 10), l = (int)((gt >> 9) & 1), kv = (int)((gt >> 8) & 1), n = (int)(gt & 255);
      const float* pe = (kv ? p.pe_v : p.pe_k) + l * 2048 + kc * 128; const float* w1 = (kv ? p.w1v : p.w1k) + (long)l * 2048 * 256 + (long)kc * 128 * 256 + n;
      float s = 0.f;
#pragma unroll 16
      for (int k = 0; k < 128; ++k) s += pe[k] * w1[(long)k * 256];
      p.bias1[gt] = s; }
  }
  PH(2) rownorm<false>(p.mem, p.mem_g, p.memn, 1024);
  rownorm<false>(p.mem, p.mem_g + DM, p.memn + 1024 * DM, 1024);
  rowprep(p.x_in, p.hb, p.ssq, NTOK);
  GSYNCK(1);

  for (int layer = 0; layer < 2; ++layer) {
    REP(3) PH(3) {
      const int nmain = 64 * 11, nextra = layer == 0 ? 64 : 0;
      for (int it = bid; it < nmain + nextra; it += nb) {
        if (it < nmain) {
          const int nt = it / 64, mt = it % 64;
          RowKB af{p.hb, NTOK, mt * 256, 0};
          RowKB bf{p.WinT + (long)layer * 2816 * DM, 2816, nt * 256, 0};
          EpiInproj ep{p.P, p.fgl, p.ssq, mt, nt};
          gemm_tile(smfull, 16, af, bf, ep);
        } else {
          const int e = it - nmain; const int l2 = e >> 5, kv = (e >> 4) & 1, mt = (e >> 2) & 3, nt = e & 3;
          RowKB af{p.memn + (long)l2 * 1024 * DM, 1024, mt * 256, 0};
          RowKB bf{(kv ? p.WvT : p.WkT) + (long)l2 * 1024 * DM, 1024, nt * 256, 0};
          EpiBf16 ep{(kv ? p.Vmem : p.Kmem) + (long)l2 * 1024 * DM, DM, mt * 256, nt * 256, nullptr};
          gemm_tile(smfull, 16, af, bf, ep);
        }
      }
    }
    GSYNCK(2 + layer * 12);
    REP(4) PH(4) {
      for (int it = bid; it < 128; it += nb) {
        const int ks = it & 7, mt = (it >> 3) & 7, kv = it >> 6;
        RowCmp af{p.P + (kv ? 1920 : 1792), mt * 256, ks * 4};
        RowKB bf{p.W1T + ((long)layer * 2 + kv) * 256 * 2048, 256, 0, ks * 8};
        EpiF32 ep{p.hidp + ((long)ks * 4096 + kv * 2048) * 256, 256, mt * 256, 0};
        gemm_tile(smfull, 4, af, bf, ep);
      }
      __syncthreads();
      for (int e = vb; e < 1024; e += nv) pool_unit(p, layer, e >> 8, (e >> 2) & 63, e & 3, sm);
      if (vb >= nv - 24) { const int e = nv - 1 - vb; cum_unit(p, layer, e / 6, e % 6, sm); }
    }
    GSYNCK(3 + layer * 12);
    PH(5) for (int it = vb; it < 256; it += nv) cmp2_unit(p, layer, it >> 7, it & 127, sm);
    GSYNCK(4 + layer * 12);
    REP(6) {
      if (FLEXP) { __syncthreads(); if (tid5 == 0) xsg[500] = (rep_ == 0 && ((DUPMASK >> 6) & 1)) ? 1 : 0; __syncthreads(); }
      int* ctr = p.wq + layer * 8 + rep_ * 2;
      for (;;) {
        __syncthreads();
        if (tid5 == 0) xsg[0] = atomicAdd(ctr, 1);
        __syncthreads();
        const int it = xsg[0];
        if (it >= 416) break;
        if (it < 216) { const int qb = 15 - it / 24, bh = it % 24; fox_unit(p, bh / 6, bh % 6, qb, smfull); }
        else if (it < 344) { const int e = it - 216; const int qb = 15 - (e >> 3), bg = e & 7; nsa_stageA(p, layer, bg >> 1, bg & 1, qb, smfull); }
        else { const int e = it - 344; const int qb = 6 - e / 24, bh = e % 24; fox_unit(p, bh / 6, bh % 6, qb, smfull); }
      }
    }
    GSYNCK(5 + layer * 12);
    REP(6) {
      if (FLEXP) { __syncthreads(); if (tid5 == 0) xsg[500] = (rep_ == 0 && ((DUPMASK >> 6) & 1)) ? 1 : 0; __syncthreads(); }
      int* ctr = p.wq + layer * 8 + 4 + rep_ * 2;
      for (;;) {
        __syncthreads();
        if (tid5 == 0) xsg[0] = atomicAdd(ctr, 1);
        __syncthreads();
        const int it = xsg[0];
        if (it >= 480) break;
        if (it < 192) { const int qb = 15 - it / 12, e = it % 12; nsa_stageB(p, layer, e / 3, 3 + e % 3, qb, smfull); }
        else if (it < 384) { const int e2 = it - 192; const int qb = 15 - e2 / 12, e = e2 % 12; nsa_stageB(p, layer, e / 3, e % 3, qb, smfull); }
        else { const int e = it - 384; const int qb = 3 - e / 24, bh = e % 24; fox_unit(p, bh / 6, bh % 6, qb, smfull); }
      }
    }
    GSYNCK(6 + layer * 12);
    PH(7) for (int it = bid; it < 256; it += nb) {
      const int nt = it >> 6, mt = it & 63;
      RowKB af{p.cat, NTOK, mt * 256, 0};
      RowKB bf{p.WoutT + (long)layer * 1024 * DM, 1024, nt * 256, 0};
      EpiResid ep{layer == 0 ? p.x_in : nullptr, p.hb, p.ssq, mt * 256, nt * 256};
      gemm_tile(smfull, 16, af, bf, ep);
    }
    GSYNCK(7 + layer * 12);
    REP(8) PH(8) for (int it = bid; it < 256; it += nb) {
      const int nt = it >> 6, mt = it & 63;
      RowKB af{p.hb, NTOK, mt * 256, 0};
      RowKB bf{p.WqT + (long)layer * 1024 * DM, 1024, nt * 256, 0};
      EpiBf16 ep{p.qx, DM, mt * 256, nt * 256, p.ssq};
      gemm_tile(smfull, 16, af, bf, ep);
    }
    GSYNCK(8 + layer * 12);
    REP(5) { for (int it = bid; it < 512; it += nb) { const int dh = it & 1, hd = (it >> 1) & 3, b = (it >> 3) & 3, qb = it >> 5; xattn_unit(p, layer, b, hd, qb, dh, smfull); } }
    GSYNCK(9 + layer * 12);
    PH(9) for (int it = bid; it < 256; it += nb) {
      const int nt = it >> 6, mt = it & 63;
      RowKB af{p.ox, NTOK, mt * 256, 0};
      RowKB bf{p.WoT + (long)layer * 1024 * DM, 1024, nt * 256, 0};
      EpiResid ep{nullptr, p.hb, p.ssq, mt * 256, nt * 256};
      gemm_tile(smfull, 16, af, bf, ep);
    }
    GSYNCK(10 + layer * 12);
    PH(10) for (int it = bid; it < 256; it += nb) {
      const int ks = it & 3, mt = it >> 2;
      RowKB af{p.hb, NTOK, mt * 256, ks * 8};
      RowKB bf{p.WrT + (long)layer * 256 * DM, 256, 0, ks * 8};
      EpiRouterPart ep{p.rpart + (long)ks * NTOK * 32, mt * 256};
      gemm_tile(smfull, 4, af, bf, ep);
    }
    GSYNC();
    PH(10) if (vb < 64) {
      const int tid = otid();
      const int tok = vb * 256 + tid;
      TSYNC();
      if (tid < 32) xs[tid] = 0;
      TSYNC();
      float lg[20];
#pragma unroll
      for (int q4 = 0; q4 < 5; ++q4) {
        f32x4 v = *(const f32x4*)(p.rpart + (long)tok * 32 + q4 * 4);
#pragma unroll
        for (int sI = 1; sI < 4; ++sI) v += *(const f32x4*)(p.rpart + ((long)sI * NTOK + tok) * 32 + q4 * 4);
        lg[q4 * 4] = v[0]; lg[q4 * 4 + 1] = v[1]; lg[q4 * 4 + 2] = v[2]; lg[q4 * 4 + 3] = v[3];
      }
      { const float rs = row_rstd(p.ssq, tok);
#pragma unroll
        for (int q = 0; q < 20; ++q) lg[q] *= rs; }
      float c[4], f[4];
#pragma unroll
      for (int i = 0; i < 4; ++i) c[i] = lg[i] + p.rc_b[layer * 4 + i];
      int grp = 0; float cm = c[0];
#pragma unroll
      for (int i = 1; i < 4; ++i) if (c[i] > cm) { cm = c[i]; grp = i; }
      float cs = 0.f;
#pragma unroll
      for (int i = 0; i < 4; ++i) cs += __expf(c[i] - cm);
      const float wgrp = 1.0f / cs;
#pragma unroll
      for (int i = 0; i < 4; ++i) { const float l0 = lg[4 + i], l1 = lg[8 + i], l2 = lg[12 + i], l3 = lg[16 + i];
        f[i] = (grp == 0 ? l0 : grp == 1 ? l1 : grp == 2 ? l2 : l3) + p.rf_b[layer * 16 + grp * 4 + i]; }
      int i1 = 0; float f1 = f[0];
#pragma unroll
      for (int i = 1; i < 4; ++i) if (f[i] > f1) { f1 = f[i]; i1 = i; }
      int i2 = -1; float f2 = -INFINITY;
#pragma unroll
      for (int i = 0; i < 4; ++i) if (i != i1 && f[i] > f2) { f2 = f[i]; i2 = i; }
      const float e2 = __expf(f2 - f1);
      const float w1 = wgrp / (1.0f + e2), w2 = wgrp * e2 / (1.0f + e2);
      const int a = i1 < i2 ? i1 : i2, bq = i1 < i2 ? i2 : i1;
      const float wa = i1 < i2 ? w1 : w2, wb = i1 < i2 ? w2 : w1;
      const int pairidx = (a == 0) ? (bq - 1) : (a == 1 ? bq + 1 : 5);
      const int cls = grp * 6 + pairidx;
      const int lpos = __hip_atomic_fetch_add(xs + cls, 1, __ATOMIC_RELAXED, __HIP_MEMORY_SCOPE_WORKGROUP);
      TSYNC();
      if (tid < 24) xs[32 + tid] = atomicAdd(&p.mcnt[layer * 32 + tid], xs[tid]);
      TSYNC();
      const int pos = xs[32 + cls] + lpos;
      p.mlist[((long)layer * 24 + cls) * NTOK + pos] = tok;
      p.tokw[tok * 2 + 0] = wa; p.tokw[tok * 2 + 1] = wb;
    }
    GSYNCK(11 + layer * 12);
    PH(11) {
      LAS int* tstart = xsg;
      LAS int* ccnt = xsg + 32;
      LAS int* toks = xsg + 64;
      LAS float* wts = (LAS float*)xsg + 320;
      LAS float* rsd = (LAS float*)xsg + 576;
      __syncthreads();
      if (tid5 == 0) { int a = 0; for (int c = 0; c < 24; ++c) { const int n = p.mcnt[layer * 32 + c]; ccnt[c] = n; tstart[c] = a; a += (n + 255) >> 8; } tstart[24] = a; }
      __syncthreads();
      const int nrt = tstart[24];
      for (int pass = 0; pass < 2; ++pass) {
        const int nct = pass == 0 ? 8 : 4;
        for (int it = bid; it < nrt * nct; it += nb) {
          const int rt = it / nct, ct = it % nct;
          int cls = 0;
          for (int c = 1; c < 24; ++c) if (rt >= tstart[c]) cls = c;
          const int rtl = rt - tstart[cls];
          const int grp = cls / 6, pi = cls % 6;
          const int ea = grp * 4 + (pi < 3 ? 0 : (pi < 5 ? 1 : 2)), eb = grp * 4 + (pi < 3 ? pi + 1 : (pi < 5 ? pi - 1 : 3));
          __syncthreads();
          const int tid5 = otid512();
          if (tid5 < 256) { const int idx = rtl * 256 + tid5; const bool ok = idx < ccnt[cls];
            const int tk = ok ? p.mlist[((long)layer * 24 + cls) * NTOK + idx] : -1; toks[tid5] = tk;
            wts[tid5] = ok ? p.tokw[tk * 2 + (ct < 4 ? 0 : 1)] : 0.f; rsd[tid5] = ok ? row_rstd(p.ssq, tk) : 0.f; }
          __syncthreads();
          if (pass == 0) {
            const int ex = ct < 4 ? ea : eb;
            RowGather af{p.hb, NTOK, toks};
            RowKB bf{p.WguT + ((long)layer * 16 + ex) * 1024 * DM, 1024, (ct & 3) * 256, 0};
            EpiMoeUp ep{p.he, (long)rt * 256, (ct < 4 ? 0 : 512) + (ct & 3) * 128, wts, rsd};
            gemm_tile(smfull, 16, af, bf, ep);
          } else {
            RowKB af{p.he, HE_ROWS, rt * 256, 0};
            const bf16_t* ba = p.WdT + ((long)layer * 16 + ea) * 1024 * 512;
            const bf16_t* bb = p.WdT + ((long)layer * 16 + eb) * 1024 * 512;
            RowSplitKB bf{ba, 1024, ct * 256, (long)(bb - ba)};
            EpiMoeDown ep{p.hb, p.ssq, ct * 256, toks};
            gemm_tile(smfull, 16, af, bf, ep);
          }
        }
        GSYNCK(12 + pass + layer * 12);
      }
    }
  }
  finalnorm(p.hb, p.ssq, p.final_g, p.xw, NTOK);
  if (SPINMASK != 0ull && bid == 0 && tid5 == 0) {
    unsigned long long tot = 0;
    for (int k = 0; k < 25; ++k) if ((SPINMASK >> k) & 1ull) tot += ((unsigned long long*)(xb.bar + 4096))[k + 1] - ((unsigned long long*)(xb.bar + 4096))[k];
    const unsigned long long t0 = __builtin_amdgcn_s_memrealtime();
    while (__builtin_amdgcn_s_memrealtime() - t0 < tot * SPINMUL) __builtin_amdgcn_s_sleep(8);
  }
}

static inline size_t al256(size_t x) { return (x + 255) & ~(size_t)255; }
extern "C" void kernel_launch(void* const* d_in, const int* in_sizes, int n_in, void* d_out, int out_size, void* d_ws, size_t ws_size, hipStream_t stream) {
  Params p; memset(&p, 0, sizeof(p));
  const float* const* in = (const float* const*)d_in;
  p.x_in = in[0]; p.mem = in[1]; p.mix_g = in[2]; p.fox_b = in[4]; p.pool_w = in[5]; p.pool_scale = in[6]; p.pe_k = in[7]; p.pe_v = in[8];
  p.w1k = in[9]; p.w1v = in[11]; p.w2k = in[10]; p.w2v = in[12]; p.gate_b = in[13]; p.xattn_g = in[15]; p.mem_g = in[16]; p.ffn_g = in[21]; p.rc_b = in[23]; p.rf_b = in[25]; p.final_g = in[29];
  p.xw = (float*)d_out;
  char* ws = (char*)d_ws; size_t off = 0;
  auto take = [&](size_t bytes) { char* r = ws + off; off = al256(off + bytes); return r; };
  p.bar = (unsigned*)take(4096 * 4 + 128 * 8);
  p.mcnt = (int*)take(64 * 4);
  p.wq = (int*)take(64 * 4);
  p.WinT = (bf16_t*)take(2UL * 2816 * 1024 * 2);
  p.WoutT = (bf16_t*)take(2UL * 1024 * 1024 * 2);
  p.WqT = (bf16_t*)take(2UL * 1024 * 1024 * 2);
  p.WkT = (bf16_t*)take(2UL * 1024 * 1024 * 2);
  p.WvT = (bf16_t*)take(2UL * 1024 * 1024 * 2);
  p.WoT = (bf16_t*)take(2UL * 1024 * 1024 * 2);
  p.WguT = (bf16_t*)take(2UL * 16 * 1024 * 1024 * 2);
  p.WdT = (bf16_t*)take(2UL * 16 * 1024 * 512 * 2);
  p.W1T = (bf16_t*)take(2UL * 2 * 256 * 2048 * 2);
  p.W2T = (bf16_t*)take(2UL * 2 * 64 * 256 * 2);
  p.WrT = (bf16_t*)take(2UL * 256 * 1024 * 2);
  p.bias1 = (float*)take(16 * 1024 * 4);
  p.hb = (bf16_t*)take((size_t)NTOK * 1024 * 2);
  p.onsa = (float*)d_out; p.hidp = (float*)d_out;
  p.P = (bf16_t*)take((size_t)NTOK * PW * 2);
  p.qx = p.P;
  p.ox = p.P + (size_t)NTOK * 1024;
  p.he = p.P;
  p.rpart = (float*)(p.P + (size_t)NTOK * 2048);
  p.cat = (bf16_t*)take((size_t)NTOK * 1024 * 2);
  p.memn = (bf16_t*)take(2UL * 1024 * 1024 * 2);
  p.Kmem = (bf16_t*)take(2UL * 1024 * 1024 * 2);
  p.Vmem = (bf16_t*)take(2UL * 1024 * 1024 * 2);
  p.hid = (bf16_t*)take(2UL * 2048 * 256 * 2);
  p.kvc = (bf16_t*)take(2UL * 2048 * 64 * 2);
  p.fgl = (float*)take((size_t)NTOK * 32 * 4);
  p.cum = (float*)take(24UL * SEQ * 4);
  p.tokw = (float*)take((size_t)NTOK * 2 * 4);
  p.ssq = (float*)take((size_t)NTOK * 16 * 4);
  p.mlist = (int*)take(2UL * 24 * NTOK * 4);
  p.selm = (unsigned*)take((size_t)NTOK * 2 * 2 * 4);
  int nj = 0, tile0 = 0;
  auto job = [&](const float* src, bf16_t* dst, long sbs, long dbs, int K, int N, int lds, int R, int map, int nbatch, const float* g = nullptr, int gdiv = 1) {
    TJob& j = p.jobs[nj++]; j.src = src; j.dst = dst; j.g = g; j.sbs = sbs; j.dbs = dbs; j.K = K; j.N = N; j.lds = lds; j.R = R; j.map = map;
    j.tpb = (K / 64) * ((N + 63) / 64); j.tile0 = tile0; j.gdiv = gdiv; tile0 += j.tpb * nbatch; };
  job(in[26], p.WguT, 1024L * 512, 1024L * 1024, 1024, 512, 512, 1024, 2, 32, in[21], 16);
  job(in[27], p.WguT, 1024L * 512, 1024L * 1024, 1024, 512, 512, 1024, 3, 32, in[21], 16);
  job(in[28], p.WdT, 512L * 1024, 1024L * 512, 512, 1024, 1024, 1024, 0, 32);
  job(in[3], p.WinT, 1024L * 2584, 2816L * 1024, 1024, 2584, 2584, 2816, 1, 2, in[2], 1);
  job(in[14], p.WoutT, 1024L * 1024, 1024L * 1024, 1024, 1024, 1024, 1024, 0, 2);
  job(in[17], p.WqT, 1024L * 1024, 1024L * 1024, 1024, 1024, 1024, 1024, 0, 2, in[15], 1);
  job(in[18], p.WkT, 1024L * 1024, 1024L * 1024, 1024, 1024, 1024, 1024, 0, 2);
  job(in[19], p.WvT, 1024L * 1024, 1024L * 1024, 1024, 1024, 1024, 1024, 0, 2);
  job(in[20], p.WoT, 1024L * 1024, 1024L * 1024, 1024, 1024, 1024, 1024, 0, 2);
  job(in[9], p.W1T, 2048L * 256, 2L * 256 * 2048, 2048, 256, 256, 256, 0, 2);
  job(in[11], p.W1T + 256L * 2048, 2048L * 256, 2L * 256 * 2048, 2048, 256, 256, 256, 0, 2);
  job(in[22], p.WrT, 1024L * 4, 256L * 1024, 1024, 4, 4, 256, 0, 2, in[21], 1);
  job(in[24], p.WrT + 4L * 32, 1024L * 16, 256L * 1024, 1024, 16, 16, 256, 0, 2, in[21], 1);
  p.ttiles = tile0; p.never = 0;
  static int grid_blocks = 0;
  if (!grid_blocks) {
    int dev = 0, cus = 0, per_cu = 0;
    (void)hipGetDevice(&dev);
    (void)hipDeviceGetAttribute(&cus, hipDeviceAttributeMultiprocessorCount, dev);
    if (hipFuncSetAttribute((const void*)fwd_kernel, hipFuncAttributeMaxDynamicSharedMemorySize, LDS_BYTES) != hipSuccess) fprintf(stderr, "hipFuncSetAttribute(dynamic LDS %d) failed\n", LDS_BYTES);
    (void)hipOccupancyMaxActiveBlocksPerMultiprocessor(&per_cu, fwd_kernel, 512, LDS_BYTES);
    (void)hipGetLastError();
    grid_blocks = cus;
  }
  (void)hipMemsetAsync(p.bar, 0, XCD_BAR_WORDS * 4, stream);
  void* args[] = {&p};
  hipError_t e = hipLaunchCooperativeKernel((void*)fwd_kernel, dim3(grid_blocks), dim3(512), args, LDS_BYTES, stream);
  if (e != hipSuccess) fprintf(stderr, "cooperative launch failed: %s (grid %d, ws needed %zu of %zu)\n", hipGetErrorString(e), grid_blocks, off, ws_size);
}
```

```cpp
#define DUPMASK 0
#define FLEXP 0
#define SPINMASK 0ull
#define DUPK 0
#define TCAT 0
#define SPINMUL 8
#define QEXP 0
#include <hip/hip_runtime.h>
#include <hip/hip_cooperative_groups.h>
#include <cstdint>
#include <cstdio>
#include <cstring>
namespace cg = cooperative_groups;

#define LAS __attribute__((address_space(3)))
typedef unsigned short bf16_t;
typedef short bf16x8 __attribute__((ext_vector_type(8)));
typedef short s16x4 __attribute__((ext_vector_type(4)));
typedef float f32x16 __attribute__((ext_vector_type(16)));
typedef float f32x4 __attribute__((ext_vector_type(4)));
typedef float f32x2 __attribute__((ext_vector_type(2)));
typedef unsigned u32x4 __attribute__((ext_vector_type(4)));
typedef unsigned u32x2 __attribute__((ext_vector_type(2)));
typedef __bf16 bf16x2_t __attribute__((ext_vector_type(2)));

#define NTOK 16384
#define SEQ 4096
#define DM 1024
#define PW 2560
#define LOG2E 1.4426950408889634f

__device__ __forceinline__ unsigned cvtpk(float lo, float hi) { f32x2 v = {lo, hi}; bf16x2_t b = __builtin_convertvector(v, bf16x2_t); return __builtin_bit_cast(unsigned, b); }
__device__ __forceinline__ bf16_t f2bf(float x) { return (bf16_t)(cvtpk(x, 0.f) & 0xffffu); }
__device__ __forceinline__ float bf2f(bf16_t b) { return __uint_as_float(((unsigned)b) << 16); }
__device__ __forceinline__ f32x4 bf4lo(const u32x4& w) { return (f32x4){__uint_as_float(w.x << 16), __uint_as_float(w.x & 0xffff0000u), __uint_as_float(w.y << 16), __uint_as_float(w.y & 0xffff0000u)}; }
__device__ __forceinline__ f32x4 bf4hi(const u32x4& w) { return (f32x4){__uint_as_float(w.z << 16), __uint_as_float(w.z & 0xffff0000u), __uint_as_float(w.w << 16), __uint_as_float(w.w & 0xffff0000u)}; }
__device__ __forceinline__ long kbo(long R, long r, int k) { return ((long)(k >> 5) * R + r) * 32 + (k & 31); }
#define HE_ROWS 22528
__device__ __forceinline__ int crow(int r, int hi) { return (r & 3) + 8 * (r >> 2) + 4 * hi; }
__device__ __forceinline__ float fexp2(float x) { return __builtin_amdgcn_exp2f(x); }
extern __shared__ __attribute__((aligned(16))) unsigned char lds_dyn[];
#define LDS_XS 147456
#define LDS_XB 151552
#define LDS_TB 151616
#define LDS_BYTES 151808
__device__ __forceinline__ int otid() { int t = threadIdx.x & 255; asm volatile("" : "+v"(t)); return t; }
#define TID5 ((int)threadIdx.x)
#define TIDT ((int)(threadIdx.x & 255u))
__device__ __forceinline__ int lane_id_v() { int l; asm volatile("v_mbcnt_lo_u32_b32 %0, -1, 0\n\tv_mbcnt_hi_u32_b32 %0, -1, %0" : "=v"(l)); return l; }
__device__ __forceinline__ float ninf_v() { float x = -INFINITY; asm volatile("" : "+v"(x)); return x; }
__device__ __forceinline__ void st16_sc1(void* g, const u32x4 v) { asm volatile("global_store_dwordx4 %0, %1, off sc1\n\ts_nop 1" :: "v"(g), "v"(v) : "memory"); }
__device__ __forceinline__ void st8_sc1(void* g, const u32x2 v) { asm volatile("global_store_dwordx2 %0, %1, off sc1\n\ts_nop 1" :: "v"(g), "v"(v) : "memory"); }
__device__ __forceinline__ int otid512() { int t = threadIdx.x; asm volatile("" : "+v"(t)); return t; }
__device__ __forceinline__ int team_id() { return __builtin_amdgcn_readfirstlane((int)(threadIdx.x >> 8)); }
__device__ __forceinline__ int vbid() { return blockIdx.x * 2 + team_id(); }
__device__ __forceinline__ int nvb() { return gridDim.x * 2; }
__device__ __forceinline__ void team_sync() {
  asm volatile("s_waitcnt lgkmcnt(0)" ::: "memory");
  LAS unsigned* ctr = (LAS unsigned*)((LAS char*)lds_dyn + LDS_TB + team_id() * 64);
  unsigned old = 0u;
  if ((threadIdx.x & 63) == 0) old = __hip_atomic_fetch_add(ctr, 1u, __ATOMIC_RELAXED, __HIP_MEMORY_SCOPE_WORKGROUP);
  old = __builtin_amdgcn_readfirstlane(old);
  const unsigned tgt = (old & ~3u) + 4u;
  while ((int)(__hip_atomic_load(ctr, __ATOMIC_RELAXED, __HIP_MEMORY_SCOPE_WORKGROUP) - tgt) < 0) __builtin_amdgcn_s_sleep(0);
  asm volatile("" ::: "memory");
}
#define TSYNC() team_sync()
__device__ __forceinline__ float sigmoidf_(float x) { return 1.0f / (1.0f + __expf(-x)); }

struct TJob { const float* src; bf16_t* dst; const float* g; long sbs, dbs; int K, N, lds, R, map, tpb, tile0, gdiv; };
#define NJOBS 21
constexpr size_t wsal(size_t x) { return (x + 255) & ~(size_t)255; }
constexpr size_t WSO_bar = 0;
constexpr size_t WSO_mcnt = wsal(WSO_bar + (4096 * 4 + 128 * 8));
constexpr size_t WSO_wq = wsal(WSO_mcnt + (64 * 4));
constexpr size_t WSO_mq = wsal(WSO_wq + (64 * 4));
constexpr size_t WSO_WinT = wsal(WSO_mq + (512 * 4));
constexpr size_t WSO_WoutT = wsal(WSO_WinT + (2UL * 2816 * 1024 * 2));
constexpr size_t WSO_WqT = wsal(WSO_WoutT + (2UL * 1024 * 1024 * 2));
constexpr size_t WSO_WkT = wsal(WSO_WqT + (2UL * 1024 * 1024 * 2));
constexpr size_t WSO_WvT = wsal(WSO_WkT + (2UL * 1024 * 1024 * 2));
constexpr size_t WSO_WoT = wsal(WSO_WvT + (2UL * 1024 * 1024 * 2));
constexpr size_t WSO_WguT = wsal(WSO_WoT + (2UL * 1024 * 1024 * 2));
constexpr size_t WSO_WdT = wsal(WSO_WguT + (2UL * 16 * 1024 * 1024 * 2));
constexpr size_t WSO_W1T = wsal(WSO_WdT + (2UL * 16 * 1024 * 512 * 2));
constexpr size_t WSO_WrT = wsal(WSO_W1T + (2UL * 2 * 256 * 2048 * 2));
constexpr size_t WSO_bias1 = wsal(WSO_WrT + (2UL * 256 * 1024 * 2));
constexpr size_t WSO_hb = wsal(WSO_bias1 + (17 * 1024 * 4));
constexpr size_t WSO_P = wsal(WSO_hb + ((size_t)NTOK * 1024 * 2));
constexpr size_t WSO_cat = wsal(WSO_P + ((size_t)NTOK * PW * 2));
constexpr size_t WSO_memn = wsal(WSO_cat + ((size_t)NTOK * 1024 * 2));
constexpr size_t WSO_Kmem = wsal(WSO_memn + (2UL * 1024 * 1024 * 2));
constexpr size_t WSO_Vmem = wsal(WSO_Kmem + (2UL * 1024 * 1024 * 2));
constexpr size_t WSO_kvc = wsal(WSO_Vmem + (2UL * 1024 * 1024 * 2));
constexpr size_t WSO_fgl = wsal(WSO_kvc + (2UL * 2048 * 64 * 2));
constexpr size_t WSO_cum = wsal(WSO_fgl + ((size_t)NTOK * 32 * 4));
constexpr size_t WSO_tokw = wsal(WSO_cum + (24UL * SEQ * 4));
constexpr size_t WSO_ssq = wsal(WSO_tokw + ((size_t)NTOK * 2 * 4));
constexpr size_t WSO_mlist = wsal(WSO_ssq + ((size_t)NTOK * 16 * 4));
constexpr size_t WSO_selm = wsal(WSO_mlist + (2UL * 24 * NTOK * 16));
constexpr size_t WS_TOTAL = wsal(WSO_selm + ((size_t)NTOK * 2 * 2 * 4));
struct Params {
  const float *x_in, *mem, *fox_b, *pool_w, *pool_scale, *pe_k, *pe_v, *w1k, *w1v, *w2k, *w2v, *gate_b;
  const float *mem_g, *rc_b, *rf_b, *final_g;
  float* xw;
  char* ws;
  __host__ __device__ __forceinline__ unsigned* bar() const { return (unsigned*)(ws + WSO_bar); }
  __host__ __device__ __forceinline__ int* mcnt() const { return (int*)(ws + WSO_mcnt); }
  __host__ __device__ __forceinline__ int* wq() const { return (int*)(ws + WSO_wq); }
  __host__ __device__ __forceinline__ int* mq() const { return (int*)(ws + WSO_mq); }
  __host__ __device__ __forceinline__ bf16_t* WinT() const { return (bf16_t*)(ws + WSO_WinT); }
  __host__ __device__ __forceinline__ bf16_t* WoutT() const { return (bf16_t*)(ws + WSO_WoutT); }
  __host__ __device__ __forceinline__ bf16_t* WqT() const { return (bf16_t*)(ws + WSO_WqT); }
  __host__ __device__ __forceinline__ bf16_t* WkT() const { return (bf16_t*)(ws + WSO_WkT); }
  __host__ __device__ __forceinline__ bf16_t* WvT() const { return (bf16_t*)(ws + WSO_WvT); }
  __host__ __device__ __forceinline__ bf16_t* WoT() const { return (bf16_t*)(ws + WSO_WoT); }
  __host__ __device__ __forceinline__ bf16_t* WguT() const { return (bf16_t*)(ws + WSO_WguT); }
  __host__ __device__ __forceinline__ bf16_t* WdT() const { return (bf16_t*)(ws + WSO_WdT); }
  __host__ __device__ __forceinline__ bf16_t* W1T() const { return (bf16_t*)(ws + WSO_W1T); }
  __host__ __device__ __forceinline__ bf16_t* WrT() const { return (bf16_t*)(ws + WSO_WrT); }
  __host__ __device__ __forceinline__ float* bias1() const { return (float*)(ws + WSO_bias1); }
  __host__ __device__ __forceinline__ bf16_t* hb() const { return (bf16_t*)(ws + WSO_hb); }
  __host__ __device__ __forceinline__ bf16_t* P() const { return (bf16_t*)(ws + WSO_P); }
  __host__ __device__ __forceinline__ bf16_t* cat() const { return (bf16_t*)(ws + WSO_cat); }
  __host__ __device__ __forceinline__ bf16_t* memn() const { return (bf16_t*)(ws + WSO_memn); }
  __host__ __device__ __forceinline__ bf16_t* Kmem() const { return (bf16_t*)(ws + WSO_Kmem); }
  __host__ __device__ __forceinline__ bf16_t* Vmem() const { return (bf16_t*)(ws + WSO_Vmem); }
  __host__ __device__ __forceinline__ bf16_t* kvc() const { return (bf16_t*)(ws + WSO_kvc); }
  __host__ __device__ __forceinline__ float* fgl() const { return (float*)(ws + WSO_fgl); }
  __host__ __device__ __forceinline__ float* cum() const { return (float*)(ws + WSO_cum); }
  __host__ __device__ __forceinline__ float* tokw() const { return (float*)(ws + WSO_tokw); }
  __host__ __device__ __forceinline__ float* ssq() const { return (float*)(ws + WSO_ssq); }
  __host__ __device__ __forceinline__ int* mlist() const { return (int*)(ws + WSO_mlist); }
  __host__ __device__ __forceinline__ unsigned* selm() const { return (unsigned*)(ws + WSO_selm); }
  __host__ __device__ __forceinline__ bf16_t* qx() const { return P(); }
  __host__ __device__ __forceinline__ bf16_t* ox() const { return P() + (size_t)NTOK * 1024; }
  __host__ __device__ __forceinline__ bf16_t* he() const { return P(); }
  __host__ __device__ __forceinline__ float* rpart() const { return (float*)(P() + (size_t)NTOK * 2048); }
  __host__ __device__ __forceinline__ float* onsa() const { return xw; }
  __host__ __device__ __forceinline__ float* hidp() const { return xw; }
  int never;
};
struct KArgs { Params p; TJob jobs[NJOBS]; int ttiles; int tmoe; int tdef; int jdef; };


#define XB_TMO      128
#define XB_XCNT(j)  (256  + 64 * (j))
#define XB_XSUB(j)  (1280 + 64 * (j))
#define XB_XGEN(j)  (2304 + 64 * (j))
#define XB_TOP      3328
#define XB_TOPGEN   3392
#define XCD_BAR_WORDS 3456
#define XB_SPIN_CAP (1u << 22)
__device__ __forceinline__ unsigned xb_ld(unsigned* p)              { return __hip_atomic_load(p, __ATOMIC_RELAXED, __HIP_MEMORY_SCOPE_AGENT); }
__device__ __forceinline__ unsigned xb_add(unsigned* p, unsigned v) { return __hip_atomic_fetch_add(p, v, __ATOMIC_RELAXED, __HIP_MEMORY_SCOPE_AGENT); }
__device__ __forceinline__ unsigned xb_xcc_id() { return (unsigned)__builtin_amdgcn_s_getreg((3 << 11) | 20) & 0xFu; }
#define XB_SPIN(cond, bar) do { unsigned _sp = 0; while (cond) { __builtin_amdgcn_s_sleep(1); \
    if ((++_sp & 255u) == 0u) { if (xb_ld(&(bar)[XB_TMO])) break; if (_sp > XB_SPIN_CAP) { atomicAdd(&(bar)[XB_TMO], 1u); break; } } } } while (0)
struct XcdBarrier { unsigned* bar; unsigned x; volatile LAS unsigned* st; };
__device__ __forceinline__ XcdBarrier xcd_barrier_post(unsigned* bar, volatile LAS unsigned* st) {
    XcdBarrier b; b.bar = bar; b.x = xb_xcc_id(); b.st = st;
    if (threadIdx.x == 0) (void)xb_add(&bar[XB_XCNT(b.x)], 1u);
    return b;
}
__device__ __forceinline__ void xcd_barrier_complete(unsigned* bar, unsigned x, unsigned& nloc, unsigned& nx) {
    const unsigned G = gridDim.x * gridDim.y * gridDim.z;
    unsigned sum, cnt, mine, sp = 0u;
    for (;;) {
        sum = 0u; cnt = 0u; mine = 0u;
#pragma unroll
        for (unsigned j = 0; j < 16; ++j) { const unsigned c = xb_ld(&bar[XB_XCNT(j)]); sum += c; cnt += (c > 0u) ? 1u : 0u; mine = (j == x) ? c : mine; }
        if (sum == G) break;
        __builtin_amdgcn_s_sleep(1);
        if ((++sp & 255u) == 0u) { if (xb_ld(&bar[XB_TMO])) break; if (sp > XB_SPIN_CAP) { atomicAdd(&bar[XB_TMO], 1u); break; } }
    }
    nloc = mine > 0u ? mine : 1u; nx = cnt > 0u ? cnt : 1u;
}
__device__ __forceinline__ void xcd_barrier(const XcdBarrier& b) {
    asm volatile("s_waitcnt vmcnt(0)" ::: "memory");
    __syncthreads();
    if (threadIdx.x == 0) {
        unsigned* bar = b.bar;
        unsigned bx = __builtin_amdgcn_readfirstlane(b.x); asm volatile("" : "+s"(bx));
        __builtin_amdgcn_s_waitcnt(0);
        unsigned nloc = b.st[0], nx = b.st[1];
        if (nloc == 0u) { xcd_barrier_complete(bar, bx, nloc, nx); b.st[0] = nloc; b.st[1] = nx; }
        const unsigned old = xb_add(&bar[XB_XSUB(bx)], 1u);
        const unsigned gen = old / nloc;
        if (old + 1u == (gen + 1u) * nloc) {
            __builtin_amdgcn_fence(__ATOMIC_RELEASE, "agent");
            asm volatile("s_waitcnt vmcnt(0)" ::: "memory");
            const unsigned og = xb_add(&bar[XB_TOP], 1u);
            const unsigned tg = og / nx;
            if (og + 1u == (tg + 1u) * nx) xb_add(&bar[XB_TOPGEN], 1u);
            else XB_SPIN(xb_ld(&bar[XB_TOPGEN]) == tg, bar);
            __builtin_amdgcn_fence(__ATOMIC_ACQUIRE, "agent");
            xb_add(&bar[XB_XGEN(bx)], 1u);
            asm volatile("s_waitcnt vmcnt(0)" ::: "memory");
        } else {
            XB_SPIN(xb_ld(&bar[XB_XGEN(bx)]) == gen, bar);
            __builtin_amdgcn_fence(__ATOMIC_ACQUIRE, "agent");
            asm volatile("s_waitcnt vmcnt(0)" ::: "memory");
        }
    }
    __syncthreads();
}

__device__ __forceinline__ int nmap(int map, int n) {
  if (map == 1) { if (n < 1152) return n; if (n < 1158) return 2560 + (n - 1152); if (n < 2566) return n - 6; return n; }
  if (map == 2) return 64 * (n >> 5) + (n & 31);
  if (map == 3) return 64 * (n >> 5) + 32 + (n & 31);
  return n;
}
__device__ __forceinline__ void tt_load(const TJob& j, int t, f32x4 (&v)[4]) {
  const int tid = otid();
  const int tb = t / j.tpb, tt = t - tb * j.tpb;
  const int nkt = j.K >> 6;
  const int kt = tt % nkt, nt = tt / nkt;
  const float* src = j.src + (long)tb * j.sbs + (long)(kt * 64) * j.lds + nt * 64;
  const int tk = tid >> 4, tn4 = tid & 15;
  const bool ok = (nt * 64 + tn4 * 4) < j.N;
#pragma unroll
  for (int i = 0; i < 4; ++i) { v[i] = (f32x4){0.f, 0.f, 0.f, 0.f}; if (ok) v[i] = *(const f32x4*)(src + (long)(tk + 16 * i) * j.lds + tn4 * 4); }
  if (j.g) {
#pragma unroll
    for (int i = 0; i < 4; ++i) v[i] *= j.g[(tb / j.gdiv) * DM + kt * 64 + tk + 16 * i];
  }
}
__device__ __forceinline__ void tt_finish(const TJob& j, int t, const f32x4 (&v)[4], LAS char* sm) {
  const int tid = otid();
  const int tb = t / j.tpb, tt = t - tb * j.tpb;
  const int nkt = j.K >> 6;
  const int kt = tt % nkt, nt = tt / nkt;
  bf16_t* dst = j.dst + (long)tb * j.dbs;
  LAS float* tile = (LAS float*)sm;
  {
    const int tk = tid >> 4, tn4 = tid & 15;
#pragma unroll
    for (int i = 0; i < 4; ++i) { const int k = tk + 16 * i;
      tile[k * 65 + tn4 * 4 + 0] = v[i][0]; tile[k * 65 + tn4 * 4 + 1] = v[i][1]; tile[k * 65 + tn4 * 4 + 2] = v[i][2]; tile[k * 65 + tn4 * 4 + 3] = v[i][3]; }
  }
  TSYNC();
  {
    const int n = tid >> 2, kq = tid & 3, ng = nt * 64 + n;
    if (ng < j.N) {
      const int row = nmap(j.map, ng);
      unsigned w[8];
#pragma unroll
      for (int c = 0; c < 8; ++c) w[c] = cvtpk(tile[(kq * 16 + 2 * c) * 65 + n], tile[(kq * 16 + 2 * c + 1) * 65 + n]);
      bf16_t* d = dst + kbo(j.R, row, kt * 64 + kq * 16);
      *(u32x4*)d = (u32x4){w[0], w[1], w[2], w[3]};
      *(u32x4*)(d + 8) = (u32x4){w[4], w[5], w[6], w[7]};
    }
  }
  TSYNC();
}

template <bool F32OUT>
__device__ __forceinline__ void rownorm(const float* x, const float* g, void* out, int nrows) {
  const int tid = otid(); const int lane = tid & 63;
  const int gw = vbid() * 4 + (tid >> 6), nw = nvb() * 4;
  for (int row = gw; row < nrows; row += nw) {
    const float* xr = x + (long)row * DM;
    f32x4 v[4]; float ss = 0.f;
#pragma unroll
    for (int i = 0; i < 4; ++i) { v[i] = *(const f32x4*)(xr + i * 256 + lane * 4); ss += v[i][0] * v[i][0] + v[i][1] * v[i][1] + v[i][2] * v[i][2] + v[i][3] * v[i][3]; }
#pragma unroll
    for (int o = 32; o >= 1; o >>= 1) ss += __shfl_xor(ss, o);
    const float rstd = 1.0f / sqrtf(ss * (1.0f / DM) + 1e-6f);
#pragma unroll
    for (int i = 0; i < 4; ++i) {
      const f32x4 gg = *(const f32x4*)(g + i * 256 + lane * 4);
      const f32x4 y = v[i] * rstd * gg;
      if (F32OUT) *(f32x4*)((float*)out + (long)row * DM + i * 256 + lane * 4) = y;
      else { u32x2 w; w.x = cvtpk(y[0], y[1]); w.y = cvtpk(y[2], y[3]); *(u32x2*)((bf16_t*)out + kbo(nrows, row, i * 256 + lane * 4)) = w; }
    }
  }
}

__device__ __forceinline__ float row_rstd(const float* ssq, long row) {
  const f32x4 a = *(const f32x4*)(ssq + row * 16), b = *(const f32x4*)(ssq + row * 16 + 4), c = *(const f32x4*)(ssq + row * 16 + 8), d = *(const f32x4*)(ssq + row * 16 + 12);
  const float t = ((a[0] + a[1]) + (a[2] + a[3])) + ((b[0] + b[1]) + (b[2] + b[3])) + ((c[0] + c[1]) + (c[2] + c[3])) + ((d[0] + d[1]) + (d[2] + d[3]));
  return 1.0f / sqrtf(t * (1.0f / DM) + 1e-6f);
}
__device__ __forceinline__ void rowprep(const float* x, bf16_t* xb, float* ssq, int nrows) {
  const int tid = otid(); const int lane = tid & 63;
  const int gw = vbid() * 4 + (tid >> 6), nw = nvb() * 4;
  for (int row = gw; row < nrows; row += nw) {
    const float* xr = x + (long)row * DM;
    f32x4 v[4]; float ss = 0.f;
#pragma unroll
    for (int i = 0; i < 4; ++i) { v[i] = *(const f32x4*)(xr + i * 256 + lane * 4); ss += v[i][0] * v[i][0] + v[i][1] * v[i][1] + v[i][2] * v[i][2] + v[i][3] * v[i][3]; }
#pragma unroll
    for (int o = 32; o >= 1; o >>= 1) ss += __shfl_xor(ss, o);
#pragma unroll
    for (int i = 0; i < 4; ++i) { u32x2 w; w.x = cvtpk(v[i][0], v[i][1]); w.y = cvtpk(v[i][2], v[i][3]); *(u32x2*)(xb + kbo(NTOK, row, i * 256 + lane * 4)) = w; }
    if (lane < 16) ssq[(long)row * 16 + lane] = lane == 0 ? ss : 0.f;
  }
}
struct RowKB { const bf16_t* base; long R; int r0; int s0;
  __device__ __forceinline__ const bf16_t* bptr() const { return base; }
  __device__ __forceinline__ unsigned rowoff(int r) const { return (unsigned)((r0 + r) * 32); }
  __device__ __forceinline__ long soff(int s) const { return (long)(s0 + s) * R * 32; } };
struct RowGather { const bf16_t* base; long R; LAS const int* toks;
  __device__ __forceinline__ const bf16_t* bptr() const { return base; }
  __device__ __forceinline__ unsigned rowoff(int r) const { int t = toks[r]; t = t < 0 ? 0 : t; return (unsigned)(t * 32); }
  __device__ __forceinline__ long soff(int s) const { return (long)s * R * 32; } };
struct RowCmp { const bf16_t* base; int r0; int kt0;
  __device__ __forceinline__ const bf16_t* bptr() const { return base; }
  __device__ __forceinline__ unsigned rowoff(int r) const { const int R = r0 + r; const int bg = R >> 8; int c = R & 255; c = c > 254 ? 254 : c;
    return (unsigned)(((bg >> 1) * SEQ + 16 * c) * PW + (bg & 1) * 64); }
  __device__ __forceinline__ long soff(int s) const { return (long)(kt0 + (s >> 1)) * PW + (s & 1) * 32; } };
struct RowSplitKB { const bf16_t* base; long R; int r0; long delta;
  __device__ __forceinline__ const bf16_t* bptr() const { return base; }
  __device__ __forceinline__ unsigned rowoff(int r) const { return (unsigned)((r0 + r) * 32); }
  __device__ __forceinline__ long soff(int s) const { return s < 16 ? (long)s * R * 32 : delta + (long)(s - 16) * R * 32; } };
__device__ __forceinline__ float gelu_tanh(float x) { const float u = 0.7978845608028654f * (x + 0.044715f * x * x * x); return 0.5f * x * (1.0f + tanhf(u)); }
__device__ __forceinline__ void finalnorm(const bf16_t* xb, const float* ssq, const float* g, float* out, int nrows) {
  const int tid = otid(); const int lane = tid & 63;
  const int gw = vbid() * 4 + (tid >> 6), nw = nvb() * 4;
  for (int row = gw; row < nrows; row += nw) {
    const float rs = row_rstd(ssq, row);
#pragma unroll
    for (int i = 0; i < 2; ++i) {
      const u32x4 w = *(const u32x4*)(xb + kbo(NTOK, row, i * 512 + lane * 8));
      const f32x4 g0 = *(const f32x4*)(g + i * 512 + lane * 8), g1 = *(const f32x4*)(g + i * 512 + lane * 8 + 4);
      float* op = out + (long)row * DM + i * 512 + lane * 8;
      *(f32x4*)op = (f32x4){__uint_as_float(w.x << 16) * rs * g0[0], __uint_as_float(w.x & 0xffff0000u) * rs * g0[1], __uint_as_float(w.y << 16) * rs * g0[2], __uint_as_float(w.y & 0xffff0000u) * rs * g0[3]};
      *(f32x4*)(op + 4) = (f32x4){__uint_as_float(w.z << 16) * rs * g1[0], __uint_as_float(w.z & 0xffff0000u) * rs * g1[1], __uint_as_float(w.w << 16) * rs * g1[2], __uint_as_float(w.w & 0xffff0000u) * rs * g1[3]};
    }
  }
}
#define GT_WAITBAR(N) asm volatile("s_waitcnt vmcnt(" #N ")\n\ts_barrier" ::: "memory")
template <class AF, class BF, class EPI, int EXPM = 0>
__device__ __forceinline__ void gemm_tile(LAS char* sm, int nkt, const AF& af, const BF& bfn, const EPI& epi) {
  const int tid = otid512(), lane = tid & 63, wid = __builtin_amdgcn_readfirstlane(tid >> 6), wm = wid >> 2, wn = wid & 3, l31 = lane & 31, hh = lane >> 5;
  const int lrow = tid >> 2;
  const int lkc = (tid & 3) ^ ((tid >> 4) & 3);
  unsigned ao[2], bo[2];
#pragma unroll
  for (int i = 0; i < 2; ++i) { ao[i] = (af.rowoff(lrow + 128 * i) + lkc * 8) * 2u; bo[i] = (bfn.rowoff(lrow + 128 * i) + lkc * 8) * 2u; }
  const char* abase = (const char*)af.bptr(); const char* bbase = (const char*)bfn.bptr();
  const int swz = (l31 >> 2) & 3;
  const int koff0 = ((hh ^ swz) << 4), koff1 = (((2 + hh) ^ swz) << 4);
  const int arow = (wm * 128 + l31) * 64, brow = 16384 + (wn * 64 + l31) * 64;
  f32x16 acc[4][2];
#pragma unroll
  for (int i = 0; i < 4; ++i)
#pragma unroll
    for (int j = 0; j < 2; ++j)
#pragma unroll
      for (int r = 0; r < 16; ++r) acc[i][j][r] = 0.f;
  LAS char* dst0 = sm + wid * 1024;
#define GT_ISSUE(st_) do { const int s__ = (st_); const long ka_ = af.soff(s__) * 2, kb_ = bfn.soff(s__) * 2; LAS char* d_ = dst0 + (s__ & 3) * 32768; \
    _Pragma("unroll") for (int i = 0; i < 2; ++i) { \
      __builtin_amdgcn_global_load_lds((const unsigned*)(abase + ka_ + ao[i]), (LAS unsigned*)(d_ + i * 8192), 16, 0, 0); \
      __builtin_amdgcn_global_load_lds((const unsigned*)(bbase + kb_ + bo[i]), (LAS unsigned*)(d_ + 16384 + i * 8192), 16, 0, 0); } } while (0)
  const int nst = 2 * nkt;
  __syncthreads();
  if (!(EXPM & 1)) { GT_ISSUE(0); GT_ISSUE(1); GT_ISSUE(2); }
  for (int st = 0; st < nst; ++st) {
    if (st + 2 < nst) GT_WAITBAR(8); else if (st + 1 < nst) GT_WAITBAR(4); else GT_WAITBAR(0);
    if (st + 3 < nst && !(EXPM & 1)) GT_ISSUE(st + 3);
    const int cur = (st & 3) * 32768;
    bf16x8 af4[2][4], bf2[2][2];
#pragma unroll
    for (int s2 = 0; s2 < 2; ++s2) {
      const int ko = s2 ? koff1 : koff0;
#pragma unroll
      for (int i = 0; i < 4; ++i) af4[s2][i] = *(LAS const bf16x8*)(sm + cur + arow + i * 2048 + ko);
#pragma unroll
      for (int j = 0; j < 2; ++j) bf2[s2][j] = *(LAS const bf16x8*)(sm + cur + brow + j * 2048 + ko);
    }
    __builtin_amdgcn_sched_barrier(0);
#pragma unroll
    for (int s2 = 0; s2 < 2; ++s2)
#pragma unroll
      for (int i = 0; i < 4; ++i)
#pragma unroll
        for (int j = 0; j < 2; ++j) acc[i][j] = __builtin_amdgcn_mfma_f32_32x32x16_bf16(bf2[s2][j], af4[s2][i], acc[i][j], 0, 0, 0);
  }
#undef GT_ISSUE
  __syncthreads();
  if (!(EXPM & 2)) epi(acc, wm, wn, lane, sm);
}

#define EPI_PITCH 576
__device__ __forceinline__ int epi_off(int row, int slot) { return row * EPI_PITCH + ((slot ^ ((row >> 2) & 7)) << 4); }
__device__ __forceinline__ void epi_put(LAS char* sm, int row, int c0, unsigned lo, unsigned hi) { *(LAS u32x2*)(sm + epi_off(row, c0 >> 3) + (c0 & 7) * 2) = (u32x2){lo, hi}; }

struct EpiInproj { bf16_t* P; float* fgl; const float* ssq; int mt, nt;
  __device__ __forceinline__ void operator()(f32x16 (&acc)[4][2], int wm, int wn, int lane, LAS char* sm) const {
    const int l31 = lane & 31, hh = lane >> 5;
    if (nt >= 10) {
#pragma unroll
      for (int i = 0; i < 4; ++i) {
        const long row = mt * 256 + wm * 128 + i * 32 + l31; const float rs = row_rstd(ssq, row);
#pragma unroll
        for (int j = 0; j < 2; ++j)
#pragma unroll
          for (int a = 0; a < 4; ++a) { const int c = wn * 64 + j * 32 + 8 * a + 4 * hh;
            if (c < 24) *(f32x4*)(fgl + row * 32 + c) = (f32x4){acc[i][j][4 * a] * rs, acc[i][j][4 * a + 1] * rs, acc[i][j][4 * a + 2] * rs, acc[i][j][4 * a + 3] * rs}; }
      }
      return;
    }
#pragma unroll
    for (int i = 0; i < 4; ++i) {
      const int rl = wm * 128 + i * 32 + l31; const float rs = row_rstd(ssq, mt * 256 + rl);
#pragma unroll
      for (int j = 0; j < 2; ++j)
#pragma unroll
        for (int a = 0; a < 4; ++a) epi_put(sm, rl, wn * 64 + j * 32 + 8 * a + 4 * hh, cvtpk(acc[i][j][4 * a] * rs, acc[i][j][4 * a + 1] * rs), cvtpk(acc[i][j][4 * a + 2] * rs, acc[i][j][4 * a + 3] * rs));
    }
    __syncthreads();
    const int tid = otid512();
#pragma unroll
    for (int k = 0; k < 16; ++k) { const int q = tid + 512 * k; const int row = q >> 5, slot = q & 31;
      *(u32x4*)(P + (long)(mt * 256 + row) * PW + nt * 256 + slot * 8) = *(LAS const u32x4*)(sm + epi_off(row, slot)); }
  } };
struct EpiBf16 { bf16_t* out; long ld; int row0, col0; const float* ssq;
  __device__ __forceinline__ void operator()(f32x16 (&acc)[4][2], int wm, int wn, int lane, LAS char* sm) const {
    const int l31 = lane & 31, hh = lane >> 5;
#pragma unroll
    for (int i = 0; i < 4; ++i) {
      const int rl = wm * 128 + i * 32 + l31; const float rs = ssq ? row_rstd(ssq, row0 + rl) : 1.0f;
#pragma unroll
      for (int j = 0; j < 2; ++j)
#pragma unroll
        for (int a = 0; a < 4; ++a) epi_put(sm, rl, wn * 64 + j * 32 + 8 * a + 4 * hh, cvtpk(acc[i][j][4 * a] * rs, acc[i][j][4 * a + 1] * rs), cvtpk(acc[i][j][4 * a + 2] * rs, acc[i][j][4 * a + 3] * rs));
    }
    __syncthreads();
    const int tid = otid512();
#pragma unroll
    for (int k = 0; k < 16; ++k) { const int q = tid + 512 * k; const int row = q >> 5, slot = q & 31;
      *(u32x4*)(out + (long)(row0 + row) * ld + col0 + slot * 8) = *(LAS const u32x4*)(sm + epi_off(row, slot)); }
  } };
struct EpiF32 { float* out; long ld; int row0, col0;
  __device__ __forceinline__ void operator()(f32x16 (&acc)[4][2], int wm, int wn, int lane, LAS char*) const {
    const int l31 = lane & 31, hh = lane >> 5;
#pragma unroll
    for (int i = 0; i < 4; ++i) {
      float* rp = out + (long)(row0 + wm * 128 + i * 32 + l31) * ld + col0 + wn * 64 + 4 * hh;
#pragma unroll
      for (int j = 0; j < 2; ++j)
#pragma unroll
        for (int a = 0; a < 4; ++a) { const f32x4 v = (f32x4){acc[i][j][4 * a], acc[i][j][4 * a + 1], acc[i][j][4 * a + 2], acc[i][j][4 * a + 3]}; st16_sc1(rp + j * 32 + 8 * a, __builtin_bit_cast(u32x4, v)); }
    }
  } };
template <bool GATHER>
__device__ __forceinline__ void epi_resid_out(LAS char* sm, const float* basef, bf16_t* xb, float* ssq, int row0, int col0, LAS const int* toks) {
  const int tid = otid512(); const int sub = tid & 3, rlo = tid >> 2;
  long grow[2]; bool okr[2];
#pragma unroll
  for (int h = 0; h < 2; ++h) { const int rl = rlo + 128 * h; if (GATHER) { const int t = toks[rl]; okr[h] = t >= 0; grow[h] = t < 0 ? 0 : t; } else { okr[h] = true; grow[h] = row0 + rl; } }
#pragma unroll
  for (int g = 0; g < 4; ++g) {
    float sq[2] = {0.f, 0.f};
#pragma unroll
    for (int kk = 0; kk < 4; ++kk) { const int k = 4 * g + kk; const int kb = k >> 1, h = k & 1; const int rl = rlo + 128 * h;
      const u32x4 aw = *(LAS const u32x4*)(sm + epi_off(rl, kb * 4 + sub));
      const int col = col0 + kb * 32 + sub * 8;
      f32x4 b0, b1;
      if (basef) { b0 = *(const f32x4*)(basef + grow[h] * DM + col); b1 = *(const f32x4*)(basef + grow[h] * DM + col + 4); }
      else { const u32x4 bw = *(const u32x4*)(xb + kbo(NTOK, grow[h], col)); b0 = bf4lo(bw); b1 = bf4hi(bw); }
      const f32x4 a0 = bf4lo(aw), a1 = bf4hi(aw);
      u32x4 w; w.x = cvtpk(b0[0] + a0[0], b0[1] + a0[1]); w.y = cvtpk(b0[2] + a0[2], b0[3] + a0[3]); w.z = cvtpk(b1[0] + a1[0], b1[1] + a1[1]); w.w = cvtpk(b1[2] + a1[2], b1[3] + a1[3]);
      if (okr[h]) *(u32x4*)(xb + kbo(NTOK, grow[h], col)) = w;
      const f32x4 v0 = bf4lo(w), v1 = bf4hi(w);
      sq[h] += ((v0[0] * v0[0] + v0[1] * v0[1]) + (v0[2] * v0[2] + v0[3] * v0[3])) + ((v1[0] * v1[0] + v1[1] * v1[1]) + (v1[2] * v1[2] + v1[3] * v1[3])); }
#pragma unroll
    for (int h = 0; h < 2; ++h) { float t = sq[h]; t += __shfl_xor(t, 1); t += __shfl_xor(t, 2); if (sub == 0 && okr[h]) ssq[grow[h] * 16 + (col0 >> 6) + g] = t; }
  }
}
struct EpiResid { const float* basef; bf16_t* xb; float* ssq; int row0, col0;
  __device__ __forceinline__ void operator()(f32x16 (&acc)[4][2], int wm, int wn, int lane, LAS char* sm) const {
    const int l31 = lane & 31, hh = lane >> 5;
#pragma unroll
    for (int i = 0; i < 4; ++i) { const int rl = wm * 128 + i * 32 + l31;
#pragma unroll
      for (int j = 0; j < 2; ++j)
#pragma unroll
        for (int a = 0; a < 4; ++a) epi_put(sm, rl, wn * 64 + j * 32 + 8 * a + 4 * hh, cvtpk(acc[i][j][4 * a], acc[i][j][4 * a + 1]), cvtpk(acc[i][j][4 * a + 2], acc[i][j][4 * a + 3])); }
    __syncthreads();
    epi_resid_out<false>(sm, basef, xb, ssq, row0, col0, nullptr);
  } };
struct EpiMoeUp { bf16_t* he; long herow0; int hcol0; LAS const float* wts; LAS const float* rsd;
  __device__ __forceinline__ void operator()(f32x16 (&acc)[4][2], int wm, int wn, int lane, LAS char* sm) const {
    const int l31 = lane & 31, hh = lane >> 5;
#pragma unroll
    for (int i = 0; i < 4; ++i) {
      const int rl = wm * 128 + i * 32 + l31; const float wt = wts[rl]; const float rs = rsd[rl];
#pragma unroll
      for (int a = 0; a < 4; ++a) {
        float v[4];
#pragma unroll
        for (int e = 0; e < 4; ++e) { const float gte = acc[i][0][4 * a + e] * rs, up = acc[i][1][4 * a + e] * rs; v[e] = gte * sigmoidf_(gte) * up * wt; }
        epi_put(sm, rl, wn * 32 + 8 * a + 4 * hh, cvtpk(v[0], v[1]), cvtpk(v[2], v[3]));
      }
    }
    __syncthreads();
    const int tid = otid512(); const int sub = tid & 3, rlo = tid >> 2;
#pragma unroll
    for (int k = 0; k < 8; ++k) { const int kb = k >> 1, rl = rlo + 128 * (k & 1);
      st16_sc1(he + kbo(HE_ROWS, herow0 + rl, hcol0 + kb * 32 + sub * 8), *(LAS const u32x4*)(sm + epi_off(rl, kb * 4 + sub))); }
  } };
struct EpiMoeDown { bf16_t* xb; float* ssq; int col0; LAS const int* toks;
  __device__ __forceinline__ void operator()(f32x16 (&acc)[4][2], int wm, int wn, int lane, LAS char* sm) const {
    const int l31 = lane & 31, hh = lane >> 5;
#pragma unroll
    for (int i = 0; i < 4; ++i) { const int rl = wm * 128 + i * 32 + l31;
#pragma unroll
      for (int j = 0; j < 2; ++j)
#pragma unroll
        for (int a = 0; a < 4; ++a) epi_put(sm, rl, wn * 64 + j * 32 + 8 * a + 4 * hh, cvtpk(acc[i][j][4 * a], acc[i][j][4 * a + 1]), cvtpk(acc[i][j][4 * a + 2], acc[i][j][4 * a + 3])); }
    __syncthreads();
    epi_resid_out<true>(sm, nullptr, xb, ssq, 0, col0, toks);
  } };
struct EpiRouterPart { float* part; int row0;
  __device__ __forceinline__ void operator()(f32x16 (&acc)[4][2], int wm, int wn, int lane, LAS char*) const {
    const int l31 = lane & 31, hh = lane >> 5;
    if (wn != 0) return;
#pragma unroll
    for (int i = 0; i < 4; ++i) {
      float* rp = part + (long)(row0 + wm * 128 + i * 32 + l31) * 32 + 4 * hh;
#pragma unroll
      for (int a = 0; a < 3; ++a) { const f32x4 v = (f32x4){acc[i][0][4 * a], acc[i][0][4 * a + 1], acc[i][0][4 * a + 2], acc[i][0][4 * a + 3]}; st16_sc1(rp + 8 * a, __builtin_bit_cast(u32x4, v)); }
    }
  } };

template <int NKS> __device__ __forceinline__ int kswz(int kc, int row) {
  if (NKS == 4) return kc ^ ((row >> 1) & 7);
  return (kc & 16) | ((kc & 15) ^ (row & 15));
}
__device__ __forceinline__ void qk_tile64(f32x16& p0, f32x16& p1, const bf16x8* qf, LAS const char* Ks, int lane) {
  const int l31 = lane & 31, hh = lane >> 5;
#pragma unroll
  for (int r = 0; r < 16; ++r) { p0[r] = 0.f; p1[r] = 0.f; }
#pragma unroll
  for (int ds = 0; ds < 4; ++ds) {
    const int so = kswz<4>(2 * ds + hh, l31) << 4;
    const bf16x8 k0 = *(LAS const bf16x8*)(Ks + l31 * 128 + so);
    const bf16x8 k1 = *(LAS const bf16x8*)(Ks + (32 + l31) * 128 + so);
    p0 = __builtin_amdgcn_mfma_f32_32x32x16_bf16(k0, qf[ds], p0, 0, 0, 0);
    p1 = __builtin_amdgcn_mfma_f32_32x32x16_bf16(k1, qf[ds], p1, 0, 0, 0);
  }
}
__device__ __forceinline__ void qk_tile256(f32x16& p0, f32x16& p1, const bf16x8* qf, LAS const char* Ks, int lane) {
  const int l31 = lane & 31, hh = lane >> 5;
#pragma unroll
  for (int r = 0; r < 16; ++r) { p0[r] = 0.f; p1[r] = 0.f; }
#pragma unroll
  for (int ds = 0; ds < 16; ++ds) {
    const int so = kswz<16>(2 * ds + hh, l31) << 4;
    const bf16x8 k0 = *(LAS const bf16x8*)(Ks + l31 * 512 + so);
    const bf16x8 k1 = *(LAS const bf16x8*)(Ks + (32 + l31) * 512 + so);
    p0 = __builtin_amdgcn_mfma_f32_32x32x16_bf16(k0, qf[ds], p0, 0, 0, 0);
    p1 = __builtin_amdgcn_mfma_f32_32x32x16_bf16(k1, qf[ds], p1, 0, 0, 0);
    if ((ds & 3) == 3) __builtin_amdgcn_sched_barrier(0);
  }
}
template <int NDT>
__device__ __forceinline__ void softmax_tile(f32x16& p0, f32x16& p1, float& m, float& l, f32x16* O, bf16x8* pb) {
  float mx = fmaxf(p0[0], p1[0]);
#pragma unroll
  for (int r = 1; r < 16; ++r) mx = fmaxf(mx, fmaxf(p0[r], p1[r]));
  mx = fmaxf(mx, __shfl_xor(mx, 32));
  if (__builtin_amdgcn_ballot_w64(mx > m) != 0ull) {
    const float mn = fmaxf(m, mx);
    const float mu = (mn == -INFINITY) ? 0.f : mn;
    const float alpha = fexp2(m - mu);
    l *= alpha; m = mn;
#pragma unroll
    for (int dt = 0; dt < NDT; ++dt)
#pragma unroll
      for (int r = 0; r < 16; ++r) O[dt][r] *= alpha;
  }
  const float mu = (m == -INFINITY) ? 0.f : m;
  float rs = 0.f;
#pragma unroll
  for (int r = 0; r < 16; ++r) { p0[r] = fexp2(p0[r] - mu); rs += p0[r]; }
#pragma unroll
  for (int r = 0; r < 16; ++r) { p1[r] = fexp2(p1[r] - mu); rs += p1[r]; }
  l += rs;
  u32x4 w;
  w = (u32x4){cvtpk(p0[0], p0[1]), cvtpk(p0[2], p0[3]), cvtpk(p0[4], p0[5]), cvtpk(p0[6], p0[7])}; pb[0] = __builtin_bit_cast(bf16x8, w);
  w = (u32x4){cvtpk(p0[8], p0[9]), cvtpk(p0[10], p0[11]), cvtpk(p0[12], p0[13]), cvtpk(p0[14], p0[15])}; pb[1] = __builtin_bit_cast(bf16x8, w);
  w = (u32x4){cvtpk(p1[0], p1[1]), cvtpk(p1[2], p1[3]), cvtpk(p1[4], p1[5]), cvtpk(p1[6], p1[7])}; pb[2] = __builtin_bit_cast(bf16x8, w);
  w = (u32x4){cvtpk(p1[8], p1[9]), cvtpk(p1[10], p1[11]), cvtpk(p1[12], p1[13]), cvtpk(p1[14], p1[15])}; pb[3] = __builtin_bit_cast(bf16x8, w);
}
template <int NDT>
__device__ __forceinline__ void pv_tile(f32x16* O, const bf16x8* pb, LAS const char* Vs, int lane) {
  const int hh = lane >> 5;
  const int vlane = (4 * hh + ((lane & 15) >> 2)) * 64 + (((lane >> 4) & 1) * 16 + (lane & 3) * 4) * 2;
#pragma unroll
  for (int dt = 0; dt < NDT; dt += 2) {
    s16x4 lo[2][4], hi[2][4];
#pragma unroll
    for (int d2 = 0; d2 < 2; ++d2)
#pragma unroll
      for (int ks = 0; ks < 4; ++ks) {
        LAS const char* vp = Vs + (dt + d2) * 4096 + ks * 16 * 64 + vlane;
        lo[d2][ks] = __builtin_amdgcn_ds_read_tr16_b64_v4i16((LAS s16x4*)vp);
        hi[d2][ks] = __builtin_amdgcn_ds_read_tr16_b64_v4i16((LAS s16x4*)(vp + 8 * 64));
      }
    __builtin_amdgcn_sched_barrier(0);
#pragma unroll
    for (int ks = 0; ks < 4; ++ks)
#pragma unroll
      for (int d2 = 0; d2 < 2; ++d2) {
        const bf16x8 vf = (bf16x8){lo[d2][ks][0], lo[d2][ks][1], lo[d2][ks][2], lo[d2][ks][3], hi[d2][ks][0], hi[d2][ks][1], hi[d2][ks][2], hi[d2][ks][3]};
        O[dt + d2] = __builtin_amdgcn_mfma_f32_32x32x16_bf16(vf, pb[ks], O[dt + d2], 0, 0, 0);
      }
  }
}
__device__ __forceinline__ void k_fetch64(bf16x8* kf, LAS const char* Ks, int lane) {
  const int l31 = lane & 31, hh = lane >> 5;
#pragma unroll
  for (int ds = 0; ds < 4; ++ds) {
    const int so = kswz<4>(2 * ds + hh, l31) << 4;
    kf[2 * ds] = *(LAS const bf16x8*)(Ks + l31 * 128 + so);
    kf[2 * ds + 1] = *(LAS const bf16x8*)(Ks + (32 + l31) * 128 + so);
  }
}
__device__ __forceinline__ void qk_mfma64(f32x16& p0, f32x16& p1, const bf16x8* kf, const bf16x8* qf) {
#pragma unroll
  for (int r = 0; r < 16; ++r) { p0[r] = 0.f; p1[r] = 0.f; }
#pragma unroll
  for (int ds = 0; ds < 4; ++ds) {
    p0 = __builtin_amdgcn_mfma_f32_32x32x16_bf16(kf[2 * ds], qf[ds], p0, 0, 0, 0);
    p1 = __builtin_amdgcn_mfma_f32_32x32x16_bf16(kf[2 * ds + 1], qf[ds], p1, 0, 0, 0);
  }
}
__device__ __forceinline__ void v_fetch64(s16x4* vlo, s16x4* vhi, LAS const char* Vs, int lane) {
  const int hh = lane >> 5;
  const int vlane = (4 * hh + ((lane & 15) >> 2)) * 64 + (((lane >> 4) & 1) * 16 + (lane & 3) * 4) * 2;
#pragma unroll
  for (int d2 = 0; d2 < 2; ++d2)
#pragma unroll
    for (int ks = 0; ks < 4; ++ks) {
      LAS const char* vp = Vs + d2 * 4096 + ks * 16 * 64 + vlane;
      vlo[d2 * 4 + ks] = __builtin_amdgcn_ds_read_tr16_b64_v4i16((LAS s16x4*)vp);
      vhi[d2 * 4 + ks] = __builtin_amdgcn_ds_read_tr16_b64_v4i16((LAS s16x4*)(vp + 8 * 64));
    }
}
__device__ __forceinline__ void pv_mfma64(f32x16* O, const bf16x8* pb, const s16x4* vlo, const s16x4* vhi) {
#pragma unroll
  for (int ks = 0; ks < 4; ++ks)
#pragma unroll
    for (int d2 = 0; d2 < 2; ++d2) {
      const s16x4 lo = vlo[d2 * 4 + ks], hi = vhi[d2 * 4 + ks];
      const bf16x8 vf = (bf16x8){lo[0], lo[1], lo[2], lo[3], hi[0], hi[1], hi[2], hi[3]};
      O[d2] = __builtin_amdgcn_mfma_f32_32x32x16_bf16(vf, pb[ks], O[d2], 0, 0, 0);
    }
}
struct TLRange { int n, kv_last; __device__ __forceinline__ int count() const { return n; } __device__ __forceinline__ int kv0(int i) const { return kv_last - 64 * i; } };
struct TLList { int n; LAS const int* lst; __device__ __forceinline__ int count() const { return n; } __device__ __forceinline__ int kv0(int i) const { return lst[i]; } };

struct SMFox { float cq; const float* ck; int tq; int tqmax;
  static constexpr bool EXTRA = true;
  __device__ __forceinline__ bool active(int kv0) const { return kv0 <= tqmax; }
  __device__ __forceinline__ bool full(int kv0) const { return kv0 + 63 <= tqmax - 31; }
  __device__ __forceinline__ const float* xsrc(int kv0, int lane) const { return ck + kv0 + lane; }
  template <bool MASK> __device__ __forceinline__ void apply(f32x16& p0, f32x16& p1, int kv0, int lane, LAS const char* xs_) const {
    const int hh = lane >> 5; const float C = 0.125f * LOG2E;
    const int db = tq - kv0 - 4 * hh;
    LAS const float* cp = (LAS const float*)xs_ + 4 * hh;
#pragma unroll
    for (int a = 0; a < 4; ++a) {
      const f32x4 c0 = *(LAS const f32x4*)(cp + 8 * a);
      const f32x4 c1 = *(LAS const f32x4*)(cp + 32 + 8 * a);
#pragma unroll
      for (int e = 0; e < 4; ++e) {
        const int c = 8 * a + e;
        const float s0 = __builtin_fmaf(p0[4 * a + e], C, cq - c0[e]), s1 = __builtin_fmaf(p1[4 * a + e], C, cq - c1[e]);
        p0[4 * a + e] = (!MASK || db >= c) ? s0 : -INFINITY;
        p1[4 * a + e] = (!MASK || db >= c + 32) ? s1 : -INFINITY;
      }
    }
  }
  __device__ __forceinline__ float tabval(int) const { return 0.f; }
  __device__ __forceinline__ float tsh(int) const { return 0.f; }
  __device__ __forceinline__ bool fullp(int kv0) const { return full(kv0); }
  __device__ __forceinline__ bool rowvalid(int) const { return true; }
  __device__ __forceinline__ void maskp(f32x16& p0, f32x16& p1, int kv0, int lane) const {
    const float NI = ninf_v();
    const int db = tq - kv0 - 4 * (lane >> 5);
#pragma unroll
    for (int r = 0; r < 16; ++r) { const int c = (r & 3) + 8 * (r >> 2); if (db < c) p0[r] = NI; if (db < c + 32) p1[r] = NI; }
  } };
struct SMWin { int tq; float slope2; int tqmax;
  static constexpr bool EXTRA = false;
  __device__ __forceinline__ const float* xsrc(int, int) const { return nullptr; }
  __device__ __forceinline__ bool active(int kv0) const { return kv0 <= tqmax && kv0 + 63 + 512 > tqmax - 31; }
  __device__ __forceinline__ bool full(int kv0) const { return kv0 + 63 <= tqmax - 31 && tqmax - kv0 < 512; }
  template <bool MASK> __device__ __forceinline__ void apply(f32x16& p0, f32x16& p1, int kv0, int lane, LAS const char*) const {
    const int hh = lane >> 5; const float C = 0.125f * LOG2E;
    const int db = tq - kv0 - 4 * hh; const float sb = -slope2 * (float)db;
#pragma unroll
    for (int r = 0; r < 16; ++r) {
      const int c = (r & 3) + 8 * (r >> 2);
      const int d0 = db - c, d1 = db - c - 32;
      const float s0 = __builtin_fmaf(p0[r], C, __builtin_fmaf(slope2, (float)c, sb)), s1 = __builtin_fmaf(p1[r], C, __builtin_fmaf(slope2, (float)(c + 32), sb));
      p0[r] = (!MASK || (d0 >= 0 && d0 < 512)) ? s0 : -INFINITY;
      p1[r] = (!MASK || (d1 >= 0 && d1 < 512)) ? s1 : -INFINITY;
    }
  }
  __device__ __forceinline__ float tabval(int j) const { return slope2 * (float)j * (8.0f / LOG2E); }
  __device__ __forceinline__ float tsh(int kv0) const { return slope2 * (float)kv0; }
  __device__ __forceinline__ bool fullp(int kv0) const { return full(kv0); }
  __device__ __forceinline__ bool rowvalid(int) const { return true; }
  __device__ __forceinline__ void maskp(f32x16& p0, f32x16& p1, int kv0, int lane) const {
    const float NI = ninf_v();
    const int db = tq - kv0 - 4 * (lane >> 5);
#pragma unroll
    for (int r = 0; r < 16; ++r) { const int c = (r & 3) + 8 * (r >> 2); if ((unsigned)(db - c) >= 512u) p0[r] = NI; if ((unsigned)(db - c - 32) >= 512u) p1[r] = NI; }
  } };
struct SMSel { int tq; float slope2; LAS const unsigned* msk; int tqmax;
  static constexpr bool EXTRA = false;
  __device__ __forceinline__ const float* xsrc(int, int) const { return nullptr; }
  __device__ __forceinline__ bool selbit(int kv0) const { const int j = kv0 >> 6;
    const int ln = lane_id_v();
    return ((msk[(j >> 5) * 64 + ln] >> (j & 31)) & 1u) != 0u; }
  __device__ __forceinline__ bool active(int kv0) const { return kv0 <= tqmax && __builtin_amdgcn_ballot_w64(selbit(kv0)) != 0ull; }
  __device__ __forceinline__ bool full(int kv0) const { return kv0 + 63 <= tqmax - 31 && __builtin_amdgcn_ballot_w64(!selbit(kv0)) == 0ull; }
  template <bool MASK> __device__ __forceinline__ void apply(f32x16& p0, f32x16& p1, int kv0, int lane, LAS const char*) const {
    const int hh = lane >> 5; const float C = 0.125f * LOG2E;
    const int dbr = tq - kv0 - 4 * hh;
    const int db = (!MASK || selbit(kv0)) ? dbr : -1; const float sb = -slope2 * (float)dbr;
#pragma unroll
    for (int r = 0; r < 16; ++r) {
      const int c = (r & 3) + 8 * (r >> 2);
      const float s0 = __builtin_fmaf(p0[r], C, __builtin_fmaf(slope2, (float)c, sb)), s1 = __builtin_fmaf(p1[r], C, __builtin_fmaf(slope2, (float)(c + 32), sb));
      p0[r] = (!MASK || db >= c) ? s0 : -INFINITY;
      p1[r] = (!MASK || db >= c + 32) ? s1 : -INFINITY;
    }
  }
  __device__ __forceinline__ float tabval(int j) const { return slope2 * (float)j * (8.0f / LOG2E); }
  __device__ __forceinline__ float tsh(int kv0) const { return slope2 * (float)kv0; }
  __device__ __forceinline__ bool fullp(int kv0) const { return kv0 + 63 <= tqmax - 31; }
  __device__ __forceinline__ bool rowvalid(int kv0) const { return selbit(kv0); }
  __device__ __forceinline__ void maskp(f32x16& p0, f32x16& p1, int kv0, int) const {
    const float NI = ninf_v();
    const int ln = lane_id_v();
    const int db = (tqmax - 31 + (ln & 31)) - kv0 - 4 * (ln >> 5);
#pragma unroll
    for (int r = 0; r < 16; ++r) { const int c = (r & 3) + 8 * (r >> 2); if (db < c) p0[r] = NI; if (db < c + 32) p1[r] = NI; }
  } };
struct SMCmp { int tq; float slope2; int tqmax;
  static constexpr bool EXTRA = false;
  __device__ __forceinline__ const float* xsrc(int, int) const { return nullptr; }
  __device__ __forceinline__ bool active(int kv0) const { return 16 * kv0 + 31 <= tqmax; }
  __device__ __forceinline__ bool full(int kv0) const { return 16 * (kv0 + 63) + 31 <= tqmax - 31; }
  template <bool MASK> __device__ __forceinline__ void apply(f32x16& p0, f32x16& p1, int kv0, int lane, LAS const char*) const {
    const int hh = lane >> 5; const float C = 0.125f * LOG2E;
    const int db = tq - 31 - 16 * kv0 - 64 * hh; const float sb = -slope2 * (float)db;
#pragma unroll
    for (int r = 0; r < 16; ++r) {
      const int c = 16 * ((r & 3) + 8 * (r >> 2));
      const float s0 = __builtin_fmaf(p0[r], C, __builtin_fmaf(slope2, (float)c, sb)), s1 = __builtin_fmaf(p1[r], C, __builtin_fmaf(slope2, (float)(c + 512), sb));
      p0[r] = (!MASK || db >= c) ? s0 : -INFINITY;
      p1[r] = (!MASK || db >= c + 512) ? s1 : -INFINITY;
    }
  }
  __device__ __forceinline__ float tabval(int j) const { return slope2 * (float)(16 * j) * (8.0f / LOG2E); }
  __device__ __forceinline__ float tsh(int kv0) const { return slope2 * (float)(16 * kv0); }
  __device__ __forceinline__ bool fullp(int kv0) const { return full(kv0); }
  __device__ __forceinline__ bool rowvalid(int) const { return true; }
  __device__ __forceinline__ void maskp(f32x16& p0, f32x16& p1, int kv0, int lane) const {
    const float NI = ninf_v();
    const int db = tq - 31 - 16 * kv0 - 64 * (lane >> 5);
#pragma unroll
    for (int r = 0; r < 16; ++r) { const int c = 16 * ((r & 3) + 8 * (r >> 2)); if (db < c) p0[r] = NI; if (db < c + 512) p1[r] = NI; }
  } };

#define FL_STAGE 16896
#define g_flx (((LAS const int*)((LAS const char*)lds_dyn + LDS_XS))[500] != 0)
__device__ __forceinline__ void glds16(const void* g, LAS void* dst) {
  unsigned sv; const unsigned base = (unsigned)__builtin_amdgcn_readfirstlane((int)(unsigned long)dst);
  asm volatile("s_mov_b32 %0, m0\n\ts_mov_b32 m0, %2\n\ts_nop 0\n\tglobal_load_lds_dwordx4 %1, off\n\ts_mov_b32 m0, %0" : "=&s"(sv) : "v"(g), "s"(base) : "memory");
}
__device__ __forceinline__ void glds4(const void* g, LAS void* dst) {
  unsigned sv; const unsigned base = (unsigned)__builtin_amdgcn_readfirstlane((int)(unsigned long)dst);
  asm volatile("s_mov_b32 %0, m0\n\ts_mov_b32 m0, %2\n\ts_nop 0\n\tglobal_load_lds_dword %1, off\n\ts_mov_b32 m0, %0" : "=&s"(sv) : "v"(g), "s"(base) : "memory");
}
__device__ __forceinline__ const void* uni64(const void* q) {
  const unsigned long long v = (unsigned long long)q;
  const unsigned lo = (unsigned)__builtin_amdgcn_readfirstlane((int)(unsigned)v), hi = (unsigned)__builtin_amdgcn_readfirstlane((int)(unsigned)(v >> 32));
  return (const void*)(((unsigned long long)hi << 32) | lo);
}
__device__ __forceinline__ void glds16s(const void* sbase_, unsigned voff, LAS void* dst) {
  const void* sbase = uni64(sbase_);
  unsigned sv; const unsigned base = (unsigned)__builtin_amdgcn_readfirstlane((int)(unsigned long)dst);
  asm volatile("s_mov_b32 %0, m0\n\ts_mov_b32 m0, %3\n\ts_nop 0\n\tglobal_load_lds_dwordx4 %1, %2\n\ts_mov_b32 m0, %0" : "=&s"(sv) : "v"(voff), "s"(sbase), "s"(base) : "memory");
}
__device__ __forceinline__ void glds4s(const void* sbase_, unsigned voff, LAS void* dst) {
  const void* sbase = uni64(sbase_);
  unsigned sv; const unsigned base = (unsigned)__builtin_amdgcn_readfirstlane((int)(unsigned long)dst);
  asm volatile("s_mov_b32 %0, m0\n\ts_mov_b32 m0, %3\n\ts_nop 0\n\tglobal_load_lds_dword %1, %2\n\ts_mov_b32 m0, %0" : "=&s"(sv) : "v"(voff), "s"(sbase), "s"(base) : "memory");
}
template <int N> __device__ __forceinline__ void fl_waitbar() {
  if (N == 0) asm volatile("s_waitcnt vmcnt(0)\n\ts_barrier" ::: "memory");
  else if (N == 2) asm volatile("s_waitcnt vmcnt(2)\n\ts_barrier" ::: "memory");
  else if (N == 3) asm volatile("s_waitcnt vmcnt(3)\n\ts_barrier" ::: "memory");
  else if (N == 4) asm volatile("s_waitcnt vmcnt(4)\n\ts_barrier" ::: "memory");
  else if (N == 6) asm volatile("s_waitcnt vmcnt(6)\n\ts_barrier" ::: "memory");
  else if (N == 8) asm volatile("s_waitcnt vmcnt(8)\n\ts_barrier" ::: "memory");
  else asm volatile("s_waitcnt vmcnt(12)\n\ts_barrier" ::: "memory");
}
template <int NSTG, class SM, class TL>
__device__ __forceinline__ void flash_run64(LAS char* sm, const bf16x8* qf, const bf16_t* Kb, long ldk, const bf16_t* Vb, long ldv,
                                            const TL& tl, const SM& smod, float& m, float& l, f32x16* O) {
  const int n = tl.count();
  if (n <= 0) return;
  constexpr int DPT = SM::EXTRA ? 3 : 2;
  const int tid = otid512(), lane = tid & 63, wid = __builtin_amdgcn_readfirstlane(tid >> 6);
  const int krow = tid >> 3;
  const bf16_t* ksrc = Kb + (long)krow * ldk + (((tid & 7) ^ ((krow >> 1) & 7)) * 8);
  const bf16_t* vsrc = Vb + (long)((tid & 255) >> 2) * ldv + (((tid >> 8) * 4 + (tid & 3)) * 8);
  LAS char* kd0 = sm + wid * 1024;
#define FL_ISSUE(i_) do { if ((FLEXP & 16) && g_flx) break; const int i__ = (i_); const int kv__ = tl.kv0(i__); LAS char* d__ = kd0 + (i__ % NSTG) * FL_STAGE; \
    glds16(ksrc + (long)kv__ * ldk, d__); \
    glds16(vsrc + (long)kv__ * ldv, d__ + 8192); \
    if (SM::EXTRA) glds4(smod.xsrc(kv__, lane), sm + (i__ % NSTG) * FL_STAGE + 16384); } while (0)
  __syncthreads();
#pragma unroll
  for (int i = 0; i < NSTG - 1; ++i) if (i < n) FL_ISSUE(i);
  { const int later = min(n - 1, NSTG - 2);
    if (later >= 2) fl_waitbar<2 * DPT>(); else if (later == 1) fl_waitbar<DPT>(); else fl_waitbar<0>(); }
  if (NSTG - 1 < n) FL_ISSUE(NSTG - 1);
  f32x16 pc0, pc1, pn0, pn1;
  int kv_cur = tl.kv0(0);
  bool act_cur = smod.active(kv_cur), act_next = false;
  if (act_cur) qk_tile64(pc0, pc1, qf, sm, lane);
  int st_cur = 0;
  for (int it = 0; it < n; ++it) {
    const int st_next = st_cur == NSTG - 1 ? 0 : st_cur + 1;
    int kv_next = 0;
    if (it + 1 < n) {
      kv_next = tl.kv0(it + 1);
      const int later = min(n - 1, it + NSTG - 2) - (it + 1);
      if (!((FLEXP & 32) && g_flx)) { if (NSTG >= 4 && later >= 1) fl_waitbar<DPT>(); else fl_waitbar<0>(); }
      if (it + NSTG - 1 < n && it > 0) FL_ISSUE(it + NSTG - 1);
    }
    act_next = false;
    if (it + 1 < n) act_next = smod.active(kv_next);
    bf16x8 kf[8]; s16x4 vlo[8], vhi[8];
    LAS const char* sb_ = sm + st_cur * FL_STAGE;
    if (act_next) k_fetch64(kf, sm + st_next * FL_STAGE, lane);
    __builtin_amdgcn_sched_barrier(0);
    bf16x8 pb[4];
    if (act_cur) {
      if (smod.full(kv_cur)) smod.template apply<false>(pc0, pc1, kv_cur, lane, sb_ + 16384); else smod.template apply<true>(pc0, pc1, kv_cur, lane, sb_ + 16384);
      softmax_tile<2>(pc0, pc1, m, l, O, pb);
    }
    if (act_cur) v_fetch64(vlo, vhi, sb_ + 8192, lane);
    __builtin_amdgcn_sched_barrier(0);
    if (act_next) qk_mfma64(pn0, pn1, kf, qf);
    if (act_cur) pv_mfma64(O, pb, vlo, vhi);
    pc0 = pn0; pc1 = pn1; act_cur = act_next; kv_cur = kv_next; st_cur = st_next;
  }
#undef FL_ISSUE
}

#define FLK_SLOT 8448
#define FLV_BASE 25344
#define FL2_TAB 49920
#define FL_THR 6.0f
#define PIN(x) asm volatile("" : "+v"(x))
#define SBAR() __builtin_amdgcn_sched_barrier(0)
#define MX3(a, b, c) __builtin_fmaxf(__builtin_fmaxf((a), (b)), (c))
__device__ __forceinline__ void fl_waitbar2(int n) {
  if (n == 0) asm volatile("s_waitcnt vmcnt(0) lgkmcnt(0)\n\ts_barrier" ::: "memory");
  else if (n == 1) asm volatile("s_waitcnt vmcnt(1) lgkmcnt(0)\n\ts_barrier" ::: "memory");
  else if (n == 2) asm volatile("s_waitcnt vmcnt(2) lgkmcnt(0)\n\ts_barrier" ::: "memory");
  else if (n == 3) asm volatile("s_waitcnt vmcnt(3) lgkmcnt(0)\n\ts_barrier" ::: "memory");
  else if (n == 4) asm volatile("s_waitcnt vmcnt(4) lgkmcnt(0)\n\ts_barrier" ::: "memory");
  else asm volatile("s_waitcnt vmcnt(5) lgkmcnt(0)\n\ts_barrier" ::: "memory");
}
__device__ __forceinline__ float rowmax32(const f32x16& p0, const f32x16& p1) {
  float a = MX3(p0[0], p0[1], p1[0]), b = MX3(p0[2], p0[3], p1[1]); a = MX3(a, p1[2], p1[3]);
#pragma unroll
  for (int r = 4; r < 16; r += 4) { a = MX3(a, p0[r], p0[r + 1]); b = MX3(b, p0[r + 2], p0[r + 3]); a = MX3(a, p1[r], p1[r + 1]); b = MX3(b, p1[r + 2], p1[r + 3]); }
  const float mm = __builtin_fmaxf(a, b);
  auto rr = __builtin_amdgcn_permlane32_swap(__float_as_uint(mm), __float_as_uint(mm), false, false);
  return __builtin_fmaxf(__uint_as_float(rr[0]), __uint_as_float(rr[1]));
}
template <class SM, class TL>
__device__ __forceinline__ void flash_run64p(LAS char* sm, const bf16x8* qf, const bf16_t* Kb, long ldk, const bf16_t* Vb, long ldv,
                                             const TL& tl, const SM& smod, float& m, float& l, f32x16* O) {
  const int n = __builtin_amdgcn_readfirstlane(tl.count());
  if (n <= 0) return;
  constexpr int E = SM::EXTRA ? 1 : 0;
  constexpr float C = 0.125f * LOG2E;
  const int tid = otid512(), lane = tid & 63, wid = __builtin_amdgcn_readfirstlane(tid >> 6), l31 = lane & 31, hh = lane >> 5;
  const int krow = tid >> 3;
  const unsigned koffs = (unsigned)(krow * (int)ldk + (((tid & 7) ^ ((krow >> 1) & 7)) * 8)) * 2u;
  const unsigned voffs = (unsigned)(((tid & 255) >> 2) * (int)ldv + (((tid >> 8) * 4 + (tid & 3)) * 8)) * 2u;
  LAS char* kd0 = sm + wid * 1024;
  LAS char* vd0 = sm + FLV_BASE + wid * 1024;
#define FLP_ISSUE_K(i_, s_) do { const int kv__ = __builtin_amdgcn_readfirstlane(tl.kv0(i_)); \
    glds16s(Kb + (long)kv__ * ldk, koffs, kd0 + (s_) * FLK_SLOT); \
    if (E) glds4s(smod.xsrc(kv__, 0), (unsigned)lane * 4u, sm + (s_) * FLK_SLOT + 8192); } while (0)
#define FLP_ISSUE_V(i_, s_) do { const int kv__ = __builtin_amdgcn_readfirstlane(tl.kv0(i_)); \
    glds16s(Vb + (long)kv__ * ldv, voffs, vd0 + (s_) * 8192); } while (0)
  const int kx = (l31 >> 1) & 7;
  const int ko0 = l31 * 128 + ((hh ^ kx) << 4);
  const int vlane = (4 * hh + ((lane & 15) >> 2)) * 64 + (((lane >> 4) & 1) * 16 + (lane & 3) * 4) * 2;
  LAS const char* tabp = sm + FL2_TAB + hh * 16;
  __syncthreads();
  if (!E && tid < 64) ((LAS float*)(sm + FL2_TAB))[tid] = smod.tabval(tid);
  FLP_ISSUE_K(0, 0); FLP_ISSUE_V(0, 0);
  if (n > 1) FLP_ISSUE_K(1, 1);
  if (n > 2) FLP_ISSUE_K(2, 2);
  fl_waitbar2(1 + (n > 1 ? 1 + E : 0) + (n > 2 ? 1 + E : 0));
  f32x16 pA0, pA1, pB0, pB1; bf16x8 kf[8]; s16x4 vlo[8], vhi[8]; u32x4 pw0, pw1, pw2, pw3;
#define FLP_KLOAD(d0_, Ks_) do { const int ko__ = ko0 ^ (32 * (d0_)); \
    kf[2 * (d0_)] = *(LAS const bf16x8*)((Ks_) + ko__); kf[2 * (d0_) + 1] = *(LAS const bf16x8*)((Ks_) + ko__ + 4096); } while (0)
#define FLP_ILOAD(X0, X1, i_, ip_) do { const f32x4 t__ = *(LAS const f32x4*)((ip_) + ((i_) & 3) * 32 + ((i_) >> 2) * 128); \
    if ((i_) < 4) { X0[4 * ((i_) & 3)] = t__[0]; X0[4 * ((i_) & 3) + 1] = t__[1]; X0[4 * ((i_) & 3) + 2] = t__[2]; X0[4 * ((i_) & 3) + 3] = t__[3]; } \
    else { X1[4 * ((i_) & 3)] = t__[0]; X1[4 * ((i_) & 3) + 1] = t__[1]; X1[4 * ((i_) & 3) + 2] = t__[2]; X1[4 * ((i_) & 3) + 3] = t__[3]; } } while (0)
#define FLP_IPTR(s_) (E ? (LAS const char*)(sm + (s_) * FLK_SLOT + 8192 + hh * 16) : tabp)
  int t = 0, s_prev = 2, s_cur = 0, s_next = 1;
  int kv_cur = __builtin_amdgcn_readfirstlane(tl.kv0(0)), kv_next = n > 1 ? __builtin_amdgcn_readfirstlane(tl.kv0(1)) : 0;
  { LAS const char* Ks_ = sm; FLP_KLOAD(0, Ks_); FLP_KLOAD(1, Ks_); FLP_KLOAD(2, Ks_); FLP_KLOAD(3, Ks_);
    LAS const char* ip_ = FLP_IPTR(0);
    FLP_ILOAD(pA0, pA1, 0, ip_); FLP_ILOAD(pA0, pA1, 1, ip_); FLP_ILOAD(pA0, pA1, 2, ip_); FLP_ILOAD(pA0, pA1, 3, ip_);
    FLP_ILOAD(pA0, pA1, 4, ip_); FLP_ILOAD(pA0, pA1, 5, ip_); FLP_ILOAD(pA0, pA1, 6, ip_); FLP_ILOAD(pA0, pA1, 7, ip_); }
  fl_waitbar2(n > 2 ? 1 + E : 0);
#define PKW(P, i) cvtpk(P[i], P[i + 1])
#define PAF(k) __builtin_bit_cast(bf16x8, pw##k)
#define VFR(i) (bf16x8){vlo[i][0], vlo[i][1], vlo[i][2], vlo[i][3], vhi[i][0], vhi[i][1], vhi[i][2], vhi[i][3]}
#define VRD(i) do { vlo[i] = __builtin_amdgcn_ds_read_tr16_b64_v4i16((LAS s16x4*)(vp_ + (((i) & 1) * 4096 + ((i) >> 1) * 1024))); \
                    vhi[i] = __builtin_amdgcn_ds_read_tr16_b64_v4i16((LAS s16x4*)(vp_ + (((i) & 1) * 4096 + ((i) >> 1) * 1024 + 512))); } while (0)
#define VRDQ(i, q_) do { vlo[i] = __builtin_amdgcn_ds_read_tr16_b64_v4i16((LAS s16x4*)((q_) + (((i) & 1) * 4096 + ((i) >> 1) * 1024))); \
                    vhi[i] = __builtin_amdgcn_ds_read_tr16_b64_v4i16((LAS s16x4*)((q_) + (((i) & 1) * 4096 + ((i) >> 1) * 1024 + 512))); } while (0)
#define MFMA_(a, b, c) __builtin_amdgcn_mfma_f32_32x32x16_bf16(a, b, c, 0, 0, 0)
#define EX(v) fexp2(__builtin_fmaf((v), C, nmh))
#define GAPA(MF, a0, a1, a2, a3, W0, W1, PW) do { MF; sacc += a0; sacc += a1; sacc += a2; sacc += a3; W0; W1; PIN(PW); PIN(sacc); SBAR(); } while (0)
#define GAPB(MF, X, i) do { MF; X[i] = EX(X[i]); X[i + 1] = EX(X[i + 1]); X[i + 2] = EX(X[i + 2]); X[i + 3] = EX(X[i + 3]); PIN(X); SBAR(); } while (0)
#define FLP_MIDDLE(C0, C1) \
    if (__builtin_amdgcn_ballot_w64(!smod.fullp(kv_cur)) != 0ull) smod.maskp(C0, C1, kv_cur, lane); \
    const float tsh_ = smod.tsh(kv_cur); const bool rv_ = smod.rowvalid(kv_cur); \
    { const float g_ = rv_ ? __builtin_fmaf(rowmax32(C0, C1), C, tsh_) : -INFINITY; \
      if (__builtin_amdgcn_ballot_w64(g_ > m + FL_THR) != 0ull) { const float mn_ = __builtin_fmaxf(m, g_); const float mu_ = (mn_ == -INFINITY) ? 0.f : mn_; \
        alpha = fexp2(m - mu_); l *= alpha; m = mn_; resc = true; } } \
    const float nmh = rv_ ? tsh_ - ((m == -INFINITY) ? 0.f : m) : -INFINITY;
#define FLP_STEP(C0, C1, P0, P1) do { \
    if (t + 3 < n) FLP_ISSUE_K(t + 3, s_cur); \
    if (t + 1 < n) FLP_ISSUE_V(t + 1, s_next); \
    const int cnt_ = ((t + 3 < n) ? 1 + E : 0) + ((t + 1 < n) ? 1 : 0); \
    LAS const char* Ksn_ = sm + s_next * FLK_SLOT; LAS const char* vp_ = sm + FLV_BASE + s_prev * 8192 + vlane; LAS const char* ipn_ = FLP_IPTR(s_next); \
    bool resc = false; float alpha = 1.f; \
    SBAR(); \
    VRD(0); SBAR(); float sacc = P0[0] + P0[1]; \
                    GAPA(C0 = MFMA_(kf[0], qf[0], C0), P0[2], P0[3], P0[4], P0[5],     pw0[0] = PKW(P0, 0),  pw0[1] = PKW(P0, 2),  pw0); \
    VRD(1); SBAR(); GAPA(C1 = MFMA_(kf[1], qf[0], C1), P0[6], P0[7], P0[8], P0[9],     pw0[2] = PKW(P0, 4),  pw0[3] = PKW(P0, 6),  pw0); \
    VRD(2); SBAR(); GAPA(C0 = MFMA_(kf[2], qf[1], C0), P0[10], P0[11], P0[12], P0[13], pw1[0] = PKW(P0, 8),  pw1[1] = PKW(P0, 10), pw1); \
    VRD(3); SBAR(); GAPA(C1 = MFMA_(kf[3], qf[1], C1), P0[14], P0[15], P1[0], P1[1],   pw1[2] = PKW(P0, 12), pw1[3] = PKW(P0, 14), pw1); \
    VRD(4); SBAR(); GAPA(C0 = MFMA_(kf[4], qf[2], C0), P1[2], P1[3], P1[4], P1[5],     pw2[0] = PKW(P1, 0),  pw2[1] = PKW(P1, 2),  pw2); \
    VRD(5); SBAR(); GAPA(C1 = MFMA_(kf[5], qf[2], C1), P1[6], P1[7], P1[8], P1[9],     pw2[2] = PKW(P1, 4),  pw2[3] = PKW(P1, 6),  pw2); \
    VRD(6); SBAR(); GAPA(C0 = MFMA_(kf[6], qf[3], C0), P1[10], P1[11], P1[12], P1[13], pw3[0] = PKW(P1, 8),  pw3[1] = PKW(P1, 10), pw3); \
    VRD(7); SBAR(); GAPA(C1 = MFMA_(kf[7], qf[3], C1), P1[14], P1[15], 0.f, 0.f,       pw3[2] = PKW(P1, 12), pw3[3] = PKW(P1, 14), pw3); \
    l += sacc; \
    FLP_MIDDLE(C0, C1) \
    SBAR(); \
    FLP_ILOAD(P0, P1, 0, ipn_); SBAR(); GAPB(O[0] = MFMA_(VFR(0), PAF(0), O[0]), C0, 0); \
    FLP_ILOAD(P0, P1, 1, ipn_); SBAR(); GAPB(O[1] = MFMA_(VFR(1), PAF(0), O[1]), C0, 4); \
    FLP_ILOAD(P0, P1, 2, ipn_); FLP_KLOAD(0, Ksn_); SBAR(); GAPB(O[0] = MFMA_(VFR(2), PAF(1), O[0]), C0, 8); \
    FLP_ILOAD(P0, P1, 3, ipn_); FLP_KLOAD(1, Ksn_); SBAR(); GAPB(O[1] = MFMA_(VFR(3), PAF(1), O[1]), C0, 12); \
    FLP_ILOAD(P0, P1, 4, ipn_); FLP_KLOAD(2, Ksn_); SBAR(); GAPB(O[0] = MFMA_(VFR(4), PAF(2), O[0]), C1, 0); \
    FLP_ILOAD(P0, P1, 5, ipn_); FLP_KLOAD(3, Ksn_); SBAR(); GAPB(O[1] = MFMA_(VFR(5), PAF(2), O[1]), C1, 4); \
    FLP_ILOAD(P0, P1, 6, ipn_); SBAR(); GAPB(O[0] = MFMA_(VFR(6), PAF(3), O[0]), C1, 8); \
    FLP_ILOAD(P0, P1, 7, ipn_); SBAR(); GAPB(O[1] = MFMA_(VFR(7), PAF(3), O[1]), C1, 12); \
    fl_waitbar2(cnt_); \
    if (resc) { _Pragma("unroll") for (int r = 0; r < 16; ++r) { O[0][r] *= alpha; O[1][r] *= alpha; } } \
    s_prev = s_cur; s_cur = s_next; s_next = (s_next == 2) ? 0 : s_next + 1; \
    ++t; kv_cur = kv_next; kv_next = (t + 1 < n) ? __builtin_amdgcn_readfirstlane(tl.kv0(t + 1)) : 0; \
  } while (0)
#define FLP_DRAIN(P0, P1, vq_) do { \
    float sacc = 0.f; \
    _Pragma("unroll") for (int r = 0; r < 16; ++r) sacc += P0[r]; \
    _Pragma("unroll") for (int r = 0; r < 16; ++r) sacc += P1[r]; \
    l += sacc; \
    pw0 = (u32x4){PKW(P0, 0), PKW(P0, 2), PKW(P0, 4), PKW(P0, 6)}; pw1 = (u32x4){PKW(P0, 8), PKW(P0, 10), PKW(P0, 12), PKW(P0, 14)}; \
    pw2 = (u32x4){PKW(P1, 0), PKW(P1, 2), PKW(P1, 4), PKW(P1, 6)}; pw3 = (u32x4){PKW(P1, 8), PKW(P1, 10), PKW(P1, 12), PKW(P1, 14)}; \
    { LAS const char* vq__ = (vq_); VRDQ(0, vq__); VRDQ(1, vq__); VRDQ(2, vq__); VRDQ(3, vq__); VRDQ(4, vq__); VRDQ(5, vq__); VRDQ(6, vq__); VRDQ(7, vq__); } \
    O[0] = MFMA_(VFR(0), PAF(0), O[0]); O[1] = MFMA_(VFR(1), PAF(0), O[1]); O[0] = MFMA_(VFR(2), PAF(1), O[0]); O[1] = MFMA_(VFR(3), PAF(1), O[1]); \
    O[0] = MFMA_(VFR(4), PAF(2), O[0]); O[1] = MFMA_(VFR(5), PAF(2), O[1]); O[0] = MFMA_(VFR(6), PAF(3), O[0]); O[1] = MFMA_(VFR(7), PAF(3), O[1]); } while (0)
  {
    if (3 < n) FLP_ISSUE_K(3, 0);
    if (1 < n) FLP_ISSUE_V(1, 1);
    const int cnt_ = ((3 < n) ? 1 + E : 0) + ((1 < n) ? 1 : 0);
    bool resc = false; float alpha = 1.f;
    pA0 = MFMA_(kf[0], qf[0], pA0); pA1 = MFMA_(kf[1], qf[0], pA1); pA0 = MFMA_(kf[2], qf[1], pA0); pA1 = MFMA_(kf[3], qf[1], pA1);
    pA0 = MFMA_(kf[4], qf[2], pA0); pA1 = MFMA_(kf[5], qf[2], pA1); pA0 = MFMA_(kf[6], qf[3], pA0); pA1 = MFMA_(kf[7], qf[3], pA1);
    FLP_MIDDLE(pA0, pA1)
#pragma unroll
    for (int r = 0; r < 16; ++r) { pA0[r] = EX(pA0[r]); pA1[r] = EX(pA1[r]); }
    SBAR();
    { LAS const char* Ksn_ = sm + FLK_SLOT; LAS const char* ipn_ = FLP_IPTR(1);
      FLP_KLOAD(0, Ksn_); FLP_KLOAD(1, Ksn_); FLP_KLOAD(2, Ksn_); FLP_KLOAD(3, Ksn_);
      FLP_ILOAD(pB0, pB1, 0, ipn_); FLP_ILOAD(pB0, pB1, 1, ipn_); FLP_ILOAD(pB0, pB1, 2, ipn_); FLP_ILOAD(pB0, pB1, 3, ipn_);
      FLP_ILOAD(pB0, pB1, 4, ipn_); FLP_ILOAD(pB0, pB1, 5, ipn_); FLP_ILOAD(pB0, pB1, 6, ipn_); FLP_ILOAD(pB0, pB1, 7, ipn_); }
    fl_waitbar2(cnt_);
    (void)resc; (void)alpha;
    s_prev = 0; s_cur = 1; s_next = 2; t = 1; kv_cur = kv_next; kv_next = (2 < n) ? __builtin_amdgcn_readfirstlane(tl.kv0(2)) : 0;
  }
  for (; t + 1 < n;) {
    FLP_STEP(pB0, pB1, pA0, pA1);
    FLP_STEP(pA0, pA1, pB0, pB1);
  }
  if (t < n) { FLP_STEP(pB0, pB1, pA0, pA1); FLP_DRAIN(pB0, pB1, sm + FLV_BASE + s_prev * 8192 + vlane); }
  else { FLP_DRAIN(pA0, pA1, sm + FLV_BASE + s_prev * 8192 + vlane); }
#undef FLP_ISSUE_K
#undef FLP_ISSUE_V
#undef FLP_KLOAD
#undef FLP_ILOAD
#undef FLP_IPTR
#undef FLP_MIDDLE
#undef FLP_STEP
#undef FLP_DRAIN
#undef PKW
#undef PAF
#undef VFR
#undef VRD
#undef VRDQ
#undef EX
#undef GAPA
#undef GAPB
}

__device__ __forceinline__ void fox_unit(const Params& p, int b, int h, int qb, LAS char* sm) {
  const int tid = otid512(), lane = tid & 63, w = tid >> 6, l31 = lane & 31, hh = lane >> 5;
  const int tq = qb * 256 + w * 32 + l31; const long tok = (long)b * SEQ + tq;
  const bf16_t* Pb = p.P() + (long)b * SEQ * PW;
  bf16x8 qf[4];
#pragma unroll
  for (int ds = 0; ds < 4; ++ds) qf[ds] = *(const bf16x8*)(p.P() + tok * PW + h * 64 + ds * 16 + hh * 8);
  const float* ck = p.cum() + (long)(b * 6 + h) * SEQ;
  SMFox smod; smod.cq = 0.f; smod.ck = ck; smod.tq = tq; smod.tqmax = qb * 256 + __builtin_amdgcn_readfirstlane(w) * 32 + 31;
  float m = -INFINITY, l = 0.f; f32x16 O[2];
#pragma unroll
  for (int r = 0; r < 16; ++r) { O[0][r] = 0.f; O[1][r] = 0.f; }
  TLRange tl; tl.n = 4 * qb + 4; tl.kv_last = qb * 256 + 192;
  flash_run64p(sm, qf, Pb + 384 + h * 64, PW, Pb + 768 + h * 64, PW, tl, smod, m, l, O);
  const float lt = l + __shfl_xor(l, 32); const float inv = lt > 0.f ? 1.0f / lt : 0.f;
#pragma unroll
  for (int dt = 0; dt < 2; ++dt)
#pragma unroll
    for (int a = 0; a < 4; ++a) { u32x2 wv; wv.x = cvtpk(O[dt][4 * a] * inv, O[dt][4 * a + 1] * inv); wv.y = cvtpk(O[dt][4 * a + 2] * inv, O[dt][4 * a + 3] * inv);
      *(u32x2*)(p.cat() + kbo(NTOK, tok, h * 64 + dt * 32 + 8 * a + 4 * hh)) = wv; }
}

__device__ __forceinline__ void xattn_unit(const Params& p, int layer, int b, int hd, int qb, LAS char* sm) {
  const int tid = otid512(), lane = tid & 63, w = tid >> 6, l31 = lane & 31, hh = lane >> 5;
  const int wid = __builtin_amdgcn_readfirstlane(tid >> 6);
  const int tq = qb * 256 + w * 32 + l31; const long tok = (long)b * SEQ + tq;
  const float C = 0.0625f * LOG2E;
  const bf16_t* Kb = p.Kmem() + ((long)layer * 1024 + b * 256) * DM + hd * 256;
  const bf16_t* Vb = p.Vmem() + ((long)layer * 1024 + b * 256) * DM + hd * 256;
  __syncthreads();
#pragma unroll
  for (int t = 0; t < 4; ++t)
#pragma unroll
    for (int i = 0; i < 4; ++i) { const int pp = tid + 512 * i; const int row = pp >> 5, sl = pp & 31; const int kc = (sl & 16) | ((sl & 15) ^ (row & 15));
      __builtin_amdgcn_global_load_lds((const unsigned*)(Kb + (long)(t * 64 + row) * DM + kc * 8), (LAS unsigned*)(sm + t * 32768 + wid * 1024 + i * 8192), 16, 0, 0); }
  bf16x8 qf[16];
#pragma unroll
  for (int ds = 0; ds < 16; ++ds) qf[ds] = *(const bf16x8*)(p.qx() + tok * DM + hd * 256 + ds * 16 + hh * 8);
  float m = -INFINITY, l = 0.f; float mt[4];
  bf16x8 Pst[4][4];
#pragma unroll
  for (int t = 0; t < 4; ++t) {
    if (t == 0) fl_waitbar<12>(); else if (t == 1) fl_waitbar<8>(); else if (t == 2) fl_waitbar<4>(); else fl_waitbar<0>();
    f32x16 p0, p1;
    qk_tile256(p0, p1, qf, sm + t * 32768, lane);
    float mx = -INFINITY;
#pragma unroll
    for (int r = 0; r < 16; ++r) { p0[r] *= C; p1[r] *= C; mx = fmaxf(mx, fmaxf(p0[r], p1[r])); }
    { auto rr = __builtin_amdgcn_permlane32_swap(__float_as_uint(mx), __float_as_uint(mx), false, false); mx = fmaxf(__uint_as_float(rr[0]), __uint_as_float(rr[1])); }
    const float mn = fmaxf(m, mx);
    l *= fexp2(m - mn); m = mn; mt[t] = mn;
    float rs = 0.f;
    u32x4 wv;
#pragma unroll
    for (int r = 0; r < 16; ++r) { p0[r] = fexp2(p0[r] - mn); rs += p0[r]; }
    wv = (u32x4){cvtpk(p0[0], p0[1]), cvtpk(p0[2], p0[3]), cvtpk(p0[4], p0[5]), cvtpk(p0[6], p0[7])}; Pst[t][0] = __builtin_bit_cast(bf16x8, wv);
    wv = (u32x4){cvtpk(p0[8], p0[9]), cvtpk(p0[10], p0[11]), cvtpk(p0[12], p0[13]), cvtpk(p0[14], p0[15])}; Pst[t][1] = __builtin_bit_cast(bf16x8, wv);
    __builtin_amdgcn_sched_barrier(0);
#pragma unroll
    for (int r = 0; r < 16; ++r) { p1[r] = fexp2(p1[r] - mn); rs += p1[r]; }
    wv = (u32x4){cvtpk(p1[0], p1[1]), cvtpk(p1[2], p1[3]), cvtpk(p1[4], p1[5]), cvtpk(p1[6], p1[7])}; Pst[t][2] = __builtin_bit_cast(bf16x8, wv);
    wv = (u32x4){cvtpk(p1[8], p1[9]), cvtpk(p1[10], p1[11]), cvtpk(p1[12], p1[13]), cvtpk(p1[14], p1[15])}; Pst[t][3] = __builtin_bit_cast(bf16x8, wv);
    __builtin_amdgcn_sched_barrier(0);
    l += rs;
  }
  __syncthreads();
#pragma unroll
  for (int dh = 0; dh < 2; ++dh)
#pragma unroll
    for (int t = 0; t < 4; ++t)
#pragma unroll
      for (int i = 0; i < 2; ++i) { const int pp = tid + 512 * i;
        __builtin_amdgcn_global_load_lds((const unsigned*)(Vb + (long)(t * 64 + ((pp & 255) >> 2)) * DM + dh * 128 + ((pp >> 8) * 4 + (pp & 3)) * 8),
                                         (LAS unsigned*)(sm + (dh * 4 + t) * 16384 + wid * 1024 + i * 8192), 16, 0, 0); }
#pragma unroll
  for (int t = 0; t < 3; ++t) {
    const float f = fexp2(mt[t] - m);
    if (__builtin_amdgcn_ballot_w64(f != 1.0f) != 0ull) {
#pragma unroll
      for (int k4 = 0; k4 < 4; ++k4) { const u32x4 wv = __builtin_bit_cast(u32x4, Pst[t][k4]); const f32x4 a0 = bf4lo(wv), a1 = bf4hi(wv);
        const u32x4 o = (u32x4){cvtpk(a0[0] * f, a0[1] * f), cvtpk(a0[2] * f, a0[3] * f), cvtpk(a1[0] * f, a1[1] * f), cvtpk(a1[2] * f, a1[3] * f)};
        Pst[t][k4] = __builtin_bit_cast(bf16x8, o); }
    }
  }
  float lt; { auto rr = __builtin_amdgcn_permlane32_swap(__float_as_uint(l), __float_as_uint(l), false, false); lt = __uint_as_float(rr[0]) + __uint_as_float(rr[1]); }
  const float inv = 1.0f / lt;
#pragma unroll
  for (int dh = 0; dh < 2; ++dh) {
    if (dh == 0) fl_waitbar<8>(); else fl_waitbar<0>();
    f32x16 O[4];
#pragma unroll
    for (int dt = 0; dt < 4; ++dt)
#pragma unroll
      for (int r = 0; r < 16; ++r) O[dt][r] = 0.f;
#pragma unroll
    for (int t = 0; t < 4; ++t) pv_tile<4>(O, Pst[t], sm + (dh * 4 + t) * 16384, lane);
    const int t2 = otid512(); const int hh2 = (t2 >> 5) & 1; const long tok2 = (long)b * SEQ + qb * 256 + (t2 >> 6) * 32 + (t2 & 31);
#pragma unroll
    for (int dt = 0; dt < 4; ++dt)
#pragma unroll
      for (int a = 0; a < 4; ++a) { u32x2 wv; wv.x = cvtpk(O[dt][4 * a] * inv, O[dt][4 * a + 1] * inv); wv.y = cvtpk(O[dt][4 * a + 2] * inv, O[dt][4 * a + 3] * inv);
        *(u32x2*)(p.ox() + kbo(NTOK, tok2, hd * 256 + dh * 128 + dt * 32 + 8 * a + 4 * hh2)) = wv; }
  }
}

#define NSA_SC 51200
#define NSA_UNI 122880
#define NSA_TL 122896
#define NSA_MASK 118784
#define NSA_PARK 53248
__device__ __forceinline__ void nsa_stageA(const Params& p, int layer, int b, int g, int qb, LAS char* sm) {
  const int tid = otid512(), lane = tid & 63, w = tid >> 6, l31 = lane & 31, hh = lane >> 5;
  const int tq = qb * 256 + w * 32 + l31; const long tok = (long)b * SEQ + tq;
  LAS float* sc = (LAS float*)(sm + NSA_SC);
  const bf16_t* kcb = p.kvc() + (long)(0 * 8 + b * 2 + g) * 256 * 64;
  const bf16_t* vcb = p.kvc() + (long)(1 * 8 + b * 2 + g) * 256 * 64;
  const int ntc = min(4, (16 * qb + 14) / 64 + 1);
  LAS float* myrow = sc + (w * 32 + l31) * 68;
  __syncthreads();
#pragma unroll
  for (int i = 0; i < 32; ++i) myrow[2 * i + hh] = 0.f;
  const float* glp = p.fgl() + tok * 32 + 6;
  const float* gbp = p.gate_b + layer * 18;
#pragma unroll 1
  for (int r3 = 0; r3 < 3; ++r3) {
    const int head = 3 * g + r3;
    const float slope2 = exp2f(-8.0f * (float)(head + 1) / 6.0f) * LOG2E;
    bf16x8 qf[4];
#pragma unroll
    for (int ds = 0; ds < 4; ++ds) qf[ds] = *(const bf16x8*)(p.P() + tok * PW + 1408 + head * 64 + ds * 16 + hh * 8);
    SMCmp smod; smod.tq = tq; smod.slope2 = slope2; smod.tqmax = qb * 256 + __builtin_amdgcn_readfirstlane(w) * 32 + 31;
    float m = -INFINITY, l = 0.f; f32x16 O[2];
#pragma unroll
    for (int r = 0; r < 16; ++r) { O[0][r] = 0.f; O[1][r] = 0.f; }
    TLRange tl; tl.n = ntc; tl.kv_last = 64 * (ntc - 1);
    flash_run64<3>(sm, qf, kcb, 64, vcb, 64, tl, smod, m, l, O);
    if (DUPK & 8) { m = -INFINITY; l = 0.f;
#pragma unroll
      for (int r = 0; r < 16; ++r) { O[0][r] = 0.f; O[1][r] = 0.f; }
      flash_run64<3>(sm, qf, kcb, 64, vcb, 64, tl, smod, m, l, O); }
    const float lt = l + __shfl_xor(l, 32); const float inv = lt > 0.f ? 1.0f / lt : 0.f;
    const float gc = sigmoidf_(glp[head * 3 + 0] + gbp[head * 3 + 0]) * inv;
    float* ob = p.onsa() + tok * 384 + head * 64;
#pragma unroll
    for (int dt = 0; dt < 2; ++dt)
#pragma unroll
      for (int a = 0; a < 4; ++a) { const f32x4 v = (f32x4){O[dt][4 * a] * gc, O[dt][4 * a + 1] * gc, O[dt][4 * a + 2] * gc, O[dt][4 * a + 3] * gc}; st16_sc1(ob + dt * 32 + 8 * a + 4 * hh, __builtin_bit_cast(u32x4, v)); }
    for (int dup2 = 0; dup2 < ((DUPK & 16) ? 2 : 1); ++dup2) {
    const float mu = (m == -INFINITY) ? 0.f : m;
    float e_prev = 0.f;
    u32x4 kq[4];
    { const int row = tid >> 3, kc = tid & 7;
#pragma unroll
      for (int it = 0; it < 4; ++it) if (it < ntc) kq[it] = *(const u32x4*)(kcb + (long)(64 * it + row) * 64 + kc * 8); }
    const int kdst2 = (tid >> 3) * 128 + (kswz<4>(tid & 7, tid >> 3) << 4);
    __syncthreads();
    *(LAS u32x4*)(sm + kdst2) = kq[0];
    __syncthreads();
#pragma unroll
    for (int it = 0; it < 4; ++it) {
      if (it < ntc) {
        LAS char* kb_ = sm + (it & 1) * 8192;
        if (it + 1 < ntc) *(LAS u32x4*)(sm + ((it + 1) & 1) * 8192 + kdst2) = kq[(it + 1) & 3];
        f32x16 p0, p1;
        qk_tile64(p0, p1, qf, kb_, lane);
        smod.template apply<true>(p0, p1, 64 * it, lane, sm);
#pragma unroll
        for (int r = 0; r < 16; ++r) { p0[r] = fexp2(p0[r] - mu) * inv; p1[r] = fexp2(p1[r] - mu) * inv; }
#pragma unroll
        for (int pi = 0; pi < 2; ++pi)
#pragma unroll
          for (int a = 0; a < 4; ++a) {
            const float q0 = pi ? p1[4 * a] : p0[4 * a], q1 = pi ? p1[4 * a + 1] : p0[4 * a + 1], q2 = pi ? p1[4 * a + 2] : p0[4 * a + 2], q3 = pi ? p1[4 * a + 3] : p0[4 * a + 3];
            const float ex = __shfl_xor(q3, 32);
            myrow[2 * (8 * it + 4 * pi + a) + hh] += (q0 + q1) + (q2 + q3) + (hh ? ex : e_prev);
            e_prev = ex;
          }
        __syncthreads();
      }
    }
    }
  }
  __syncthreads();
  {
    const int cur = tq >> 6;
#pragma unroll
    for (int mi = 0; mi < 32; ++mi) {
      const int j = 2 * mi + hh;
      const bool forced = (j == 0) || (j == cur) || (j == cur - 1);
      const float iv = myrow[j];
      myrow[j] = forced ? 1.0e4f : (j <= cur ? iv : -1.0f);
    }
  }
  __syncthreads();
  for (int dup3 = 0; dup3 < ((DUPK & 32) ? 2 : 1); ++dup3) {
    float v[32];
#pragma unroll
    for (int i = 0; i < 8; ++i) { const f32x4 t = *(LAS const f32x4*)(myrow + 32 * hh + 4 * i); v[4 * i] = t[0]; v[4 * i + 1] = t[1]; v[4 * i + 2] = t[2]; v[4 * i + 3] = t[3]; }
    unsigned mym = 0u;
#pragma unroll 1
    for (int itk = 0; itk < 16; ++itk) {
      float best = v[0]; int bi = 0;
#pragma unroll
      for (int i = 1; i < 32; ++i) { const bool gt = v[i] > best; best = gt ? v[i] : best; bi = gt ? i : bi; }
      const float ob = __shfl_xor(best, 32);
      const bool mine = hh == 0 ? (best >= ob) : (best > ob);
      if (mine) {
        mym |= 1u << bi;
#pragma unroll
        for (int i = 0; i < 32; ++i) v[i] = (i == bi) ? -INFINITY : v[i];
      }
    }
    const unsigned oth = __shfl_xor(mym, 32);
    if (hh == 0) st8_sc1(p.selm() + (tok * 2 + g) * 2, (u32x2){mym, oth});
  }
  __syncthreads();
}

__device__ __forceinline__ void nsa_stageB(const Params& p, int layer, int b, int head, int qb, LAS char* sm) {
  const int tid = otid512(), lane = tid & 63, w = tid >> 6, l31 = lane & 31, hh = lane >> 5;
  const int g = head / 3;
  const int tq = qb * 256 + w * 32 + l31; const long tok = (long)b * SEQ + tq;
  const bf16_t* Pb = p.P() + (long)b * SEQ * PW;
  LAS unsigned* uni = (LAS unsigned*)(sm + NSA_UNI);
  LAS int* tll = (LAS int*)(sm + NSA_TL);
  const float* glp = p.fgl() + tok * 32 + 6;
  const float* gbp = p.gate_b + layer * 18;
  const u32x2 mk = *(const u32x2*)(p.selm() + (tok * 2 + g) * 2);
  const unsigned mlo = mk.x, mhi = mk.y;
  __syncthreads();
  if (tid < 2) uni[tid] = 0u;
  __syncthreads();
  if (hh == 0) { __hip_atomic_fetch_or(uni, mlo, __ATOMIC_RELAXED, __HIP_MEMORY_SCOPE_WORKGROUP); __hip_atomic_fetch_or(uni + 1, mhi, __ATOMIC_RELAXED, __HIP_MEMORY_SCOPE_WORKGROUP); }
  { LAS unsigned* mw = (LAS unsigned*)(sm + NSA_MASK) + w * 128 + lane; mw[0] = mlo; mw[64] = mhi; }
  __syncthreads();
  if (tid == 0) {
    unsigned long long u = ((unsigned long long)uni[1] << 32) | (unsigned long long)uni[0];
    const int jmax = (qb * 256 + 255) >> 6;
    int n = 0;
    for (int j = jmax; j >= 0; --j) if ((u >> j) & 1ull) tll[1 + n++] = 64 * j;
    tll[0] = n;
  }
  __syncthreads();
  const int nsel = tll[0];
  const int tqmax = qb * 256 + __builtin_amdgcn_readfirstlane(w) * 32 + 31;
  const float slope2 = exp2f(-8.0f * (float)(head + 1) / 6.0f) * LOG2E;
  bf16x8 qf[4];
#pragma unroll
  for (int ds = 0; ds < 4; ++ds) qf[ds] = *(const bf16x8*)(p.P() + tok * PW + 1408 + head * 64 + ds * 16 + hh * 8);
  {
    SMSel smod; smod.tq = tq; smod.slope2 = slope2; smod.msk = (LAS const unsigned*)(sm + NSA_MASK) + __builtin_amdgcn_readfirstlane(w) * 128; smod.tqmax = tqmax;
    float m = -INFINITY, l = 0.f; f32x16 O[2];
#pragma unroll
    for (int r = 0; r < 16; ++r) { O[0][r] = 0.f; O[1][r] = 0.f; }
    TLList tl; tl.n = nsel; tl.lst = tll + 1;
    flash_run64p(sm, qf, Pb + 2048 + g * 64, PW, Pb + 2176 + g * 64, PW, tl, smod, m, l, O);
    const float lt = l + __shfl_xor(l, 32); const float inv = lt > 0.f ? 1.0f / lt : 0.f;
    const float gs = sigmoidf_(glp[head * 3 + 1] + gbp[head * 3 + 1]) * inv;
    __syncthreads();
    LAS f32x4* park = (LAS f32x4*)(sm + NSA_PARK) + tid;
#pragma unroll
    for (int a = 0; a < 4; ++a) { park[a * 512] = (f32x4){O[0][4 * a] * gs, O[0][4 * a + 1] * gs, O[0][4 * a + 2] * gs, O[0][4 * a + 3] * gs};
      park[(4 + a) * 512] = (f32x4){O[1][4 * a] * gs, O[1][4 * a + 1] * gs, O[1][4 * a + 2] * gs, O[1][4 * a + 3] * gs}; }
  }
  {
    SMWin smod; smod.tq = tq; smod.slope2 = slope2; smod.tqmax = tqmax;
    float m = -INFINITY, l = 0.f; f32x16 O[2];
#pragma unroll
    for (int r = 0; r < 16; ++r) { O[0][r] = 0.f; O[1][r] = 0.f; }
    const int kvf = max(0, qb * 256 - 512);
    TLRange tl; tl.kv_last = qb * 256 + 192; tl.n = (qb * 256 + 256 - kvf) >> 6;
    flash_run64p(sm, qf, Pb + 2304 + g * 64, PW, Pb + 2432 + g * 64, PW, tl, smod, m, l, O);
    const int tid = otid512(); const int hh = (tid >> 5) & 1; const long tok = (long)b * SEQ + qb * 256 + (tid >> 6) * 32 + (tid & 31);
    const float* glp = p.fgl() + tok * 32 + 6;
    const float lt = l + __shfl_xor(l, 32); const float inv = lt > 0.f ? 1.0f / lt : 0.f;
    const float gw = sigmoidf_(glp[head * 3 + 2] + gbp[head * 3 + 2]) * inv;
    const float* ob = p.onsa() + tok * 384 + head * 64;
#pragma unroll
    for (int dt = 0; dt < 2; ++dt)
#pragma unroll
      for (int a = 0; a < 4; ++a) {
        const f32x4 oc = *(const f32x4*)(ob + dt * 32 + 8 * a + 4 * hh);
        const f32x4 ac = ((LAS const f32x4*)(sm + NSA_PARK))[(dt * 4 + a) * 512 + tid];
        u32x2 wv; wv.x = cvtpk(O[dt][4 * a] * gw + ac[0] + oc[0], O[dt][4 * a + 1] * gw + ac[1] + oc[1]);
        wv.y = cvtpk(O[dt][4 * a + 2] * gw + ac[2] + oc[2], O[dt][4 * a + 3] * gw + ac[3] + oc[3]);
        *(u32x2*)(p.cat() + kbo(NTOK, tok, 640 + head * 64 + dt * 32 + 8 * a + 4 * hh)) = wv;
      }
  }
  __syncthreads();
}

__device__ __forceinline__ void pool_unit(const Params& p, int layer, int b, int tb, int g, LAS char* sm) {
  const int tid = otid();
  LAS float* u = (LAS float*)sm;
  LAS bf16_t* Wt = (LAS bf16_t*)(sm + 20480);
  LAS bf16_t* pl = (LAS bf16_t*)(sm + 36864);
  const int t0 = tb * 64;
  const int wsz = 2 << g;
  TSYNC();
#pragma unroll
  for (int i3 = 0; i3 < 3; ++i3) { const int pi = tid + 256 * i3; if (pi < 79 * 8) { const int rr = pi >> 3, c8 = (pi & 7) * 8; const int t = t0 - 15 + rr;
      u32x4 v = {0u, 0u, 0u, 0u}; if (t >= 0) v = *(const u32x4*)(p.P() + ((long)b * SEQ + t) * PW + 1152 + g * 64 + c8);
      *(LAS f32x4*)(u + rr * 64 + c8) = (f32x4){__uint_as_float(v.x << 16), __uint_as_float(v.x & 0xffff0000u), __uint_as_float(v.y << 16), __uint_as_float(v.y & 0xffff0000u)};
      *(LAS f32x4*)(u + rr * 64 + c8 + 4) = (f32x4){__uint_as_float(v.z << 16), __uint_as_float(v.z & 0xffff0000u), __uint_as_float(v.w << 16), __uint_as_float(v.w & 0xffff0000u)}; } }
#pragma unroll
  for (int i4 = 0; i4 < 4; ++i4) { const int i = (tid + 256 * i4) * 4; const int c = i >> 6, d = i & 63;
    const f32x4 w4 = *(const f32x4*)(p.pool_w + ((long)layer * 4 + g) * 4096 + i);
    Wt[(d + 0) * 72 + c] = f2bf(w4[0]); Wt[(d + 1) * 72 + c] = f2bf(w4[1]); Wt[(d + 2) * 72 + c] = f2bf(w4[2]); Wt[(d + 3) * 72 + c] = f2bf(w4[3]); }
  TSYNC();
  for (int i = tid; i < 4096; i += 256) { const int tl = i >> 6, c = i & 63; const int t = t0 + tl;
    float s = 0.f; for (int k = 0; k < wsz; ++k) s += u[(tl + 15 - k) * 64 + c];
    const float cnt = (float)min(t + 1, wsz);
    pl[tl * 72 + c] = f2bf(s / cnt - u[(tl + 15) * 64 + c]); }
  TSYNC();
  { const int lane = tid & 63, w = tid >> 6, l31 = lane & 31, hh = lane >> 5;
    const int db = w & 1, tbk = w >> 1;
    f32x16 acc;
#pragma unroll
    for (int r = 0; r < 16; ++r) acc[r] = 0.f;
#pragma unroll
    for (int ks = 0; ks < 4; ++ks) {
      const bf16x8 af = *(LAS const bf16x8*)(Wt + (db * 32 + l31) * 72 + ks * 16 + hh * 8);
      const bf16x8 bfr = *(LAS const bf16x8*)(pl + (tbk * 32 + l31) * 72 + ks * 16 + hh * 8);
      acc = __builtin_amdgcn_mfma_f32_32x32x16_bf16(af, bfr, acc, 0, 0, 0);
    }
    const long tok = (long)b * SEQ + t0 + tbk * 32 + l31;
    const float* scp = p.pool_scale + layer * 256 + g * 64 + db * 32 + 4 * hh;
#pragma unroll
    for (int a = 0; a < 4; ++a) { const f32x4 sc = *(const f32x4*)(scp + 8 * a);
      u32x2 wv; wv.x = cvtpk(acc[4 * a] * sc[0], acc[4 * a + 1] * sc[1]); wv.y = cvtpk(acc[4 * a + 2] * sc[2], acc[4 * a + 3] * sc[3]);
      *(u32x2*)(p.cat() + kbo(NTOK, tok, 384 + g * 64 + db * 32 + 8 * a + 4 * hh)) = wv; } }
}

__device__ __forceinline__ void cum_unit(const Params& p, int layer, int b, int h, LAS char* sm) {
  const int tid = otid();
  LAS float* part = (LAS float*)sm;
  const float bf = p.fox_b[layer * 6 + h];
  float v[16]; float s = 0.f;
#pragma unroll
  for (int i = 0; i < 16; ++i) { const int t = tid * 16 + i; const float z = p.fgl()[((long)b * SEQ + t) * 32 + h] + bf;
    const float ls = fminf(z, 0.f) - log1pf(__expf(-fabsf(z))); s += ls; v[i] = s; }
  TSYNC();
  part[tid] = s;
  TSYNC();
  if (tid < 64) {
    const f32x4 q = *(LAS const f32x4*)(part + 4 * tid);
    const float s0 = q[0], s1 = s0 + q[1], s2 = s1 + q[2], s3 = s2 + q[3];
    float inc = s3;
#pragma unroll
    for (int o = 1; o < 64; o <<= 1) { const float t = __shfl_up(inc, o); if (tid >= o) inc += t; }
    const float ex = inc - s3;
    *(LAS f32x4*)(part + 4 * tid) = (f32x4){ex, ex + s0, ex + s1, ex + s2};
  }
  TSYNC();
  const float base = part[tid];
#pragma unroll
  for (int i = 0; i < 16; ++i) p.cum()[(long)(b * 6 + h) * SEQ + tid * 16 + i] = (base + v[i]) * -8.0f;
  TSYNC();
}

__device__ __forceinline__ void cmp2_unit(const Params& p, int layer, int kv, int rb, LAS char* sm) {
  const int tid = otid();
  LAS float* hs = (LAS float*)sm;
  LAS float* ws = (LAS float*)(sm + 16384);
  const float* bias = p.bias1() + 16 * 1024 + (layer * 2 + kv) * 256;
  const float* part = p.hidp() + (long)kv * 2048 * 256;
  const float* w2g = (kv ? p.w2v : p.w2k) + (long)layer * 256 * 64;
  TSYNC();
  f32x4 wq[8];
#pragma unroll
  for (int q = 0; q < 8; ++q) wq[q] = *(const f32x4*)(w2g + (tid + 256 * q) * 4);
#pragma unroll
  for (int i4 = 0; i4 < 4; ++i4) { const int i = (tid + 256 * i4) * 4; const int r = i >> 8, k = i & 255; const long o = (long)(rb * 16 + r) * 256 + k;
    f32x4 v = *(const f32x4*)(bias + k);
#pragma unroll
    for (int sI = 0; sI < 4; ++sI) v += *(const f32x4*)(part + o + (long)sI * 4096 * 256);
    *(LAS f32x4*)(hs + i) = (f32x4){gelu_tanh(v[0]), gelu_tanh(v[1]), gelu_tanh(v[2]), gelu_tanh(v[3])}; }
  const int n = tid & 63, rg = tid >> 6;
  float acc[4] = {0.f, 0.f, 0.f, 0.f};
#pragma unroll 1
  for (int half = 0; half < 2; ++half) {
#pragma unroll
    for (int q = 0; q < 8; ++q) *(LAS f32x4*)(ws + (tid + 256 * q) * 4) = wq[q];
    TSYNC();
    if (half == 0) {
#pragma unroll
      for (int q = 0; q < 8; ++q) wq[q] = *(const f32x4*)(w2g + 8192 + (tid + 256 * q) * 4);
    }
#pragma unroll 4
    for (int k0 = 0; k0 < 128; k0 += 4) {
      const float w0 = ws[(k0 + 0) * 64 + n], w1 = ws[(k0 + 1) * 64 + n], w2_ = ws[(k0 + 2) * 64 + n], w3 = ws[(k0 + 3) * 64 + n];
#pragma unroll
      for (int j = 0; j < 4; ++j) { const f32x4 h4 = *(LAS const f32x4*)(hs + (rg * 4 + j) * 256 + half * 128 + k0);
        acc[j] += h4[0] * w0 + h4[1] * w1 + h4[2] * w2_ + h4[3] * w3; }
    }
    TSYNC();
  }
#pragma unroll
  for (int j = 0; j < 4; ++j) { const int row = rb * 16 + rg * 4 + j; p.kvc()[((long)kv * 2048 + row) * 64 + n] = ((row & 255) == 255) ? (bf16_t)0 : f2bf(acc[j]); }
}

#define GSYNC() xcd_barrier(xb)
#define GSYNCK(k) do { xcd_barrier(xb); if (SPINMASK != 0ull && bid == 0 && TID5 == 0) { ((unsigned long long*)(xb.bar + 4096))[(k)] = __builtin_amdgcn_s_memrealtime(); } } while (0)
#ifndef SKIPMASK
#define SKIPMASK 0
#endif
#define PH(n) if (!((SKIPMASK >> (n)) & 1))
#define REP(n) for (int rep_ = 0; rep_ < ((((DUPMASK) >> (n)) & 1) ? 2 : 1); ++rep_)
__global__ void __launch_bounds__(512, 2) fwd_kernel(KArgs ka) {
  const Params& p = ka.p;
  LAS char* smfull = (LAS char*)lds_dyn;
  const int team = team_id();
  LAS char* sm = smfull + team * 65536;
  LAS int* xs = (LAS int*)(smfull + LDS_XS + team * 2048);
  LAS int* xsg = (LAS int*)(smfull + LDS_XS);
  const int bid = blockIdx.x, nb = gridDim.x;
  const int vb = vbid(), nv = nvb();
  if (p.never) cg::this_grid().sync();
  if (TID5 < 64) ((LAS unsigned*)(smfull + LDS_XB))[TID5] = 0u;
  __syncthreads();
  XcdBarrier xb = xcd_barrier_post(p.bar(), (volatile LAS unsigned*)(smfull + LDS_XB));
  if (SPINMASK != 0ull && bid == 0 && TID5 == 0) ((unsigned long long*)(xb.bar + 4096))[0] = __builtin_amdgcn_s_memrealtime();
  if (TCAT != 0 && bid == 0 && TID5 == 0) ((unsigned long long*)(xb.bar + 4096))[100] = 0ull;
#define TC_SLOT ((LAS unsigned long long*)(smfull + LDS_XS + 2016))
#define TC_BEG() do { if (TCAT != 0 && TID5 == 0) *TC_SLOT = __builtin_amdgcn_s_memrealtime(); } while (0)
#define TC_END(c) do { if (TCAT == (c) && TID5 == 0) atomicAdd((unsigned long long*)(xb.bar + 4096) + 100, (unsigned long long)(__builtin_amdgcn_s_memrealtime() - *TC_SLOT)); } while (0)

  REP(0) PH(0) {
    f32x4 vcur[4], vnxt[4];
    int t = ka.tmoe + vb, ji = 0;
    if (t < ka.tdef) {
#pragma unroll
      for (int q = 1; q < NJOBS; ++q) if (t >= ka.jobs[q].tile0) ji = q;
      tt_load(ka.jobs[ji], t - ka.jobs[ji].tile0, vnxt);
    }
    for (; t < ka.tdef; t += nv) {
#pragma unroll
      for (int i = 0; i < 4; ++i) vcur[i] = vnxt[i];
      const int tn = t + nv; int jn = 0;
      if (tn < ka.tdef) {
#pragma unroll
        for (int q = 1; q < NJOBS; ++q) if (tn >= ka.jobs[q].tile0) jn = q;
        tt_load(ka.jobs[jn], tn - ka.jobs[jn].tile0, vnxt);
      }
      tt_finish(ka.jobs[ji], t - ka.jobs[ji].tile0, vcur, sm);
      ji = jn;
    }
  }
  PH(1) {
    const long gt = (long)vb * 256 + TIDT, gs = (long)nv * 256;
    for (long i = gt; i < 2L * 32 * 232 * 4; i += gs) { const long l = i / (32 * 232 * 4); long rem = i % (32 * 232 * 4); const long kb = rem / (232 * 4); rem %= (232 * 4);
      *(u32x4*)(p.WinT() + l * 2816 * 1024 + (kb * 2816 + 2584) * 32 + rem * 8) = (u32x4){0u, 0u, 0u, 0u}; }
    for (long i = gt; i < 2L * 32 * 236 * 4; i += gs) { const long l = i / (32 * 236 * 4); long rem = i % (32 * 236 * 4); const long kb = rem / (236 * 4); rem %= (236 * 4);
      *(u32x4*)(p.WrT() + l * 256 * 1024 + (kb * 256 + 20) * 32 + rem * 8) = (u32x4){0u, 0u, 0u, 0u}; }
    if (gt < 64) { p.mcnt()[gt] = 0; p.wq()[gt] = 0; }
    if (gt < 512) p.mq()[gt] = 0;
    if (gt < 16384) { const int kc = (int)(gt >> 10), l = (int)((gt >> 9) & 1), kv = (int)((gt >> 8) & 1), n = (int)(gt & 255);
      const float* pe = (kv ? p.pe_v : p.pe_k) + l * 2048 + kc * 128; const float* w1 = (kv ? p.w1v : p.w1k) + (long)l * 2048 * 256 + (long)kc * 128 * 256 + n;
      float s = 0.f;
#pragma unroll 16
      for (int k = 0; k < 128; ++k) s += pe[k] * w1[(long)k * 256];
      p.bias1()[gt] = s; }
  }
  PH(2) rownorm<false>(p.mem, p.mem_g, p.memn(), 1024);
  rownorm<false>(p.mem, p.mem_g + DM, p.memn() + 1024 * DM, 1024);
  rowprep(p.x_in, p.hb(), p.ssq(), NTOK);
  GSYNCK(1);

  auto layer_body = [&](const int layer) __attribute__((always_inline)) {
    Params pl_ = ka.p; asm volatile("" : "+s"(pl_.ws));
    const Params& p = pl_;
    REP(3) PH(3) {
      if (layer == 0 && bid == nb - 1) {
        const int t5 = otid512();
#pragma unroll
        for (int h = 0; h < 2; ++h) { const int idx = t5 + 512 * h; float sacc = 0.f;
#pragma unroll
          for (int sI = 0; sI < 16; ++sI) sacc += p.bias1()[sI * 1024 + idx];
          p.bias1()[16 * 1024 + idx] = sacc; }
      }
      const int nmain = 64 * 11, nextra = layer == 0 ? 64 : 0;
      for (int it = bid; it < nmain + nextra; it += nb) {
        if (it < nmain) {
          const int nt = it / 64, mt = it % 64;
          RowKB af{p.hb(), NTOK, mt * 256, 0};
          RowKB bf{p.WinT() + (long)layer * 2816 * DM, 2816, nt * 256, 0};
          EpiInproj ep{p.P(), p.fgl(), p.ssq(), mt, nt};
          gemm_tile(smfull, 16, af, bf, ep);
        } else {
          const int e = it - nmain; const int l2 = e >> 5, kv = (e >> 4) & 1, mt = (e >> 2) & 3, nt = e & 3;
          RowKB af{p.memn() + (long)l2 * 1024 * DM, 1024, mt * 256, 0};
          RowKB bf{(kv ? p.WvT() : p.WkT()) + (long)l2 * 1024 * DM, 1024, nt * 256, 0};
          EpiBf16 ep{(kv ? p.Vmem() : p.Kmem()) + (long)l2 * 1024 * DM, DM, mt * 256, nt * 256, nullptr};
          gemm_tile(smfull, 16, af, bf, ep);
        }
      }
    }
    GSYNCK(2 + layer * 9);
    REP(4) PH(4) {
      for (int it = bid; it < 64; it += nb) {
        const int ks = it & 3, mt = (it >> 2) & 7, kv = it >> 5;
        RowCmp af{p.P() + (kv ? 1920 : 1792), mt * 256, ks * 8};
        RowKB bf{p.W1T() + ((long)layer * 2 + kv) * 256 * 2048, 256, 0, ks * 16};
        EpiF32 ep{p.hidp() + ((long)ks * 4096 + kv * 2048) * 256, 256, mt * 256, 0};
        gemm_tile(smfull, 8, af, bf, ep);
        asm volatile("s_waitcnt vmcnt(0)" ::: "memory");
        __syncthreads();
        if (TID5 == 0) xb_add((unsigned*)(p.mq() + layer * 128 + 96 + kv * 8 + mt), 1u);
      }
      __syncthreads();
      for (int e = vb; e < 1024; e += nv) pool_unit(p, layer, e >> 8, (e >> 2) & 63, e & 3, sm);
      if (vb >= nv - 256 && vb < nv - 232) { const int e = vb - (nv - 256); cum_unit(p, layer, e / 6, e % 6, sm); }
      for (int it = vb - (nv - 256); it >= 0 && it < 256; it += nv) {
        const int kv = it >> 7, rb = it & 127;
        if (TIDT == 0) { unsigned* c_ = (unsigned*)(p.mq() + layer * 128 + 96 + kv * 8 + (rb >> 4)); XB_SPIN(xb_ld(c_) < 4u, p.bar()); __builtin_amdgcn_fence(__ATOMIC_ACQUIRE, "agent"); asm volatile("s_waitcnt vmcnt(0)" ::: "memory"); }
        TSYNC();
        cmp2_unit(p, layer, kv, rb, sm);
      }
      {
        const int half = ka.jobs[0].tpb * 16;
        for (;;) {
          TSYNC();
          if (TIDT == 0) xs[0] = atomicAdd(p.mq() + 392 + layer, 4);
          TSYNC();
          const int c0 = xs[0];
          if (c0 >= 3 * half) break;
          const int ji = (c0 >= 2 * half) ? 2 : (c0 >= half ? 1 : 0);
          const int tl0 = layer * half + (c0 - ji * half);
          f32x4 vcur[4], vnxt[4];
          tt_load(ka.jobs[ji], tl0, vnxt);
          for (int q = 0; q < 4; ++q) {
#pragma unroll
            for (int i = 0; i < 4; ++i) vcur[i] = vnxt[i];
            if (q + 1 < 4) tt_load(ka.jobs[ji], tl0 + q + 1, vnxt);
            tt_finish(ka.jobs[ji], tl0 + q, vcur, sm);
          }
        }
      }
    }
    GSYNCK(3 + layer * 9);
    REP(6) {
      int* ctr = p.wq() + layer * 8 + rep_ * 2;
      unsigned* dn = (unsigned*)(p.wq() + layer * 8 + 7);
      for (;;) {
        TC_BEG();
        __syncthreads();
        if (TID5 == 0) xsg[0] = atomicAdd(ctr, 1);
        __syncthreads();
        int it = xsg[0];
        TC_END(5);
        if (it >= 896) break;
        int kind, qb, e;
        if (it < 128) { kind = 0; qb = 15 - (it >> 3); e = it & 7; }
        else if (it < 512) { const int j = it - 128; kind = 1; qb = 15 - j / 24; e = j % 24; }
        else { const int j = it - 512; kind = 2; qb = 15 - j / 24; e = j % 24; }
        if (kind == 0) {
          TC_BEG();
          nsa_stageA(p, layer, e >> 1, e & 1, qb, smfull);
          if (DUPK & 1) nsa_stageA(p, layer, e >> 1, e & 1, qb, smfull);
          asm volatile("s_waitcnt vmcnt(0)" ::: "memory");
          __syncthreads();
          if (TID5 == 0) xb_add(dn, 1u);
          TC_END(1);
        } else if (kind == 1) { TC_BEG(); fox_unit(p, e / 6, e % 6, qb, smfull); if (DUPK & 2) fox_unit(p, e / 6, e % 6, qb, smfull); if (TCAT != 0) __syncthreads(); TC_END(2); }
        else {
          { TC_BEG();
          if (TID5 == 0) { XB_SPIN(xb_ld(dn) < 128u, p.bar()); __builtin_amdgcn_fence(__ATOMIC_ACQUIRE, "agent"); asm volatile("s_waitcnt vmcnt(0)" ::: "memory"); }
          __syncthreads(); TC_END(4); }
          TC_BEG();
          nsa_stageB(p, layer, e / 6, e % 6, qb, smfull);
          if (DUPK & 4) nsa_stageB(p, layer, e / 6, e % 6, qb, smfull);
          TC_END(3);
        }
      }
    }
    GSYNCK(4 + layer * 9);
    PH(7) for (int it = bid; it < 256; it += nb) {
      const int nt = it >> 6, mt = it & 63;
      RowKB af{p.cat(), NTOK, mt * 256, 0};
      RowKB bf{p.WoutT() + (long)layer * 1024 * DM, 1024, nt * 256, 0};
      EpiResid ep{layer == 0 ? p.x_in : nullptr, p.hb(), p.ssq(), mt * 256, nt * 256};
      gemm_tile(smfull, 16, af, bf, ep);
    }
    GSYNCK(5 + layer * 9);
    REP(8) PH(8) for (int it = bid; it < 256; it += nb) {
      const int nt = it >> 6, mt = it & 63;
      RowKB af{p.hb(), NTOK, mt * 256, 0};
      RowKB bf{p.WqT() + (long)layer * 1024 * DM, 1024, nt * 256, 0};
      EpiBf16 ep{p.qx(), DM, mt * 256, nt * 256, p.ssq()};
      gemm_tile(smfull, 16, af, bf, ep);
    }
    GSYNCK(6 + layer * 9);
    REP(5) { for (int it = bid; it < 256; it += nb) { const int hd = it & 3, b = (it >> 2) & 3, qb = it >> 4; xattn_unit(p, layer, b, hd, qb, smfull); } }
    GSYNCK(7 + layer * 9);
    PH(9) for (int it = bid; it < 256; it += nb) {
      const int nt = it >> 6, mt = it & 63;
      RowKB af{p.ox(), NTOK, mt * 256, 0};
      RowKB bf{p.WoT() + (long)layer * 1024 * DM, 1024, nt * 256, 0};
      EpiResid ep{nullptr, p.hb(), p.ssq(), mt * 256, nt * 256};
      gemm_tile(smfull, 16, af, bf, ep);
    }
    GSYNCK(8 + layer * 9);
    PH(10) for (int it = bid; it < 256; it += nb) {
      const int ks = it & 3, mt = it >> 2;
      RowKB af{p.hb(), NTOK, mt * 256, ks * 8};
      RowKB bf{p.WrT() + (long)layer * 256 * DM, 256, 0, ks * 8};
      EpiRouterPart ep{p.rpart() + (long)ks * NTOK * 32, mt * 256};
      gemm_tile(smfull, 4, af, bf, ep);
      asm volatile("s_waitcnt vmcnt(0)" ::: "memory");
      __syncthreads();
      if (TID5 == 0) xb_add((unsigned*)(p.mq() + 256 + layer * 64 + mt), 1u);
    }
    __syncthreads();
    PH(10) if (vb < 64) {
      const int tid = otid();
      const int tok = vb * 256 + tid;
      if (tid == 0) { unsigned* c_ = (unsigned*)(p.mq() + 256 + layer * 64 + vb); XB_SPIN(xb_ld(c_) < 4u, p.bar()); __builtin_amdgcn_fence(__ATOMIC_ACQUIRE, "agent"); asm volatile("s_waitcnt vmcnt(0)" ::: "memory"); }
      TSYNC();
      if (tid < 32) xs[tid] = 0;
      TSYNC();
      float lg[20];
#pragma unroll
      for (int q4 = 0; q4 < 5; ++q4) {
        f32x4 v = *(const f32x4*)(p.rpart() + (long)tok * 32 + q4 * 4);
#pragma unroll
        for (int sI = 1; sI < 4; ++sI) v += *(const f32x4*)(p.rpart() + ((long)sI * NTOK + tok) * 32 + q4 * 4);
        lg[q4 * 4] = v[0]; lg[q4 * 4 + 1] = v[1]; lg[q4 * 4 + 2] = v[2]; lg[q4 * 4 + 3] = v[3];
      }
      const float rs_tok = row_rstd(p.ssq(), tok);
#pragma unroll
      for (int q = 0; q < 20; ++q) lg[q] *= rs_tok;
      float c[4], f[4];
#pragma unroll
      for (int i = 0; i < 4; ++i) c[i] = lg[i] + p.rc_b[layer * 4 + i];
      int grp = 0; float cm = c[0];
#pragma unroll
      for (int i = 1; i < 4; ++i) if (c[i] > cm) { cm = c[i]; grp = i; }
      float cs = 0.f;
#pragma unroll
      for (int i = 0; i < 4; ++i) cs += __expf(c[i] - cm);
      const float wgrp = 1.0f / cs;
#pragma unroll
      for (int i = 0; i < 4; ++i) { const float l0 = lg[4 + i], l1 = lg[8 + i], l2 = lg[12 + i], l3 = lg[16 + i];
        f[i] = (grp == 0 ? l0 : grp == 1 ? l1 : grp == 2 ? l2 : l3) + p.rf_b[layer * 16 + grp * 4 + i]; }
      int i1 = 0; float f1 = f[0];
#pragma unroll
      for (int i = 1; i < 4; ++i) if (f[i] > f1) { f1 = f[i]; i1 = i; }
      int i2 = -1; float f2 = -INFINITY;
#pragma unroll
      for (int i = 0; i < 4; ++i) if (i != i1 && f[i] > f2) { f2 = f[i]; i2 = i; }
      const float e2 = __expf(f2 - f1);
      const float w1 = wgrp / (1.0f + e2), w2 = wgrp * e2 / (1.0f + e2);
      const int a = i1 < i2 ? i1 : i2, bq = i1 < i2 ? i2 : i1;
      const float wa = i1 < i2 ? w1 : w2, wb = i1 < i2 ? w2 : w1;
      const int pairidx = (a == 0) ? (bq - 1) : (a == 1 ? bq + 1 : 5);
      const int cls = grp * 6 + pairidx;
      const int lpos = __hip_atomic_fetch_add(xs + cls, 1, __ATOMIC_RELAXED, __HIP_MEMORY_SCOPE_WORKGROUP);
      TSYNC();
      if (tid < 24) xs[32 + tid] = atomicAdd(&p.mcnt()[layer * 32 + tid], xs[tid]);
      TSYNC();
      const int pos = xs[32 + cls] + lpos;
      *(u32x4*)(p.mlist() + (((long)layer * 24 + cls) * NTOK + pos) * 4) = (u32x4){(unsigned)tok, __float_as_uint(wa), __float_as_uint(wb), __float_as_uint(rs_tok)};
      p.tokw()[tok * 2 + 0] = wa; p.tokw()[tok * 2 + 1] = wb;
    }
    GSYNCK(9 + layer * 9);
    PH(11) {
      LAS int* tstart = xsg;
      LAS int* ccnt = xsg + 32;
      LAS int* toks = xsg + 64;
      LAS float* wts = (LAS float*)xsg + 320;
      LAS float* rsd = (LAS float*)xsg + 576;
      __syncthreads();
      if (TID5 == 0) { int a = 0; for (int c = 0; c < 24; ++c) { const int n = p.mcnt()[layer * 32 + c]; ccnt[c] = n; tstart[c] = a; a += (n + 255) >> 8; } tstart[24] = a; }
      __syncthreads();
      const int nrt = tstart[24];
      {
        const int nup = nrt * 8, ndn = nrt * 4;
        unsigned* rcnt = (unsigned*)(p.mq() + layer * 128);
        for (int it = bid; it < nup + ndn; it += nb) {
          const int pass = it < nup ? 0 : 1;
          const int idx = pass ? it - nup : it;
          const int nct = pass == 0 ? 8 : 4;
          const int rt = idx / nct, ct = idx % nct;
          int cls = 0;
          for (int c = 1; c < 24; ++c) if (rt >= tstart[c]) cls = c;
          const int rtl = rt - tstart[cls];
          const int grp = cls / 6, pi = cls % 6;
          const int ea = grp * 4 + (pi < 3 ? 0 : (pi < 5 ? 1 : 2)), eb = grp * 4 + (pi < 3 ? pi + 1 : (pi < 5 ? pi - 1 : 3));
          __syncthreads();
          const int tid5 = otid512();
          if (tid5 < 256) { const int idx2 = rtl * 256 + tid5; const bool ok = idx2 < ccnt[cls];
            u32x4 rec = {0xffffffffu, 0u, 0u, 0u}; if (ok) rec = *(const u32x4*)(p.mlist() + (((long)layer * 24 + cls) * NTOK + idx2) * 4);
            toks[tid5] = (int)rec.x; wts[tid5] = __uint_as_float(ct < 4 ? rec.y : rec.z); rsd[tid5] = __uint_as_float(rec.w); }
          if (pass == 1 && tid5 == 0) { XB_SPIN(xb_ld(rcnt + rt) < 8u, p.bar()); __builtin_amdgcn_fence(__ATOMIC_ACQUIRE, "agent"); asm volatile("s_waitcnt vmcnt(0)" ::: "memory"); }
          __syncthreads();
          if (pass == 0) {
            const int ex = ct < 4 ? ea : eb;
            RowGather af{p.hb(), NTOK, toks};
            RowKB bf{p.WguT() + ((long)layer * 16 + ex) * 1024 * DM, 1024, (ct & 3) * 256, 0};
            EpiMoeUp ep{p.he(), (long)rt * 256, (ct < 4 ? 0 : 512) + (ct & 3) * 128, wts, rsd};
            gemm_tile(smfull, 16, af, bf, ep);
            asm volatile("s_waitcnt vmcnt(0)" ::: "memory");
            __syncthreads();
            if (tid5 == 0) xb_add(rcnt + rt, 1u);
          } else {
            RowKB af{p.he(), HE_ROWS, rt * 256, 0};
            const bf16_t* ba = p.WdT() + ((long)layer * 16 + ea) * 1024 * 512;
            const bf16_t* bb = p.WdT() + ((long)layer * 16 + eb) * 1024 * 512;
            RowSplitKB bf{ba, 1024, ct * 256, (long)(bb - ba)};
            EpiMoeDown ep{p.hb(), p.ssq(), ct * 256, toks};
            gemm_tile(smfull, 16, af, bf, ep);
          }
        }
        if (layer == 0) {
          __syncthreads();
          for (;;) {
            TSYNC();
            if (TIDT == 0) xs[0] = atomicAdd(p.mq() + 394, 4);
            TSYNC();
            const int c0 = ka.tdef + xs[0];
            if (c0 >= ka.ttiles) break;
            const int c1 = min(c0 + 4, ka.ttiles);
            for (int t = c0; t < c1; ++t) {
              int ji = ka.jdef;
#pragma unroll
              for (int q = 14; q < NJOBS; ++q) if (q > ka.jdef && t >= ka.jobs[q].tile0) ji = q;
              f32x4 vcur[4];
              tt_load(ka.jobs[ji], t - ka.jobs[ji].tile0, vcur);
              tt_finish(ka.jobs[ji], t - ka.jobs[ji].tile0, vcur, sm);
            }
          }
        }
        GSYNCK(10 + layer * 9);
      }
    }
  };
  layer_body(0);
  layer_body(1);
  finalnorm(p.hb(), p.ssq(), p.final_g, p.xw, NTOK);
  if ((SPINMASK != 0ull || TCAT != 0) && bid == 0 && TID5 == 0) {
    unsigned long long tot = 0;
    for (int k = 0; k < 25; ++k) if ((SPINMASK >> k) & 1ull) tot += ((unsigned long long*)(xb.bar + 4096))[k + 1] - ((unsigned long long*)(xb.bar + 4096))[k];
    if (TCAT != 0) tot += ((unsigned long long*)(xb.bar + 4096))[100] / 256ull;
    const unsigned long long t0 = __builtin_amdgcn_s_memrealtime();
    while (__builtin_amdgcn_s_memrealtime() - t0 < tot * SPINMUL) __builtin_amdgcn_s_sleep(8);
  }
}

static inline size_t al256(size_t x) { return (x + 255) & ~(size_t)255; }
extern "C" void kernel_launch(void* const* d_in, const int* in_sizes, int n_in, void* d_out, int out_size, void* d_ws, size_t ws_size, hipStream_t stream) {
  KArgs ka; memset(&ka, 0, sizeof(ka)); Params& p = ka.p;
  const float* const* in = (const float* const*)d_in;
  p.x_in = in[0]; p.mem = in[1]; p.fox_b = in[4]; p.pool_w = in[5]; p.pool_scale = in[6]; p.pe_k = in[7]; p.pe_v = in[8];
  p.w1k = in[9]; p.w1v = in[11]; p.w2k = in[10]; p.w2v = in[12]; p.gate_b = in[13]; p.mem_g = in[16]; p.rc_b = in[23]; p.rf_b = in[25]; p.final_g = in[29];
  p.xw = (float*)d_out;
  p.ws = (char*)d_ws; const size_t off = WS_TOTAL;
  int nj = 0, tile0 = 0;
  auto job = [&](const float* src, bf16_t* dst, long sbs, long dbs, int K, int N, int lds, int R, int map, int nbatch, const float* g = nullptr, int gdiv = 1) {
    TJob& j = ka.jobs[nj++]; j.src = src; j.dst = dst; j.g = g; j.sbs = sbs; j.dbs = dbs; j.K = K; j.N = N; j.lds = lds; j.R = R; j.map = map;
    j.tpb = (K / 64) * ((N + 63) / 64); j.tile0 = tile0; j.gdiv = gdiv; tile0 += j.tpb * nbatch; };
  job(in[26], p.WguT(), 1024L * 512, 1024L * 1024, 1024, 512, 512, 1024, 2, 32, in[21], 16);
  job(in[27], p.WguT(), 1024L * 512, 1024L * 1024, 1024, 512, 512, 1024, 3, 32, in[21], 16);
  job(in[28], p.WdT(), 512L * 1024, 1024L * 512, 512, 1024, 1024, 1024, 0, 32);
  ka.tmoe = tile0;
  job(in[3], p.WinT(), 1024L * 2584, 2816L * 1024, 1024, 2584, 2584, 2816, 1, 1, in[2], 1);
  job(in[14], p.WoutT(), 1024L * 1024, 1024L * 1024, 1024, 1024, 1024, 1024, 0, 1);
  job(in[17], p.WqT(), 1024L * 1024, 1024L * 1024, 1024, 1024, 1024, 1024, 0, 1, in[15], 1);
  job(in[18], p.WkT(), 1024L * 1024, 1024L * 1024, 1024, 1024, 1024, 1024, 0, 2);
  job(in[19], p.WvT(), 1024L * 1024, 1024L * 1024, 1024, 1024, 1024, 1024, 0, 2);
  job(in[20], p.WoT(), 1024L * 1024, 1024L * 1024, 1024, 1024, 1024, 1024, 0, 1);
  job(in[9], p.W1T(), 2048L * 256, 2L * 256 * 2048, 2048, 256, 256, 256, 0, 1);
  job(in[11], p.W1T() + 256L * 2048, 2048L * 256, 2L * 256 * 2048, 2048, 256, 256, 256, 0, 1);
  job(in[22], p.WrT(), 1024L * 4, 256L * 1024, 1024, 4, 4, 256, 0, 1, in[21], 1);
  job(in[24], p.WrT() + 4L * 32, 1024L * 16, 256L * 1024, 1024, 16, 16, 256, 0, 1, in[21], 1);
  ka.tdef = tile0; ka.jdef = nj;
  job(in[3] + 1024L * 2584, p.WinT() + 2816L * 1024, 1024L * 2584, 2816L * 1024, 1024, 2584, 2584, 2816, 1, 1, in[2] + DM, 1);
  job(in[14] + 1024L * 1024, p.WoutT() + 1024L * 1024, 1024L * 1024, 1024L * 1024, 1024, 1024, 1024, 1024, 0, 1);
  job(in[17] + 1024L * 1024, p.WqT() + 1024L * 1024, 1024L * 1024, 1024L * 1024, 1024, 1024, 1024, 1024, 0, 1, in[15] + DM, 1);
  job(in[20] + 1024L * 1024, p.WoT() + 1024L * 1024, 1024L * 1024, 1024L * 1024, 1024, 1024, 1024, 1024, 0, 1);
  job(in[9] + 2048L * 256, p.W1T() + 2L * 256 * 2048, 2048L * 256, 2L * 256 * 2048, 2048, 256, 256, 256, 0, 1);
  job(in[11] + 2048L * 256, p.W1T() + 256L * 2048 + 2L * 256 * 2048, 2048L * 256, 2L * 256 * 2048, 2048, 256, 256, 256, 0, 1);
  job(in[22] + 1024L * 4, p.WrT() + 256L * 1024, 1024L * 4, 256L * 1024, 1024, 4, 4, 256, 0, 1, in[21] + DM, 1);
  job(in[24] + 1024L * 16, p.WrT() + 4L * 32 + 256L * 1024, 1024L * 16, 256L * 1024, 1024, 16, 16, 256, 0, 1, in[21] + DM, 1);
  ka.ttiles = tile0; p.never = 0;
  static int grid_blocks = 0;
  if (!grid_blocks) {
    int dev = 0, cus = 0, per_cu = 0;
    (void)hipGetDevice(&dev);
    (void)hipDeviceGetAttribute(&cus, hipDeviceAttributeMultiprocessorCount, dev);
    if (hipFuncSetAttribute((const void*)fwd_kernel, hipFuncAttributeMaxDynamicSharedMemorySize, LDS_BYTES) != hipSuccess) fprintf(stderr, "hipFuncSetAttribute(dynamic LDS %d) failed\n", LDS_BYTES);
    (void)hipOccupancyMaxActiveBlocksPerMultiprocessor(&per_cu, fwd_kernel, 512, LDS_BYTES);
    (void)hipGetLastError();
    grid_blocks = cus;
  }
  (void)hipMemsetAsync(p.bar(), 0, XCD_BAR_WORDS * 4, stream);
  void* args[] = {&ka};
  hipError_t e = hipLaunchCooperativeKernel((void*)fwd_kernel, dim3(grid_blocks), dim3(512), args, LDS_BYTES, stream);
  if (e != hipSuccess) fprintf(stderr, "cooperative launch failed: %s (grid %d, ws needed %zu of %zu)\n", hipGetErrorString(e), grid_blocks, off, ws_size);
}
```
